# Optimizing an MI355X kernel written in HIP

```python
import jax, jax.numpy as jnp
from jax import lax
import numpy as np

D_MODEL = 1024
BATCH = 16
SEQ = 4096
DEPTH = 2
DEC_BATCH = 16
DEC_SEQ = 32
PAST_LEN = 1024

CHUNK = 64
HEAD_DIM = 64
H_MLSTM = 4
H_FOX = 8
G_GMLP = 4
D_MLSTM = H_MLSTM * HEAD_DIM
D_FOX = H_FOX * HEAD_DIM
D_GMLP = G_GMLP * HEAD_DIM
D_MIX = D_MLSTM + D_FOX + D_GMLP
MLP_CHUNK = 128
Q_BLOCK = 128
D_FF = ((8 * D_MODEL + 3 * 256 - 1) // (3 * 256)) * 256
IN_SIZES = (D_MLSTM, D_MLSTM, D_MLSTM, D_MLSTM, H_MLSTM, H_MLSTM, D_FOX, D_FOX, D_FOX, H_FOX, D_GMLP, D_GMLP)
N_IN = 4 * D_MLSTM + 2 * H_MLSTM + 3 * D_FOX + H_FOX + 2 * D_GMLP
ALPHA = (2 * DEPTH) ** 0.25
BETA = (8 * DEPTH) ** -0.25
LN_EPS = 1e-5
HN_EPS = 1e-6
FOX_SCALE = HEAD_DIM ** -0.5

kernel_name = "hybrid_mlstm_fox_gmlp_stream_step"


def _layer_norm(x, g, b):
    xf = x.astype(jnp.float32)
    mu = xf.mean(-1, keepdims=True)
    var = jnp.square(xf - mu).mean(-1, keepdims=True)
    return ((xf - mu) * lax.rsqrt(var + LN_EPS) * g + b).astype(x.dtype)


def _head_norm(h):
    mu = h.mean(-1, keepdims=True)
    var = jnp.square(h - mu).mean(-1, keepdims=True)
    return (h - mu) * lax.rsqrt(var + HN_EPS)


def _mlstm_chunk(carry, inp):
    C0, n0, m0 = carry
    q, k, v, li, lf = inp
    L = q.shape[1]
    bT = jnp.cumsum(lf, axis=1).transpose(0, 2, 1)
    liT = li.transpose(0, 2, 1)
    causal = jnp.tril(jnp.ones((L, L), bool))
    dmat = jnp.where(causal, bT[..., :, None] - bT[..., None, :] + liT[..., None, :], -jnp.inf)
    inter = m0[..., None] + bT
    m = jnp.maximum(inter, dmat.max(-1))
    w_intra = jnp.exp(dmat - m[..., None])
    w_inter = jnp.exp(inter - m)
    s = jnp.einsum('bthd,bshd->bhts', q, k) * w_intra
    num = (jnp.einsum('bhts,bshd->bthd', s, v)
           + jnp.einsum('bthk,bhkv->bthv', q, C0) * w_inter.transpose(0, 2, 1)[..., None])
    den = s.sum(-1) + jnp.einsum('bthk,bhk->bht', q, n0) * w_inter
    den = jnp.maximum(jnp.abs(den), jnp.exp(-m))
    h = num / den.transpose(0, 2, 1)[..., None]
    m_end = m[..., -1]
    w_end = jnp.exp(dmat[..., -1, :] - m_end[..., None])
    d0 = jnp.exp(inter[..., -1] - m_end)
    C1 = d0[..., None, None] * C0 + jnp.einsum('bhs,bshk,bshv->bhkv', w_end, k, v)
    n1 = d0[..., None] * n0 + jnp.einsum('bhs,bshk->bhk', w_end, k)
    return (C1, n1, m_end), h


def _mlstm(q, k, v, li, lf, state0, blk):
    B, S = q.shape[:2]
    nc = S // blk

    def to_blocks(a):
        return a.reshape(B, nc, blk, *a.shape[2:]).swapaxes(0, 1)

    final, h = lax.scan(_mlstm_chunk, state0,
                        (to_blocks(q), to_blocks(k), to_blocks(v), to_blocks(li), to_blocks(lf)))
    return h.swapaxes(0, 1).reshape(B, S, H_MLSTM, HEAD_DIM), final


def _fox_prompt(q, k, v, logf):
    B, S = q.shape[:2]
    nb = S // Q_BLOCK
    Ft = jnp.cumsum(logf, axis=1).transpose(0, 2, 1)
    qb = q.reshape(B, nb, Q_BLOCK, H_FOX, HEAD_DIM).swapaxes(0, 1)
    Fb = Ft.reshape(B, H_FOX, nb, Q_BLOCK).transpose(2, 0, 1, 3)
    pos_k = jnp.arange(S)

    def block(args):
        i, qi, Fi = args
        pos_q = i * Q_BLOCK + jnp.arange(Q_BLOCK)
        logits = (jnp.einsum('bthd,bshd->bhts', qi, k) * FOX_SCALE
                  + Fi[..., None] - Ft[:, :, None, :])
        logits = jnp.where(pos_k[None, :] <= pos_q[:, None], logits, -jnp.inf)
        p = jax.nn.softmax(logits, axis=-1)
        return jnp.einsum('bhts,bshd->bthd', p, v)

    out = lax.map(block, (jnp.arange(nb), qb, Fb))
    return out.swapaxes(0, 1).reshape(B, S, H_FOX, HEAD_DIM)


def _fox_sample(q, k, v, logf, k_c, v_c, logf_c):
    P, T = k_c.shape[1], q.shape[1]
    k_all = jnp.concatenate([k_c, k], axis=1)
    v_all = jnp.concatenate([v_c, v], axis=1)
    Ft = jnp.cumsum(jnp.concatenate([logf_c, logf], axis=1), axis=1).transpose(0, 2, 1)
    logits = (jnp.einsum('bthd,bshd->bhts', q, k_all) * FOX_SCALE
              + Ft[:, :, P:, None] - Ft[:, :, None, :])
    mask = jnp.arange(P + T)[None, :] <= (P + jnp.arange(T))[:, None]
    p = jax.nn.softmax(jnp.where(mask, logits, -jnp.inf), axis=-1)
    return jnp.einsum('bhts,bshd->bthd', p, v_all)


def _spatial_gate(u, vn, ws, bs):
    B, S, _ = u.shape
    L = min(S, MLP_CHUNK)
    w = jnp.where(jnp.tril(jnp.ones((L, L), bool)), ws[:, :L, :L], 0.0)
    vc = vn.reshape(B, S // L, L, G_GMLP, HEAD_DIM)
    z = jnp.einsum('gts,bnsgc->bntgc', w, vc) + bs[:, :L].T[None, None, :, :, None]
    return u * z.reshape(B, S, D_GMLP).astype(u.dtype)


def _layer(x, c, p, cache):
    (w_ada, b_ada, w_in, b_mlstm_i, b_mlstm_f, mlstm_norm_g, b_fox_f, gmlp_ln_g, gmlp_ln_b,
     gmlp_ws, gmlp_bs, w_o, ln1_g, ln1_b, w_gate, w_up, w_down, ln2_g, ln2_b) = p
    B, S, _ = x.shape
    dt = x.dtype
    f32 = jnp.float32
    mod = jax.nn.silu(c) @ w_ada + b_ada
    sh1, sc1, g1, sh2, sc2, g2 = jnp.split(mod[:, None, :], 6, axis=-1)
    h = x * (1 + sc1) + sh1
    split_at = np.cumsum(IN_SIZES)[:-1].tolist()
    mq, mk, mv, mo, mi, mf, fq, fk, fv, ff, gu, gv = jnp.split(h @ w_in, split_at, axis=-1)

    def heads(a, n):
        return a.reshape(B, S, n, HEAD_DIM).astype(f32)

    li = mi.astype(f32) + b_mlstm_i
    lf = jax.nn.log_sigmoid(mf.astype(f32) + b_mlstm_f)
    if cache is None:
        st0 = (jnp.zeros((B, H_MLSTM, HEAD_DIM, HEAD_DIM), f32),
               jnp.zeros((B, H_MLSTM, HEAD_DIM), f32),
               jnp.full((B, H_MLSTM), -jnp.inf, f32))
        blk = CHUNK
    else:
        st0 = (cache[3].astype(f32), cache[4].astype(f32), cache[5].astype(f32))
        blk = S
    hm, (C1, n1, m1) = _mlstm(heads(mq, H_MLSTM), heads(mk, H_MLSTM) * HEAD_DIM ** -0.5,
                              heads(mv, H_MLSTM), li, lf, st0, blk)
    hm = (_head_norm(hm) * mlstm_norm_g.reshape(H_MLSTM, HEAD_DIM)
          * jax.nn.sigmoid(heads(mo, H_MLSTM)))
    fk_h, fv_h = heads(fk, H_FOX), heads(fv, H_FOX)
    logf = jax.nn.log_sigmoid(ff.astype(f32) + b_fox_f)
    if cache is None:
        hf = _fox_prompt(heads(fq, H_FOX), fk_h, fv_h, logf)
    else:
        hf = _fox_sample(heads(fq, H_FOX), fk_h, fv_h, logf,
                         cache[0].astype(f32), cache[1].astype(f32), cache[2].astype(f32))
    vn = _layer_norm(gv, gmlp_ln_g, gmlp_ln_b)
    hg = _spatial_gate(gu, vn, gmlp_ws, gmlp_bs)
    mix = jnp.concatenate([hm.reshape(B, S, D_MLSTM).astype(dt),
                           hf.reshape(B, S, D_FOX).astype(dt), hg], axis=-1) @ w_o
    x = _layer_norm(ALPHA * x + (1 + g1) * mix, ln1_g, ln1_b)
    h = x * (1 + sc2) + sh2
    y = (jax.nn.silu(h @ w_gate) * (h @ w_up)) @ w_down
    x = _layer_norm(ALPHA * x + (1 + g2) * y, ln2_g, ln2_b)
    new = (fk_h.astype(dt), fv_h.astype(dt), logf.astype(dt),
           C1.astype(dt), n1.astype(dt), m1.astype(dt), vn)
    return x, new


def setup_inputs(seed: int = 0) -> dict:
    key = jax.random.key(seed)
    ks = jax.random.split(key, 40)
    cnt = [0]

    def nk():
        cnt[0] += 1
        return ks[cnt[0] - 1]

    def nrm(shape, s=1.0):
        return s * jax.random.normal(nk(), shape, jnp.float32)

    def uni(shape, lo, hi):
        return jax.random.uniform(nk(), shape, jnp.float32, lo, hi)

    return {
        'x_prompt': nrm((BATCH, SEQ, D_MODEL)),
        'x_sample': nrm((DEC_BATCH, DEC_SEQ, D_MODEL)),
        'cache_fox_k': nrm((DEPTH, DEC_BATCH, PAST_LEN, H_FOX, HEAD_DIM)),
        'cache_fox_v': nrm((DEPTH, DEC_BATCH, PAST_LEN, H_FOX, HEAD_DIM)),
        'cache_fox_logf': jax.nn.log_sigmoid(3.5 + nrm((DEPTH, DEC_BATCH, PAST_LEN, H_FOX))),
        'state_mlstm_C': nrm((DEPTH, DEC_BATCH, H_MLSTM, HEAD_DIM, HEAD_DIM), 0.5),
        'state_mlstm_n': nrm((DEPTH, DEC_BATCH, H_MLSTM, HEAD_DIM), 0.5),
        'state_mlstm_m': nrm((DEPTH, DEC_BATCH, H_MLSTM)),
        'c_prompt': nrm((BATCH, D_MODEL)),
        'c_sample': nrm((DEC_BATCH, D_MODEL)),
        'w_ada': nrm((DEPTH, D_MODEL, 6 * D_MODEL), 0.5 * D_MODEL ** -0.5),
        'b_ada': nrm((DEPTH, 6 * D_MODEL), 0.05),
        'w_in': nrm((DEPTH, D_MODEL, N_IN), D_MODEL ** -0.5),
        'b_mlstm_i': nrm((DEPTH, H_MLSTM), 0.1),
        'b_mlstm_f': uni((DEPTH, H_MLSTM), 3.0, 6.0),
        'mlstm_norm_g': 1.0 + nrm((DEPTH, D_MLSTM), 0.05),
        'b_fox_f': uni((DEPTH, H_FOX), 2.0, 5.0),
        'gmlp_ln_g': 1.0 + nrm((DEPTH, D_GMLP), 0.05),
        'gmlp_ln_b': nrm((DEPTH, D_GMLP), 0.05),
        'gmlp_ws': nrm((DEPTH, G_GMLP, MLP_CHUNK, MLP_CHUNK), MLP_CHUNK ** -0.5),
        'gmlp_bs': 1.0 + nrm((DEPTH, G_GMLP, MLP_CHUNK), 0.1),
        'w_o': nrm((DEPTH, D_MIX, D_MODEL), BETA * D_MIX ** -0.5),
        'ln1_g': 1.0 + nrm((DEPTH, D_MODEL), 0.05),
        'ln1_b': nrm((DEPTH, D_MODEL), 0.05),
        'w_gate': nrm((DEPTH, D_MODEL, D_FF), D_MODEL ** -0.5),
        'w_up': nrm((DEPTH, D_MODEL, D_FF), D_MODEL ** -0.5),
        'w_down': nrm((DEPTH, D_FF, D_MODEL), BETA * D_FF ** -0.5),
        'ln2_g': 1.0 + nrm((DEPTH, D_MODEL), 0.05),
        'ln2_b': nrm((DEPTH, D_MODEL), 0.05),
    }


def reference(x_prompt, x_sample, cache_fox_k, cache_fox_v, cache_fox_logf, state_mlstm_C, state_mlstm_n,
              state_mlstm_m, c_prompt, c_sample, w_ada, b_ada, w_in, b_mlstm_i, b_mlstm_f, mlstm_norm_g,
              b_fox_f, gmlp_ln_g, gmlp_ln_b, gmlp_ws, gmlp_bs, w_o, ln1_g, ln1_b, w_gate, w_up, w_down,
              ln2_g, ln2_b):
    xp, xs = x_prompt, x_sample
    new_p, new_s = [], []
    for l in range(DEPTH):
        p = (w_ada[l], b_ada[l], w_in[l], b_mlstm_i[l], b_mlstm_f[l], mlstm_norm_g[l], b_fox_f[l],
             gmlp_ln_g[l], gmlp_ln_b[l], gmlp_ws[l], gmlp_bs[l], w_o[l], ln1_g[l], ln1_b[l],
             w_gate[l], w_up[l], w_down[l], ln2_g[l], ln2_b[l])
        xp, st_p = _layer(xp, c_prompt, p, None)
        xs, st_s = _layer(xs, c_sample, p, (cache_fox_k[l], cache_fox_v[l], cache_fox_logf[l],
                                             state_mlstm_C[l], state_mlstm_n[l], state_mlstm_m[l]))
        new_p.append(st_p)
        new_s.append(st_s)

    def stk(lst, i):
        return jnp.stack([e[i] for e in lst], axis=0)

    return (xp, xs,
            stk(new_p, 0), stk(new_p, 1), stk(new_p, 2), stk(new_p, 3), stk(new_p, 4), stk(new_p, 5),
            stk(new_s, 0), stk(new_s, 1), stk(new_s, 2), stk(new_s, 3), stk(new_s, 4), stk(new_s, 5),
            stk(new_s, 6))
```

```cpp
#include <hip/hip_runtime.h>
#include <hip/hip_bf16.h>
#include <hip/hip_cooperative_groups.h>
#include <cstdio>
#include <cstdint>
#include <cmath>
namespace cg = cooperative_groups;
__device__ __forceinline__ int mk_tid() { int t = threadIdx.x; asm volatile("" : "+v"(t)); return t; }
namespace pg8 {
#define PG8_LAS __attribute__((address_space(3)))
typedef unsigned short bf16_t;
typedef short bf16x8 __attribute__((ext_vector_type(8)));
typedef float f32x4 __attribute__((ext_vector_type(4)));
typedef unsigned u32x4 __attribute__((ext_vector_type(4)));
constexpr int BM = 256, BK = 64, HALF = 128, HTB = HALF * BK * 2  , STAGE_BYTES = 8 * HTB, NXCD = 8, WGM = 8;

__host__ __device__ __forceinline__ int lds_byte(int r, int c) { const int st = (r >> 4) * 2 + (c >> 5), rr = r & 15, cc = c & 31, ob = rr * 64 + cc * 2; return st * 1024 + (ob ^ (((ob >> 9) & 1) << 5)); }
__host__ __device__ __forceinline__ void stage_rc(int b, int& R, int& C) { const int st = b / 1024, sb = b % 1024, swz = sb ^ (((sb >> 9) & 1) << 5); R = (st >> 1) * 16 + swz / 64; C = (st & 1) * 32 + (swz % 64) / 2; }
__host__ __device__ __forceinline__ int perm32(int rho) { const int n = rho >> 4, i = rho & 15; return 8 * (i >> 2) + 4 * n + (i & 3); }

struct Unit { int pm, pn; };
struct Gemm { const bf16_t* A; const bf16_t* Bt; int M, N, K; };

struct StaticOrder {
    int nM, nN, nwg, G, c;
    __host__ __device__ void init(int M, int N, int G_, int c_) { nM = M / BM; nN = N / BM; nwg = nM * nN; G = G_; c = c_; }
    __host__ __device__ bool next(int i, Unit& u) const {
        const long L = (long)i * G + c; if (L >= nwg) return false;
        int wgid = (int)L; { const int q = nwg / NXCD, r = nwg % NXCD, xcd = wgid % NXCD, off = wgid / NXCD; wgid = (xcd < r ? xcd * (q + 1) : r * (q + 1) + (xcd - r) * q) + off; }
        const int nig = WGM * nN, gid = wgid / nig, fm = gid * WGM, gsz = (nM - fm) < WGM ? (nM - fm) : WGM;
        u.pm = fm + ((wgid % nig) % gsz); u.pn = (wgid % nig) / gsz; return true;
    }
    __device__ __forceinline__ void a_ready(const Unit&) const {}
    __device__ __forceinline__ void done(const Unit&) const {}
};

__device__ __forceinline__ unsigned cvt_pk_bf16(float lo, float hi) { unsigned r; asm volatile("v_cvt_pk_bf16_f32 %0, %1, %2" : "=v"(r) : "v"(lo), "v"(hi)); return r; }
typedef float f32x2 __attribute__((ext_vector_type(2)));
__device__ __forceinline__ f32x2 gelu_pk(f32x2 v) {
    const f32x2 av = __builtin_elementwise_abs(v), d = av * 0.2316418882f + 1.0f;
    f32x2 t; t.x = __builtin_amdgcn_rcpf(d.x); t.y = __builtin_amdgcn_rcpf(d.y);
    f32x2 q = t * 0.5307027145f + (-0.7265760135f); q = q * t + 0.7107068705f; q = q * t + (-0.142248368f); q = q * t + 0.127414796f; q = q * t;
    const f32x2 s = (v * v) * (-0.72134752044f);
    f32x2 e; e.x = __builtin_amdgcn_exp2f(s.x); e.y = __builtin_amdgcn_exp2f(s.y);
    const f32x2 m = v * (q * e), r = v - m;
    f32x2 o; o.x = v.x < 0.f ? m.x : r.x; o.y = v.y < 0.f ? m.y : r.y; return o;
}

template <int ACT  > struct EpiBf16 {
    static constexpr bool PERM = true, AFTER_DRAIN = false; static_assert(ACT == 0 || ACT == 1, "EpiBf16: ACT is 0 (none) or 1 (gelu_pk)");
    bf16_t* O; int ldc; const float* bias; int split_cols; size_t split_stride; float scale0;
    __device__ __forceinline__ void operator()(const f32x4 (&acc)[2][2][4][2], const Unit& u, int wr, int wc, int fr, int fq) const {
        const int row0 = u.pm * BM + wr * 64 + fr; int colt = u.pn * BM; bf16_t* base = O;
        float sc = 1.f; if (split_cols) { const int t = colt / split_cols; base += (size_t)t * split_stride; colt -= t * split_cols; if (t == 0) sc = scale0; }
        const int col0 = colt + wc * 32 + 8 * fq, bcol0 = u.pn * BM + wc * 32 + 8 * fq;
        f32x4 bv[2][2];
#pragma unroll
        for (int bj = 0; bj < 2; ++bj)
#pragma unroll
            for (int n = 0; n < 2; ++n) bv[bj][n] = bias ? *(const f32x4*)(bias + bcol0 + bj * HALF + 4 * n) : (f32x4){0.f, 0.f, 0.f, 0.f};
#pragma unroll
        for (int ai = 0; ai < 2; ++ai)
#pragma unroll
            for (int m = 0; m < 4; ++m) { bf16_t* rowp = base + (size_t)(row0 + ai * HALF + m * 16) * ldc + col0;
#pragma unroll
                for (int bj = 0; bj < 2; ++bj) { f32x4 v0 = acc[ai][bj][m][0] + bv[bj][0], v1 = acc[ai][bj][m][1] + bv[bj][1];
                    if (ACT == 1) { f32x2 a = gelu_pk((f32x2){v0[0], v0[1]}), b = gelu_pk((f32x2){v0[2], v0[3]}), c = gelu_pk((f32x2){v1[0], v1[1]}), d = gelu_pk((f32x2){v1[2], v1[3]});
                        v0 = (f32x4){a.x, a.y, b.x, b.y}; v1 = (f32x4){c.x, c.y, d.x, d.y}; }
                    v0 = v0 * sc; v1 = v1 * sc; u32x4 w; w.x = cvt_pk_bf16(v0[0], v0[1]); w.y = cvt_pk_bf16(v0[2], v0[3]); w.z = cvt_pk_bf16(v1[0], v1[1]); w.w = cvt_pk_bf16(v1[2], v1[3]);
                    *(u32x4*)(rowp + bj * HALF) = w; } }
    }
};

struct PanelStats {
    unsigned* xbuf;
    unsigned* cnt;
    unsigned* tmo;
    int ntn; float eps;
    unsigned code;
    __device__ __forceinline__ bool run(const f32x4 (&v)[2][2][4][2], const Unit& u, int wr, int wc, int fr, int fq, PG8_LAS unsigned char* lds, int wid, int lane) const {
        typedef float f32x2v __attribute__((ext_vector_type(2)));
        PG8_LAS f32x2v* P = (PG8_LAS f32x2v*)lds;
        PG8_LAS f32x2v* S = (PG8_LAS f32x2v*)(lds + 8192);
        PG8_LAS unsigned* flag = (PG8_LAS unsigned*)(lds + 8192 + 2048);
#pragma unroll
        for (int ai = 0; ai < 2; ++ai)
#pragma unroll
            for (int m = 0; m < 4; ++m) {
                float s = 0.f;
#pragma unroll
                for (int bj = 0; bj < 2; ++bj)
#pragma unroll
                    for (int n = 0; n < 2; ++n) { const f32x4 x = v[ai][bj][m][n]; s += (x[0] + x[1]) + (x[2] + x[3]); }
                s += __shfl_xor(s, 16); s += __shfl_xor(s, 32);
                const float mw = s * (1.0f / 64.0f); float q = 0.f;
#pragma unroll
                for (int bj = 0; bj < 2; ++bj)
#pragma unroll
                    for (int n = 0; n < 2; ++n) { const f32x4 d = v[ai][bj][m][n] - mw; q += (d[0] * d[0] + d[1] * d[1]) + (d[2] * d[2] + d[3] * d[3]); }
                q += __shfl_xor(q, 16); q += __shfl_xor(q, 32);
                if (fq == 0) P[(ai * HALF + wr * 64 + m * 16 + fr) * 4 + wc] = (f32x2v){mw, q};
            }
        asm volatile("s_waitcnt lgkmcnt(0)" ::: "memory"); __builtin_amdgcn_s_barrier(); asm volatile("" ::: "memory");
#if defined(BROKEN_EXCHANGE_NO_WAIT)
#warning BROKEN CONTROL BUILD: the row-statistics exchange does not wait; results are wrong by design
        if (blockIdx.x >= 64) { const long long t0_ = clock64(); while (clock64() - t0_ < 60000) __builtin_amdgcn_s_sleep(8); }
#endif
        const int row = wid * 32 + (lane & 31);
        if (lane < 32) {
            const f32x2v a = P[row * 4 + 0], b = P[row * 4 + 1], c = P[row * 4 + 2], d = P[row * 4 + 3];
            const float mt = (a.x + b.x + c.x + d.x) * 0.25f;
            const float da = a.x - mt, db = b.x - mt, dc = c.x - mt, dd = d.x - mt;
            const float m2 = (a.y + b.y) + (c.y + d.y) + 64.0f * ((da * da + db * db) + (dc * dc + dd * dd));
            unsigned long long* slot = (unsigned long long*)xbuf + ((size_t)(u.pm * BM + row) * 4 + u.pn);
            __hip_atomic_store(slot, ((unsigned long long)__float_as_uint(m2) << 32) | __float_as_uint(mt), __ATOMIC_RELAXED, __HIP_MEMORY_SCOPE_AGENT);
        }
        asm volatile("s_waitcnt vmcnt(0)" ::: "memory");
        if (lane == 0) __hip_atomic_fetch_add(cnt + 64 * u.pm, 1u, __ATOMIC_RELAXED, __HIP_MEMORY_SCOPE_AGENT);
        if (wid == 0) {
            bool dead = false; const unsigned long long t0 = __builtin_amdgcn_s_memrealtime(); const unsigned want = 8u * (unsigned)ntn;
            for (;;) {
#if defined(BROKEN_EXCHANGE_NO_WAIT)
                break;
#endif
                if ((unsigned)__builtin_amdgcn_readfirstlane(__hip_atomic_load(cnt + 64 * u.pm, __ATOMIC_RELAXED, __HIP_MEMORY_SCOPE_AGENT)) >= want) break;
                if (__builtin_amdgcn_s_memrealtime() - t0 > 2000000ull) {
                    if (lane == 0) { unsigned expect = 0u; __hip_atomic_compare_exchange_strong(tmo + 1, &expect, code | (unsigned)(u.pm & 0xff), __ATOMIC_RELAXED, __ATOMIC_RELAXED, __HIP_MEMORY_SCOPE_AGENT);
                                     __hip_atomic_store(tmo, 1u, __ATOMIC_RELAXED, __HIP_MEMORY_SCOPE_AGENT); }
                    dead = true; break; }
                __builtin_amdgcn_s_sleep(2);
            }
            __builtin_amdgcn_fence(__ATOMIC_ACQUIRE, "agent");
            if (lane == 0) flag[0] = dead ? 1u : 0u;
        }
        asm volatile("s_waitcnt vmcnt(0) lgkmcnt(0)" ::: "memory"); __builtin_amdgcn_s_barrier(); asm volatile("" ::: "memory");
        const bool bad = flag[0] != 0u;
        if (lane < 32) {
            const unsigned long long* slot = (const unsigned long long*)xbuf + (size_t)(u.pm * BM + row) * 4; float mt[4], m2[4]; float ms = 0.f;
#pragma unroll
            for (int t = 0; t < 4; ++t) { if (t < ntn) { const unsigned long long w = __hip_atomic_load(slot + t, __ATOMIC_RELAXED, __HIP_MEMORY_SCOPE_AGENT); mt[t] = __uint_as_float((unsigned)w); m2[t] = __uint_as_float((unsigned)(w >> 32)); } else { mt[t] = 0.f; m2[t] = 0.f; } ms += mt[t]; }
            const float mean = ms / (float)ntn; float q = 0.f;
#pragma unroll
            for (int t = 0; t < 4; ++t) if (t < ntn) { const float dm = mt[t] - mean; q += m2[t] + 256.0f * dm * dm; }
            S[row] = (f32x2v){mean, 1.0f / sqrtf(q / (256.0f * (float)ntn) + eps)};
        }
        asm volatile("s_waitcnt lgkmcnt(0)" ::: "memory"); __builtin_amdgcn_s_barrier(); asm volatile("" ::: "memory");
        return bad;
    }
};
struct EpiLnRes {
    static constexpr bool PERM = false, AFTER_DRAIN = true;
    const float* base; float* out; int ldc; const float* bias; PanelStats st; unsigned poison;
    __device__ __forceinline__ void fused(f32x4 (&acc)[2][2][4][2], const Unit& u, int wr, int wc, int fr, int fq, PG8_LAS unsigned char* lds, int wid, int lane) const {
        typedef float f32x2v __attribute__((ext_vector_type(2)));
        const PG8_LAS f32x2v* S = (const PG8_LAS f32x2v*)(lds + 8192);
        const int col0 = u.pn * BM + wc * 32 + 4 * fq;
#pragma unroll
        for (int bj = 0; bj < 2; ++bj)
#pragma unroll
            for (int n = 0; n < 2; ++n) { const f32x4 bv = bias ? *(const f32x4*)(bias + col0 + bj * HALF + n * 16) : (f32x4){0.f, 0.f, 0.f, 0.f};
#pragma unroll
                for (int ai = 0; ai < 2; ++ai)
#pragma unroll
                    for (int m = 0; m < 4; ++m) acc[ai][bj][m][n] += bv; }
        f32x4 pre[4][2][2];
#pragma unroll
        for (int m = 0; m < 4; ++m) { const size_t off = (size_t)(u.pm * BM + wr * 64 + m * 16 + fr) * ldc + col0;
#pragma unroll
            for (int bj = 0; bj < 2; ++bj)
#pragma unroll
                for (int n = 0; n < 2; ++n) pre[m][bj][n] = *(const f32x4*)(base + off + bj * HALF + n * 16); }
        const bool bad = st.run(acc, u, wr, wc, fr, fq, lds, wid, lane) || poison != 0u;
        const float qnan = __builtin_nanf("");
#pragma unroll
        for (int ai = 0; ai < 2; ++ai)
#pragma unroll
            for (int m = 0; m < 4; ++m) { const int r = ai * HALF + wr * 64 + m * 16 + fr; const f32x2v sr = S[r]; const size_t off = (size_t)(u.pm * BM + r) * ldc + col0;
#pragma unroll
                for (int bj = 0; bj < 2; ++bj)
#pragma unroll
                    for (int n = 0; n < 2; ++n) { const f32x4 bs = ai == 0 ? pre[m][bj][n] : *(const f32x4*)(base + off + bj * HALF + n * 16); f32x4 o = bs + (acc[ai][bj][m][n] - sr.x) * sr.y;
                        if (bad) o = (f32x4){qnan, qnan, qnan, qnan}; *(f32x4*)(out + off + bj * HALF + n * 16) = o; }
                if (m & 1) asm volatile("" ::: "memory"); }
    }
};
struct EpiLnResLn {
    static constexpr bool PERM = false, AFTER_DRAIN = true;
    const float* base; float* out; bf16_t* xn; int ldc; const float* bias; PanelStats st1, st2; unsigned poison;
    __device__ __forceinline__ void fused(f32x4 (&acc)[2][2][4][2], const Unit& u, int wr, int wc, int fr, int fq, PG8_LAS unsigned char* lds, int wid, int lane) const {
        typedef float f32x2v __attribute__((ext_vector_type(2))); typedef unsigned u32x2v __attribute__((ext_vector_type(2)));
        const PG8_LAS f32x2v* S = (const PG8_LAS f32x2v*)(lds + 8192);
        const int col0 = u.pn * BM + wc * 32 + 4 * fq;
#pragma unroll
        for (int bj = 0; bj < 2; ++bj)
#pragma unroll
            for (int n = 0; n < 2; ++n) { const f32x4 bv = bias ? *(const f32x4*)(bias + col0 + bj * HALF + n * 16) : (f32x4){0.f, 0.f, 0.f, 0.f};
#pragma unroll
                for (int ai = 0; ai < 2; ++ai)
#pragma unroll
                    for (int m = 0; m < 4; ++m) acc[ai][bj][m][n] += bv; }
        bool bad = st1.run(acc, u, wr, wc, fr, fq, lds, wid, lane) || poison != 0u;
        const float qnan = __builtin_nanf("");
#pragma unroll
        for (int ai = 0; ai < 2; ++ai)
#pragma unroll
            for (int m = 0; m < 4; ++m) { const int r = ai * HALF + wr * 64 + m * 16 + fr; const f32x2v sr = S[r]; const size_t off = (size_t)(u.pm * BM + r) * ldc + col0;
#pragma unroll
                for (int bj = 0; bj < 2; ++bj)
#pragma unroll
                    for (int n = 0; n < 2; ++n) { const f32x4 bs = *(const f32x4*)(base + off + bj * HALF + n * 16); acc[ai][bj][m][n] = bs + (acc[ai][bj][m][n] - sr.x) * sr.y; }
                asm volatile("" : "+v"(acc[ai][0][m][0]), "+v"(acc[ai][0][m][1]), "+v"(acc[ai][1][m][0]), "+v"(acc[ai][1][m][1]));
                if (m & 1) asm volatile("" ::: "memory"); }
        const bool bad1 = bad;
        bad = st2.run(acc, u, wr, wc, fr, fq, lds, wid, lane) || bad;
#pragma unroll
        for (int ai = 0; ai < 2; ++ai)
#pragma unroll
            for (int m = 0; m < 4; ++m) { const int r = ai * HALF + wr * 64 + m * 16 + fr; const f32x2v sr = S[r]; const size_t off = (size_t)(u.pm * BM + r) * ldc + col0;
#pragma unroll
                for (int bj = 0; bj < 2; ++bj)
#pragma unroll
                    for (int n = 0; n < 2; ++n) { const f32x4 x1 = acc[ai][bj][m][n]; *(f32x4*)(out + off + bj * HALF + n * 16) = bad1 ? (f32x4){qnan, qnan, qnan, qnan} : x1;
                        const f32x4 o = (x1 - sr.x) * sr.y; u32x2v w; w.x = cvt_pk_bf16(o[0], o[1]); w.y = cvt_pk_bf16(o[2], o[3]);
                        if (bad) { w.x = 0x7fc07fc0u; w.y = 0x7fc07fc0u; } *(u32x2v*)(xn + off + bj * HALF + n * 16) = w; }
                asm volatile("" ::: "memory"); }
    }
};

template <class Epi, class Sched, bool ALIGN_EPI = false, bool SP2 = false>
__device__ __forceinline__ void gemm_phase(PG8_LAS unsigned char* lds, const Gemm g, const Sched& S, const Epi& E) {
    const int tid = mk_tid(), wid = __builtin_amdgcn_readfirstlane(tid >> 6), lane = tid & 63, wr = wid >> 2, wc = wid & 3, fr = lane & 15, fq = lane >> 4;
    const int K = g.K, nt = K / BK;
    unsigned voffA[2], voffB[2];
#pragma unroll
    for (int i = 0; i < 2; ++i) { int R, C; stage_rc(tid * 16 + i * 8192, R, C); const int Rb = Epi::PERM ? ((R & ~31) + perm32(R & 31)) : R;
        voffA[i] = (unsigned)(R * K + C) * 2u; voffB[i] = (unsigned)(Rb * K + C) * 2u; }
    const size_t kstep = (size_t)(BK * 2);
    const size_t hstep = (size_t)HALF * K * 2;
    const size_t tstep = 2 * hstep;
    const unsigned ldsw = (unsigned)wid * 1024u;
    const int aoff = lds_byte(wr * 64 + fr, fq * 8), boff = lds_byte(wc * 32 + fr, fq * 8);
#define PG8_SA(b, h) (((b) * 2 + (h)) * HTB)
#define PG8_SB(b, h) ((4 + (b) * 2 + (h)) * HTB)
#define PG8_STAGE(bufoff, gbase, voff) do { _Pragma("unroll") for (int _i = 0; _i < 2; ++_i) \
        __builtin_amdgcn_global_load_lds((const unsigned*)((const char*)(gbase) + (voff)[_i]), (PG8_LAS unsigned*)(lds + (bufoff) + ldsw + _i * 8192), 16, 0, 0); } while (0)
#define PG8_LDA(dst, b, h) do { _Pragma("unroll") for (int m = 0; m < 4; ++m) _Pragma("unroll") for (int k = 0; k < 2; ++k) dst[m][k] = *(const PG8_LAS bf16x8*)(lds + PG8_SA(b, h) + aoff + m * 2048 + k * 1024); } while (0)
#define PG8_LDB(dst, b, h) do { _Pragma("unroll") for (int n = 0; n < 2; ++n) _Pragma("unroll") for (int k = 0; k < 2; ++k) dst[n][k] = *(const PG8_LAS bf16x8*)(lds + PG8_SB(b, h) + boff + n * 2048 + k * 1024); } while (0)
#define PG8_MMA(ai, bj, At, Bt) do { __builtin_amdgcn_s_setprio(1); _Pragma("unroll") for (int m = 0; m < 4; ++m) _Pragma("unroll") for (int n = 0; n < 2; ++n) _Pragma("unroll") for (int k = 0; k < 2; ++k) \
        acc[ai][bj][m][n] = __builtin_amdgcn_mfma_f32_16x16x32_bf16(Bt[n][k], At[m][k], acc[ai][bj][m][n], 0, 0, 0); __builtin_amdgcn_s_setprio(0); } while (0)
#define PG8_WAIT_V(n) asm volatile("s_waitcnt vmcnt(" #n ")" ::: "memory")
#define PG8_WAIT_L(n) asm volatile("s_waitcnt lgkmcnt(" #n ")" ::: "memory")
#define PG8_BAR __builtin_amdgcn_s_barrier()
#define PG8_SCHED __builtin_amdgcn_sched_barrier(0)
    Unit cur, nxt; int ui = 0;
    if (!S.next(0, cur)) return;
    f32x4 acc[2][2][4][2];
#pragma unroll
    for (int a = 0; a < 2; ++a)
#pragma unroll
        for (int b = 0; b < 2; ++b)
#pragma unroll
            for (int m = 0; m < 4; ++m)
#pragma unroll
                for (int n = 0; n < 2; ++n) acc[a][b][m][n] = (f32x4){0.f, 0.f, 0.f, 0.f};
    bf16x8 At[4][2], B0[2][2], B1[2][2];
    const char* cA = (const char*)g.A + (size_t)cur.pm * tstep; const char* cB = (const char*)g.Bt + (size_t)cur.pn * tstep;
    S.a_ready(cur);
    if constexpr (SP2) {
        PG8_STAGE(PG8_SB(0, 0), cB, voffB); PG8_STAGE(PG8_SB(0, 1), cB + hstep, voffB); PG8_STAGE(PG8_SA(0, 0), cA, voffA); PG8_STAGE(PG8_SA(0, 1), cA + hstep, voffA);
        if (wr == 1) PG8_BAR;
        PG8_WAIT_V(2); PG8_BAR;
        PG8_STAGE(PG8_SB(1, 0), cB + kstep, voffB); PG8_STAGE(PG8_SA(1, 0), cA + kstep, voffA); PG8_STAGE(PG8_SB(1, 1), cB + hstep + kstep, voffB);
        PG8_WAIT_V(6); PG8_BAR;
    } else {
        PG8_STAGE(PG8_SB(0, 0), cB, voffB); PG8_STAGE(PG8_SA(0, 0), cA, voffA); PG8_STAGE(PG8_SB(0, 1), cB + hstep, voffB); PG8_STAGE(PG8_SA(0, 1), cA + hstep, voffA);
        if (wr == 1) PG8_BAR;
        PG8_WAIT_V(4); PG8_BAR;
        PG8_STAGE(PG8_SB(1, 0), cB + kstep, voffB); PG8_STAGE(PG8_SA(1, 0), cA + kstep, voffA); PG8_STAGE(PG8_SB(1, 1), cB + hstep + kstep, voffB);
        PG8_WAIT_V(6); PG8_BAR;
    }
    for (;;) {
        const bool has_next = S.next(ui + 1, nxt);
        const char* nA = has_next ? (const char*)g.A + (size_t)nxt.pm * tstep : cA; const char* nB = has_next ? (const char*)g.Bt + (size_t)nxt.pn * tstep : cB;
        for (int t = 0; t < nt; t += 2) {
            const bool last = (t == nt - 2);
            const char* a1 = cA + (size_t)(t + 1) * kstep;
            const char* a2 = last ? nA : cA + (size_t)(t + 2) * kstep; const char* b2 = last ? nB : cB + (size_t)(t + 2) * kstep;
            const char* a3 = a2 + kstep; const char* b3 = b2 + kstep;
            if (last && has_next) S.a_ready(nxt);
            if constexpr (SP2) {
            PG8_LDB(B0, 0, 0); PG8_LDB(B1, 0, 1); PG8_SCHED; PG8_LDA(At, 0, 0); PG8_STAGE(PG8_SA(1, 1), a1 + hstep, voffA);
            PG8_WAIT_V(8); PG8_WAIT_L(0); PG8_BAR; PG8_MMA(0, 0, At, B0); PG8_MMA(0, 1, At, B1); PG8_BAR; PG8_SCHED;
            PG8_LDA(At, 0, 1); PG8_STAGE(PG8_SB(0, 0), b2, voffB); PG8_STAGE(PG8_SB(0, 1), b2 + hstep, voffB); PG8_STAGE(PG8_SA(0, 0), a2, voffA);
            PG8_WAIT_V(8); PG8_WAIT_L(0); PG8_BAR; PG8_MMA(1, 0, At, B0); PG8_MMA(1, 1, At, B1); PG8_BAR; PG8_SCHED;
            PG8_LDB(B0, 1, 0); PG8_LDB(B1, 1, 1); PG8_SCHED; PG8_LDA(At, 1, 0); PG8_STAGE(PG8_SA(0, 1), a2 + hstep, voffA);
            PG8_WAIT_V(8); PG8_WAIT_L(0); PG8_BAR; PG8_MMA(0, 0, At, B0); PG8_MMA(0, 1, At, B1); PG8_BAR; PG8_SCHED;
            PG8_LDA(At, 1, 1); PG8_STAGE(PG8_SB(1, 0), b3, voffB); PG8_STAGE(PG8_SB(1, 1), b3 + hstep, voffB); PG8_STAGE(PG8_SA(1, 0), a3, voffA);
            PG8_WAIT_V(8); PG8_WAIT_L(0); PG8_BAR; PG8_MMA(1, 0, At, B0); PG8_MMA(1, 1, At, B1); PG8_BAR; PG8_SCHED;
            } else {
            PG8_LDB(B0, 0, 0); PG8_SCHED; PG8_LDA(At, 0, 0); PG8_STAGE(PG8_SA(1, 1), a1 + hstep, voffA);
            PG8_WAIT_L(8); PG8_BAR; PG8_WAIT_L(0); PG8_MMA(0, 0, At, B0); PG8_BAR; PG8_SCHED;
            PG8_LDB(B1, 0, 1); PG8_STAGE(PG8_SB(0, 0), b2, voffB);
            PG8_BAR; PG8_WAIT_L(0); PG8_MMA(0, 1, At, B1); PG8_BAR;
            PG8_LDA(At, 0, 1); PG8_STAGE(PG8_SA(0, 0), a2, voffA);
            PG8_BAR; PG8_WAIT_L(0); PG8_MMA(1, 0, At, B0); PG8_BAR; PG8_SCHED;
            PG8_STAGE(PG8_SB(0, 1), b2 + hstep, voffB);
            PG8_WAIT_V(6); PG8_BAR; PG8_MMA(1, 1, At, B1); PG8_BAR;
            PG8_LDB(B0, 1, 0); PG8_SCHED; PG8_LDA(At, 1, 0); PG8_STAGE(PG8_SA(0, 1), a2 + hstep, voffA);
            PG8_WAIT_L(8); PG8_BAR; PG8_WAIT_L(0); PG8_MMA(0, 0, At, B0); PG8_BAR; PG8_SCHED;
            PG8_LDB(B1, 1, 1); PG8_STAGE(PG8_SB(1, 0), b3, voffB);
            PG8_BAR; PG8_WAIT_L(0); PG8_MMA(0, 1, At, B1); PG8_BAR;
            PG8_LDA(At, 1, 1); PG8_STAGE(PG8_SA(1, 0), a3, voffA);
            PG8_BAR; PG8_WAIT_L(0); PG8_MMA(1, 0, At, B0); PG8_BAR; PG8_SCHED;
            PG8_STAGE(PG8_SB(1, 1), b3 + hstep, voffB);
            PG8_WAIT_V(6); PG8_BAR; PG8_MMA(1, 1, At, B1); PG8_BAR;
            }
        }
        if constexpr (ALIGN_EPI) { if (wr == 0) PG8_BAR; }
        if constexpr (!Epi::AFTER_DRAIN) { E(acc, cur, wr, wc, fr, fq); S.done(cur); }
        if (!has_next) break;
#pragma unroll
        for (int a = 0; a < 2; ++a)
#pragma unroll
            for (int b = 0; b < 2; ++b)
#pragma unroll
                for (int m = 0; m < 4; ++m)
#pragma unroll
                    for (int n = 0; n < 2; ++n) acc[a][b][m][n] = (f32x4){0.f, 0.f, 0.f, 0.f};
        cur = nxt; cA = nA; cB = nB; ++ui;
        if constexpr (ALIGN_EPI) { if (wr == 1) PG8_BAR; }
    }
    PG8_WAIT_V(0);
    if constexpr (!ALIGN_EPI) { if (wr == 0) PG8_BAR; }
    PG8_BAR;
    if constexpr (Epi::AFTER_DRAIN) { E.fused(acc, cur, wr, wc, fr, fq, lds, wid, lane); S.done(cur); }
#undef PG8_SA
#undef PG8_SB
#undef PG8_STAGE
#undef PG8_LDA
#undef PG8_LDB
#undef PG8_MMA
#undef PG8_WAIT_V
#undef PG8_WAIT_L
#undef PG8_BAR
#undef PG8_SCHED
}
}

#ifndef PG8_SP2
#define PG8_SP2 true
#endif
namespace attn_body {
using bf16=__hip_bfloat16;
using bf16x8=__attribute__((ext_vector_type(8)))short;
using s16x4=__attribute__((ext_vector_type(4)))short;
using f32x16=__attribute__((ext_vector_type(16)))float;
using u32x4=__attribute__((ext_vector_type(4)))unsigned;
constexpr int BATCH=16,NHEAD=8,SEQ=4096,D=64,DM=3072,OPITCH=1024;
constexpr int NW=8,QBLK=32,QB=QBLK*NW,KVBLK=64,NQB=SEQ/QB;
constexpr int ATTN_PITCH=DM, ATTN_UNIT_ROWS=QB;
__device__ __forceinline__ int crow(int r,int hi){return (r&3)+8*(r>>2)+4*hi;}
#define SBAR() __builtin_amdgcn_sched_barrier(0)
__device__ __forceinline__ void cmask(f32x16&p0,f32x16&p1,int jb,int qrel,int hi){
  const float NEG=-INFINITY; int kb=64*jb+4*hi;
  #pragma unroll
  for(int r=0;r<16;++r){int kv=kb+(r&3)+8*(r>>2); if(kv>qrel)p0[r]=NEG; if(kv+32>qrel)p1[r]=NEG;}
}

constexpr int NSLOT=3, SLOTB=8192;
constexpr int LDS_K=0, LDS_V=NSLOT*SLOTB, LDS_WS=2*NSLOT*SLOTB, LDS_OST=LDS_WS+NW*64*4, LDS_BYTES=LDS_OST+NW*4096, LDS_F=86016;
constexpr float C2=0.125f*1.4426950408889634f;
__device__ __forceinline__ void glds16(const void*gsrc,unsigned lds_dst){unsigned keep;
  asm volatile("s_mov_b32 %0, m0\n\ts_mov_b32 m0, %2\n\ts_nop 0\n\tglobal_load_lds_dwordx4 %1, off\n\ts_mov_b32 m0, %0":"=&s"(keep):"v"(gsrc),"s"(lds_dst):"memory");}
__device__ __forceinline__ float max3f(float a,float b,float c){float r;asm("v_max3_f32 %0, %1, %2, %3":"=v"(r):"v"(a),"v"(b),"v"(c));return r;}
__device__ __forceinline__ float max2f(float a,float b){float r;asm("v_max_f32_e32 %0, %1, %2":"=v"(r):"v"(a),"v"(b));return r;}
__device__ __forceinline__ float fadd_s(float a,float b){float r;asm("v_add_f32_e32 %0, %1, %2":"=v"(r):"v"(a),"v"(b));return r;}
__device__ __forceinline__ float fsub_s(float a,float b){float r;asm("v_sub_f32_e32 %0, %1, %2":"=v"(r):"v"(a),"v"(b));return r;}
typedef float f32x2_t __attribute__((ext_vector_type(2))); typedef __bf16 bf16x2_t __attribute__((ext_vector_type(2)));
__device__ __forceinline__ unsigned cvtpk_s(float lo,float hi){f32x2_t v={lo,hi};bf16x2_t b=__builtin_convertvector(v,bf16x2_t);return __builtin_bit_cast(unsigned,b);}
#define WAIT_BAR(N) asm volatile("s_waitcnt vmcnt(" #N ") lgkmcnt(0)\n\ts_barrier":::"memory")

__device__ __forceinline__ void qkt(f32x16&p0,f32x16&p1,const char*Kslot,const bf16x8*qr,int r32,int hi){
  const char*kb=Kslot+hi*1024+r32*16;
  #pragma unroll
  for(int d0=0;d0<4;++d0){
    const bf16x8 b0=*reinterpret_cast<const bf16x8*>(kb+d0*2048);
    const bf16x8 b1=*reinterpret_cast<const bf16x8*>(kb+d0*2048+512);
    p0=__builtin_amdgcn_mfma_f32_32x32x16_bf16(b0,qr[d0],p0,0,0,0);p1=__builtin_amdgcn_mfma_f32_32x32x16_bf16(b1,qr[d0],p1,0,0,0);}
}
typedef __attribute__((address_space(3))) const char* lds_cptr;
typedef short v4i16_t __attribute__((ext_vector_type(4)));
__device__ __forceinline__ void kload8(bf16x8*kf,lds_cptr kp){
  kf[0]=*(const __attribute__((address_space(3))) bf16x8*)(kp);      kf[1]=*(const __attribute__((address_space(3))) bf16x8*)(kp+512);
  kf[2]=*(const __attribute__((address_space(3))) bf16x8*)(kp+2048); kf[3]=*(const __attribute__((address_space(3))) bf16x8*)(kp+2560);
  kf[4]=*(const __attribute__((address_space(3))) bf16x8*)(kp+4096); kf[5]=*(const __attribute__((address_space(3))) bf16x8*)(kp+4608);
  kf[6]=*(const __attribute__((address_space(3))) bf16x8*)(kp+6144); kf[7]=*(const __attribute__((address_space(3))) bf16x8*)(kp+6656);
}
__device__ __forceinline__ void kload2(bf16x8*kf,lds_cptr kp,int j){ kf[2*j]=*(const __attribute__((address_space(3))) bf16x8*)(kp+j*2048); kf[2*j+1]=*(const __attribute__((address_space(3))) bf16x8*)(kp+j*2048+512); }
__device__ __forceinline__ s16x4 vtr(lds_cptr p){ return __builtin_bit_cast(s16x4,__builtin_amdgcn_ds_read_tr16_b64_v4i16((__attribute__((address_space(3))) v4i16_t*)p)); }
__device__ __forceinline__ float rowmax(const f32x16&p0,const f32x16&p1){
  float a=max3f(p0[0],p0[1],p1[0]),b=max3f(p0[2],p0[3],p1[1]);a=max3f(a,p1[2],p1[3]);
  #pragma unroll
  for(int r=4;r<16;r+=4){a=max3f(a,p0[r],p0[r+1]);b=max3f(b,p0[r+2],p0[r+3]);a=max3f(a,p1[r],p1[r+1]);b=max3f(b,p1[r+2],p1[r+3]);}
  const float m=max2f(a,b);
  auto rr=__builtin_amdgcn_permlane32_swap(__float_as_uint(m),__float_as_uint(m),false,false);
  return max2f(__uint_as_float(rr[0]),__uint_as_float(rr[1]));
}
__device__ __forceinline__ void pv(f32x16*o,int vb,bf16x8 pa0,bf16x8 pa1,bf16x8 pa2,bf16x8 pa3){
  #pragma unroll
  for(int d0=0;d0<2;++d0){s16x4 lo[4],hi[4];
    #pragma unroll
    for(int ks=0;ks<4;++ks){
      asm volatile("ds_read_b64_tr_b16 %0,%1 offset:%c2":"=&v"(lo[ks]):"v"(vb),"i"(d0*4096+ks*1024):"memory");
      asm volatile("ds_read_b64_tr_b16 %0,%1 offset:%c2":"=&v"(hi[ks]):"v"(vb),"i"(d0*4096+ks*1024+512):"memory");}
    asm volatile("s_waitcnt lgkmcnt(0)":::"memory");SBAR();
    #define PK(k) (bf16x8){lo[k][0],lo[k][1],lo[k][2],lo[k][3],hi[k][0],hi[k][1],hi[k][2],hi[k][3]}
    o[d0]=__builtin_amdgcn_mfma_f32_32x32x16_bf16(pa0,PK(0),o[d0],0,0,0);
    o[d0]=__builtin_amdgcn_mfma_f32_32x32x16_bf16(pa1,PK(1),o[d0],0,0,0);
    o[d0]=__builtin_amdgcn_mfma_f32_32x32x16_bf16(pa2,PK(2),o[d0],0,0,0);
    o[d0]=__builtin_amdgcn_mfma_f32_32x32x16_bf16(pa3,PK(3),o[d0],0,0,0);
    #undef PK
  }
}

#ifndef ATTN_STORE16
#define ATTN_STORE16(p,v) (*(u32x4*)(p)=(v))
#endif
template<int THRL> __device__ __forceinline__ void attn_unit(int b,int h,int qb,const bf16*Q,const bf16*__restrict__ K,const bf16*__restrict__ V,bf16*O,const float*Fg,char*shm){
  const int tid=mk_tid(),lane=tid&63,r32=lane&31,hi=lane>>5; const int wid=__builtin_amdgcn_readfirstlane(tid>>6);
  const long rowbase=(long)b*SEQ; const int q0=qb*QB;
  const bf16*Qw=Q+(rowbase+q0+wid*QBLK)*DM+h*D;
  const bf16*Kh=K+rowbase*DM+h*D,*Vh=V+rowbase*DM+h*D;
  const unsigned lds0=(unsigned)(uintptr_t)shm;
  float*wsf=(float*)(shm+LDS_WS)+wid*64;
  const bf16*ksrc=Kh+(long)lane*DM+wid*8;
  const bf16*vsrc=Vh+(long)(16*(wid&3)+(lane>>2))*DM+(wid>>2)*32+(lane&3)*8;
  const unsigned kdst=lds0+LDS_K+wid*1024, vdst=lds0+LDS_V+wid*1024;
  #define DMA_K(t,slot) glds16(ksrc+(long)(t)*KVBLK*DM,(unsigned)__builtin_amdgcn_readfirstlane(kdst+(slot)))
  #define DMA_V(t,slot) glds16(vsrc+(long)(t)*KVBLK*DM,(unsigned)__builtin_amdgcn_readfirstlane(vdst+(slot)))
  const int vb0=(int)(lds0+LDS_V)+((lane>>4)&1)*32+(lane&3)*8+(4*hi+((lane&15)>>2))*64;
  const char*Kbase=shm+LDS_K; bf16x8 kf[8];
  const lds_cptr shm3=(lds_cptr)shm; const lds_cptr kp0=shm3+LDS_K+hi*1024+r32*16; const lds_cptr vp0=shm3+LDS_V+((lane>>4)&1)*32+(lane&3)*8+(4*hi+((lane&15)>>2))*64;
  const int NT=(q0+QB)/KVBLK;
  typedef float f4v_t __attribute__((ext_vector_type(4))); typedef __attribute__((address_space(3))) f4v_t lf4_t; lf4_t*Fl4=(lf4_t*)((__attribute__((address_space(3))) char*)shm+LDS_F);
  { const int nf4=(q0+QB)/4; const f4v_t*src=(const f4v_t*)Fg; for(int i=tid;i<nf4;i+=NW*64) Fl4[i]=src[i]; }
  const float fq_l=Fg[q0+wid*QBLK+r32];
  #define BINIT(C0,C1,t) do{ const lf4_t*fp_=Fl4+(t)*16+hi; _Pragma("unroll") for(int a_=0;a_<4;++a_){ const f4v_t f0_=fp_[2*a_], f1_=fp_[8+2*a_]; \
      C0[4*a_]=nb-f0_.x; C0[4*a_+1]=nb-f0_.y; C0[4*a_+2]=nb-f0_.z; C0[4*a_+3]=nb-f0_.w; C1[4*a_]=nb-f1_.x; C1[4*a_+1]=nb-f1_.y; C1[4*a_+2]=nb-f1_.z; C1[4*a_+3]=nb-f1_.w; } }while(0)
  DMA_K(0,0);DMA_V(0,0);DMA_K(1,SLOTB);
  bf16x8 qr[4];
  #pragma unroll
  for(int d0=0;d0<4;++d0)qr[d0]=*reinterpret_cast<const bf16x8*>(&Qw[(long)r32*DM+d0*16+hi*8]);
  float mhat=0.f,l_reg=0.f;f32x16 o[2];o[0]=f32x16{};o[1]=f32x16{};float nb=fq_l;
  const int qrel=wid*QBLK+r32;
  #define CMASK(P0,P1,t) do{int jb_=(t)-(NT-4); if(jb_>=0)cmask(P0,P1,jb_,qrel,hi);}while(0)
  bool resc=false;
  #define START(P0,P1) do{ const float rm=rowmax(P0,P1); resc=false; \
    { const float dl=rm; mhat=fadd_s(mhat,dl); \
      _Pragma("unroll") for(int r=0;r<16;++r){P0[r]=fsub_s(P0[r],dl);P1[r]=fsub_s(P1[r],dl);} \
      nb=fq_l-mhat; } \
    _Pragma("unroll") for(int r=0;r<16;++r)P0[r]=__builtin_amdgcn_exp2f(P0[r]); }while(0)
  #define RESC() do{ if(resc){ asm volatile("s_waitcnt lgkmcnt(0)":::"memory"); \
      _Pragma("unroll") for(int d_=0;d_<2;++d_) _Pragma("unroll") for(int r=0;r<16;++r)o[d_][r]*=wsf[crow(r,hi)]; } }while(0)
  f32x16 pA0,pA1,pB0,pB1;
  int sl_prev=0,sl_cur=0,sl_next=SLOTB;
  #define ROT() do{sl_prev=sl_cur;sl_cur=sl_next;sl_next=(sl_next==(NSLOT-1)*SLOTB)?0:sl_next+SLOTB;}while(0)
  DMA_K(2,2*SLOTB);
  WAIT_BAR(3);
  BINIT(pA0,pA1,0); qkt(pA0,pA1,Kbase,qr,r32,hi);asm volatile("s_nop 15\n\ts_nop 7":"+v"(pA0),"+v"(pA1));CMASK(pA0,pA1,0);
  START(pA0,pA1);
  _Pragma("unroll") for(int r=0;r<16;++r)pA1[r]=__builtin_amdgcn_exp2f(pA1[r]);
  WAIT_BAR(0);
  DMA_K(3,0);DMA_V(1,SLOTB);
  ROT();
  kload8(kf,kp0+sl_cur);
  WAIT_BAR(2);
  s16x4 vlo[8],vhi[8]; u32x4 pw0,pw1,pw2,pw3;
  #define PKW(P,B) cvtpk_s(P[B],P[B+1])
  #define PAF(k) __builtin_bit_cast(bf16x8,pw##k)
  #define VFR(i) (bf16x8){vlo[i][0],vlo[i][1],vlo[i][2],vlo[i][3],vhi[i][0],vhi[i][1],vhi[i][2],vhi[i][3]}
  #define PIN(x) asm volatile("":"+v"(x))
  #define MX3(a,b,c) __builtin_fmaxf(__builtin_fmaxf((a),(b)),(c))
  #define GAPA(MF,A0,A1,A2,A3,W0,W1,PW) do{ MF; sacc+=A0; sacc+=A1; sacc+=A2; sacc+=A3; PIN(sacc); W0; W1; PIN(PW); SBAR(); }while(0)
  #define EX(v) __builtin_amdgcn_exp2f(v)
  #define GAPB(MF,X,B) do{ MF; X[B]=EX(X[B]); X[B+1]=EX(X[B+1]); X[B+2]=EX(X[B+2]); X[B+3]=EX(X[B+3]); PIN(X); SBAR(); }while(0)
  #define VRD(i) do{ vlo[i]=vtr(vp_+(((i)>>2)*4096+((i)&3)*1024)); vhi[i]=vtr(vp_+(((i)>>2)*4096+((i)&3)*1024+512)); }while(0)
  #define KRD(G,j) do{ if(G){ kload2(kf,kp0+sl_next,j); SBAR(); } }while(0)
  #define STEP(C0,C1,P0,P1,t,GK,GV,GL) do{ BINIT(C0,C1,t); SBAR(); \
    const lds_cptr vp_=vp0+sl_prev; \
    VRD(0); SBAR(); float sacc=(P0[0]+P0[1]); \
    GAPA(C0=__builtin_amdgcn_mfma_f32_32x32x16_bf16(kf[0],qr[0],C0,0,0,0), P0[2],P0[3],P0[4],P0[5],     pw0[0]=PKW(P0,0), pw0[1]=PKW(P0,2), pw0); \
    VRD(4); SBAR(); GAPA(C1=__builtin_amdgcn_mfma_f32_32x32x16_bf16(kf[1],qr[0],C1,0,0,0), P0[6],P0[7],P0[8],P0[9],     pw0[2]=PKW(P0,4), pw0[3]=PKW(P0,6), pw0); \
    VRD(1); SBAR(); GAPA(C0=__builtin_amdgcn_mfma_f32_32x32x16_bf16(kf[2],qr[1],C0,0,0,0),   P0[10],P0[11],P0[12],P0[13], pw1[0]=PKW(P0,8), pw1[1]=PKW(P0,10), pw1); \
    VRD(5); SBAR(); GAPA(C1=__builtin_amdgcn_mfma_f32_32x32x16_bf16(kf[3],qr[1],C1,0,0,0),   P0[14],P0[15],P1[0],P1[1],   pw1[2]=PKW(P0,12),pw1[3]=PKW(P0,14), pw1); \
    VRD(2); SBAR(); GAPA(C0=__builtin_amdgcn_mfma_f32_32x32x16_bf16(kf[4],qr[2],C0,0,0,0),   P1[2],P1[3],P1[4],P1[5],     pw2[0]=PKW(P1,0), pw2[1]=PKW(P1,2), pw2); \
    VRD(6); SBAR(); GAPA(C1=__builtin_amdgcn_mfma_f32_32x32x16_bf16(kf[5],qr[2],C1,0,0,0),   P1[6],P1[7],P1[8],P1[9],     pw2[2]=PKW(P1,4), pw2[3]=PKW(P1,6), pw2); \
    VRD(3); SBAR(); GAPA(C0=__builtin_amdgcn_mfma_f32_32x32x16_bf16(kf[6],qr[3],C0,0,0,0),   P1[10],P1[11],P1[12],P1[13], pw3[0]=PKW(P1,8), pw3[1]=PKW(P1,10), pw3); \
    VRD(7); SBAR(); GAPA(C1=__builtin_amdgcn_mfma_f32_32x32x16_bf16(kf[7],qr[3],C1,0,0,0),   P1[14],P1[15],0.f,0.f,       pw3[2]=PKW(P1,12),pw3[3]=PKW(P1,14), pw3); \
    l_reg+=sacc; \
    if(GK){DMA_K((t)+3,sl_cur);} if(GV){DMA_V((t)+1,sl_next);} \
    CMASK(C0,C1,t); \
    { float a=MX3(C0[0],C0[1],C1[0]),b=MX3(C0[2],C0[3],C1[1]); a=MX3(a,C1[2],C1[3]); \
      _Pragma("unroll") for(int r=4;r<16;r+=4){a=MX3(a,C0[r],C0[r+1]);b=MX3(b,C0[r+2],C0[r+3]);a=MX3(a,C1[r],C1[r+1]);b=MX3(b,C1[r+2],C1[r+3]);} \
      float rm=__builtin_fmaxf(a,b); { auto rr=__builtin_amdgcn_permlane32_swap(__float_as_uint(rm),__float_as_uint(rm),false,false); rm=__builtin_fmaxf(__uint_as_float(rr[0]),__uint_as_float(rr[1])); } \
      resc=false; \
      if(__builtin_expect(__any(rm>(float)THRL),0)){ const float dl=__builtin_fmaxf(rm,0.f); mhat+=dl; \
        _Pragma("unroll") for(int r=0;r<16;++r){C0[r]-=dl;C1[r]-=dl;} \
        nb-=dl; \
        const float f=__builtin_amdgcn_exp2f(-dl); l_reg*=f; if(hi==0)wsf[r32]=f; resc=true; } } \
    SBAR(); \
    GAPB(o[0]=__builtin_amdgcn_mfma_f32_32x32x16_bf16(PAF(0),VFR(0),o[0],0,0,0), C0,0); \
    GAPB(o[1]=__builtin_amdgcn_mfma_f32_32x32x16_bf16(PAF(0),VFR(4),o[1],0,0,0), C0,4); \
    KRD(GL,0); GAPB(o[0]=__builtin_amdgcn_mfma_f32_32x32x16_bf16(PAF(1),VFR(1),o[0],0,0,0), C0,8); \
    KRD(GL,1); GAPB(o[1]=__builtin_amdgcn_mfma_f32_32x32x16_bf16(PAF(1),VFR(5),o[1],0,0,0), C0,12); \
    KRD(GL,2); GAPB(o[0]=__builtin_amdgcn_mfma_f32_32x32x16_bf16(PAF(2),VFR(2),o[0],0,0,0), C1,0); \
    KRD(GL,3); GAPB(o[1]=__builtin_amdgcn_mfma_f32_32x32x16_bf16(PAF(2),VFR(6),o[1],0,0,0), C1,4); \
    GAPB(o[0]=__builtin_amdgcn_mfma_f32_32x32x16_bf16(PAF(3),VFR(3),o[0],0,0,0), C1,8); \
    GAPB(o[1]=__builtin_amdgcn_mfma_f32_32x32x16_bf16(PAF(3),VFR(7),o[1],0,0,0), C1,12); \
    }while(0)
  int t=1;
  #undef CMASK
  #define CMASK(P0,P1,t) do{}while(0)
  for(;t+5<NT;t+=2){
    STEP(pB0,pB1,pA0,pA1,t,true,true,true);     WAIT_BAR(2); RESC(); ROT();
    STEP(pA0,pA1,pB0,pB1,t+1,true,true,true);   WAIT_BAR(2); RESC(); ROT();
  }
  #undef CMASK
  #define CMASK(P0,P1,t) do{int jb_=(t)-(NT-4); if(jb_>=0)cmask(P0,P1,jb_,qrel,hi);}while(0)
  #define ENDW(tt) do{ if((tt)+3<NT){WAIT_BAR(2);} else if((tt)+2<NT){WAIT_BAR(1);} else {WAIT_BAR(0);} }while(0)
  for(;t+1<NT;t+=2){
    STEP(pB0,pB1,pA0,pA1,t,(t+3<NT),(t+1<NT),(t+1<NT));       ENDW(t);   RESC(); ROT();
    STEP(pA0,pA1,pB0,pB1,t+1,(t+4<NT),(t+2<NT),(t+2<NT));     ENDW(t+1); RESC(); ROT();
  }
  STEP(pB0,pB1,pA0,pA1,NT-1,false,false,false); RESC();
  { float sacc=pB0[0]+pB0[1]; _Pragma("unroll") for(int r=2;r<16;++r)sacc+=pB0[r]; _Pragma("unroll") for(int r=0;r<16;++r)sacc+=pB1[r]; l_reg+=sacc;
    pw0=(u32x4){PKW(pB0,0),PKW(pB0,2),PKW(pB0,4),PKW(pB0,6)};pw1=(u32x4){PKW(pB0,8),PKW(pB0,10),PKW(pB0,12),PKW(pB0,14)};pw2=(u32x4){PKW(pB1,0),PKW(pB1,2),PKW(pB1,4),PKW(pB1,6)};pw3=(u32x4){PKW(pB1,8),PKW(pB1,10),PKW(pB1,12),PKW(pB1,14)};
    SBAR(); pv(o,vb0+sl_cur,PAF(0),PAF(1),PAF(2),PAF(3)); }
  #undef PKW
  #undef PAF
  #undef VFR
  #undef PIN
  #undef MX3
  #undef GAPA
  #undef GAPB
  #undef EX
  #undef VRD
  #undef KRD
  #undef STEP
  #undef ENDW
  {auto rr=__builtin_amdgcn_permlane32_swap(__float_as_uint(l_reg),__float_as_uint(l_reg),false,false);l_reg=__uint_as_float(rr[0])+__uint_as_float(rr[1]);}
  if(hi==0)wsf[32+r32]=l_reg;asm volatile("s_waitcnt lgkmcnt(0)":::"memory");
  float rli[16];
  #pragma unroll
  for(int r=0;r<16;++r)rli[r]=__builtin_amdgcn_rcpf(wsf[32+crow(r,hi)]);
  bf16*Ow=O+(rowbase+q0+wid*QBLK)*OPITCH+h*D;
  { bf16*stg=(bf16*)(shm+LDS_OST)+wid*2048;
    #pragma unroll
    for(int r=0;r<16;++r){const int orow=crow(r,hi);
      #pragma unroll
      for(int d0=0;d0<2;++d0)stg[orow*64+d0*32+r32]=__float2bfloat16(o[d0][r]*rli[r]);}
    asm volatile("s_waitcnt lgkmcnt(0)":::"memory");
    #pragma unroll
    for(int i=0;i<4;++i){const int row=i*8+(lane>>3),ch=lane&7; const u32x4 v=*(const u32x4*)(stg+row*64+ch*8); ATTN_STORE16(Ow+(long)row*OPITCH+ch*8,v);} }
  asm volatile("s_waitcnt lgkmcnt(0)\n\ts_barrier":::"memory");
  #undef DMA_K
  #undef DMA_V
  #undef CMASK
  #undef START
  #undef RESC
  #undef ROT
  #undef BINIT
}
constexpr int ATTN_LDS_BYTES=LDS_BYTES;
struct AttnTensors { const bf16* Q; const bf16* K; const bf16* V; bf16* O; const float* F; };
struct AttnUnit { int bh; int qb; };
struct StaticOrder {
  int vcu;
  __device__ __forceinline__ explicit StaticOrder(int v):vcu(v){}
  __device__ __forceinline__ bool next(int i,AttnUnit&u)const{ if(i>=8)return false; const int s=4*(vcu&1)+(i>>1); u.bh=vcu>>1; u.qb=(i&1)?15-s:s; return true; }
};
template<class Sched,int THRL=8> __device__ __forceinline__ void attn_phase(char*lds,const AttnTensors&T,const Sched&S){
  AttnUnit u;
  for(int i=0;S.next(i,u);++i){ attn_unit<THRL>(u.bh/NHEAD,u.bh%NHEAD,u.qb,T.Q,T.K,T.V,T.O,T.F+(size_t)u.bh*SEQ,lds); }
}
#undef SBAR
#undef WAIT_BAR
}
namespace mk {
typedef unsigned short bf16_t;
typedef short bf16x8 __attribute__((ext_vector_type(8)));
typedef float f32x4 __attribute__((ext_vector_type(4)));
typedef float f32x16 __attribute__((ext_vector_type(16)));
typedef unsigned u32x4 __attribute__((ext_vector_type(4)));
typedef unsigned u32x2 __attribute__((ext_vector_type(2)));

constexpr int DM = 1024, NPT = 65536, NST = 512, MT = NPT + NST, SEQ = 4096, DFF = 2816, PW = 3072, NINP = 3328;
constexpr float LOG2E = 1.4426950408889634f;
constexpr float C2 = 0.125f * LOG2E;
constexpr float ALPHA = 1.4142135623730951f;
constexpr size_t O_YP = 0, O_YS = O_YP + 67108864, O_PFK = O_YS + 524288, O_PFV = O_PFK + 67108864, O_PFL = O_PFV + 67108864,
    O_PMC = O_PFL + 1048576, O_PMN = O_PMC + 524288, O_PMM = O_PMN + 8192, O_SFK = O_PMM + 128, O_SFV = O_SFK + 524288,
    O_SFL = O_SFV + 524288, O_SMC = O_SFL + 8192, O_SMN = O_SMC + 524288, O_SMM = O_SMN + 8192, O_SGV = O_SMM + 128, O_END = O_SGV + 262144;
constexpr size_t MiB = 1u << 20;
constexpr size_t WS_MOD = 1 * MiB, WS_STATS = 3 * MiB, WS_GATES = 6 * MiB, WS_FQ = 11 * MiB, WS_AB = 13 * MiB, WS_MS = 13 * MiB + 65536, WS_NS = 14 * MiB,
    WS_WIN = 16 * MiB, WS_WO = 29 * MiB, WS_WGU = 33 * MiB, WS_WD = 55 * MiB, WS_GW = 66 * MiB, WS_HA = 67 * MiB, WS_PROJ = 196 * MiB,
    WS_R1 = 583 * MiB, WS_R2 = 712 * MiB, WS_UT = 841 * MiB, WS_CS = 906 * MiB, WS_END = 938 * MiB;
constexpr int LDS_BYTES = 155648;

struct Ctx {
    unsigned char* ws; float* out; const PG8_LAS unsigned long long* tab;
    __device__ __forceinline__ const float* in(int i) const { const unsigned long long v = tab[i]; const unsigned lo = __builtin_amdgcn_readfirstlane((unsigned)v), hi = __builtin_amdgcn_readfirstlane((unsigned)(v >> 32)); return (const float*)(((unsigned long long)hi << 32) | lo); }
    __device__ __forceinline__ const float* x_prompt() const { return in(0); }
    __device__ __forceinline__ const float* x_sample() const { return in(1); }
    __device__ __forceinline__ const float* cache_k() const { return in(2); }
    __device__ __forceinline__ const float* cache_v() const { return in(3); }
    __device__ __forceinline__ const float* cache_logf() const { return in(4); }
    __device__ __forceinline__ const float* st_C() const { return in(5); }
    __device__ __forceinline__ const float* st_n() const { return in(6); }
    __device__ __forceinline__ const float* st_m() const { return in(7); }
    __device__ __forceinline__ const float* c_prompt() const { return in(8); }
    __device__ __forceinline__ const float* c_sample() const { return in(9); }
    __device__ __forceinline__ const float* w_ada() const { return in(10); }
    __device__ __forceinline__ const float* b_ada() const { return in(11); }
    __device__ __forceinline__ const float* w_in() const { return in(12); }
    __device__ __forceinline__ const float* b_mi() const { return in(13); }
    __device__ __forceinline__ const float* b_mf() const { return in(14); }
    __device__ __forceinline__ const float* norm_g() const { return in(15); }
    __device__ __forceinline__ const float* b_ff() const { return in(16); }
    __device__ __forceinline__ const float* gln_g() const { return in(17); }
    __device__ __forceinline__ const float* gln_b() const { return in(18); }
    __device__ __forceinline__ const float* gws() const { return in(19); }
    __device__ __forceinline__ const float* gbs() const { return in(20); }
    __device__ __forceinline__ const float* w_o() const { return in(21); }
    __device__ __forceinline__ const float* ln1_g() const { return in(22); }
    __device__ __forceinline__ const float* ln1_b() const { return in(23); }
    __device__ __forceinline__ const float* w_gate() const { return in(24); }
    __device__ __forceinline__ const float* w_up() const { return in(25); }
    __device__ __forceinline__ const float* w_down() const { return in(26); }
    __device__ __forceinline__ const float* ln2_g() const { return in(27); }
    __device__ __forceinline__ const float* ln2_b() const { return in(28); }
    __device__ __forceinline__ float* MOD() const { return (float*)(ws + WS_MOD); }
    __device__ __forceinline__ float* STATS() const { return (float*)(ws + WS_STATS); }
    __device__ __forceinline__ float* GATES() const { return (float*)(ws + WS_GATES); }
    __device__ __forceinline__ float* FQ() const { return (float*)(ws + WS_FQ); }
    __device__ __forceinline__ float* AB() const { return (float*)(ws + WS_AB); }
    __device__ __forceinline__ float* MS() const { return (float*)(ws + WS_MS); }
    __device__ __forceinline__ float* NS() const { return (float*)(ws + WS_NS); }
    __device__ __forceinline__ float* UT() const { return (float*)(ws + WS_UT); }
    __device__ __forceinline__ bf16_t* WIN() const { return (bf16_t*)(ws + WS_WIN); }
    __device__ __forceinline__ bf16_t* WO() const { return (bf16_t*)(ws + WS_WO); }
    __device__ __forceinline__ bf16_t* WGU() const { return (bf16_t*)(ws + WS_WGU); }
    __device__ __forceinline__ bf16_t* WD() const { return (bf16_t*)(ws + WS_WD); }
    __device__ __forceinline__ bf16_t* GW() const { return (bf16_t*)(ws + WS_GW); }
    __device__ __forceinline__ bf16_t* HA() const { return (bf16_t*)(ws + WS_HA); }
    __device__ __forceinline__ bf16_t* PROJ() const { return (bf16_t*)(ws + WS_PROJ); }
    __device__ __forceinline__ bf16_t* R1() const { return (bf16_t*)(ws + WS_R1); }
    __device__ __forceinline__ bf16_t* R2() const { return (bf16_t*)(ws + WS_R2); }
    __device__ __forceinline__ bf16_t* CS() const { return (bf16_t*)(ws + WS_CS); }
};

__device__ __forceinline__ float bf2f(unsigned u16) { return __uint_as_float(u16 << 16); }
__device__ __forceinline__ unsigned pkbf(float lo, float hi) { unsigned r; asm("v_cvt_pk_bf16_f32 %0, %1, %2" : "=v"(r) : "v"(lo), "v"(hi)); return r; }
__device__ __forceinline__ float logsig(float x) { return fminf(x, 0.f) - __logf(1.f + __expf(-fabsf(x))); }
__device__ __forceinline__ float sigm(float x) { return 1.f / (1.f + __expf(-x)); }
__device__ __forceinline__ float wsum(float v) {
#pragma unroll
    for (int o = 32; o > 0; o >>= 1) v += __shfl_xor(v, o);
    return v;
}
__device__ __forceinline__ float wmax(float v) {
#pragma unroll
    for (int o = 32; o > 0; o >>= 1) v = fmaxf(v, __shfl_xor(v, o));
    return v;
}
__device__ __forceinline__ int row_cb(int row) { return row < NPT ? (row >> 12) : 16 + ((row - NPT) >> 5); }
__device__ __forceinline__ int crow(int r, int hi) { return (r & 3) + 8 * (r >> 2) + 4 * hi; }
__device__ __forceinline__ bf16x8 gather8(const bf16_t* p, int stride, int o4) {
    unsigned v[8];
#pragma unroll
    for (int j = 0; j < 4; ++j) { v[j] = p[j * stride]; v[4 + j] = p[(o4 + j) * stride]; }
    u32x4 w; w.x = v[0] | (v[1] << 16); w.y = v[2] | (v[3] << 16); w.z = v[4] | (v[5] << 16); w.w = v[6] | (v[7] << 16);
    return __builtin_bit_cast(bf16x8, w);
}
__device__ __forceinline__ void unpack8(const u32x4 w, float* f) {
    f[0] = bf2f(w.x & 0xffffu); f[1] = bf2f(w.x >> 16); f[2] = bf2f(w.y & 0xffffu); f[3] = bf2f(w.y >> 16);
    f[4] = bf2f(w.z & 0xffffu); f[5] = bf2f(w.z >> 16); f[6] = bf2f(w.w & 0xffffu); f[7] = bf2f(w.w >> 16);
}

__device__ __forceinline__ void tr_item(const float* W, int ldw, int srccol, bf16_t* WT, int K, int dst_row0, int k0, float* scr, int lane) {
#pragma unroll 8
    for (int i = 0; i < 32; ++i) { const int kk = 2 * i + (lane >> 5); scr[kk * 33 + (lane & 31)] = srccol >= 0 ? W[(size_t)(k0 + kk) * ldw + srccol] : 0.f; }
    asm volatile("s_waitcnt lgkmcnt(0)" ::: "memory");
    const int c = lane & 7;
#pragma unroll
    for (int j = 0; j < 4; ++j) { const int n = (lane >> 3) + 8 * j; const float* s = scr + (8 * c) * 33 + n;
        u32x4 o; o.x = pkbf(s[0 * 33], s[1 * 33]); o.y = pkbf(s[2 * 33], s[3 * 33]); o.z = pkbf(s[4 * 33], s[5 * 33]); o.w = pkbf(s[6 * 33], s[7 * 33]);
        *(u32x4*)(WT + (size_t)(dst_row0 + n) * K + k0 + 8 * c) = o; }
    asm volatile("s_waitcnt lgkmcnt(0)" ::: "memory");
}

__device__ __forceinline__ void p0a(const Ctx& C, unsigned char* smem) {
    const int tid = mk_tid(), lane = tid & 63, wid = tid >> 6;
    const int gtid = blockIdx.x * 512 + tid, GT = gridDim.x * 512;
    for (int i = gtid; i < 4 * MT * 2; i += GT) C.STATS()[i] = 0.f;
    for (int i = gtid; i < 2 * 4 * 128 * 128; i += GT) { const int t = (i >> 7) & 127, s = i & 127; C.GW()[i] = (bf16_t)(pkbf(s <= t ? C.gws()[i] : 0.f, 0.f) & 0xffffu); }
    float* sil = (float*)smem;
    for (int u = blockIdx.x; u < 192; u += gridDim.x) {
        __syncthreads();
        for (int i = tid; i < 32 * 1024; i += 512) { const int cb = i >> 10, k = i & 1023; const float c = cb < 16 ? C.c_prompt()[cb * 1024 + k] : C.c_sample()[(cb - 16) * 1024 + k]; sil[i] = c / (1.f + __expf(-c)); }
        __syncthreads();
        const int l = u / 96, n0 = (u % 96) * 64;
        float acc[32];
#pragma unroll
        for (int cb = 0; cb < 32; ++cb) acc[cb] = 0.f;
        const float* W = C.w_ada() + (size_t)l * 1024 * 6144 + n0 + lane;
        for (int k = wid * 128; k < wid * 128 + 128; k += 4) {
            const float w0 = W[(size_t)k * 6144], w1 = W[(size_t)(k + 1) * 6144], w2 = W[(size_t)(k + 2) * 6144], w3 = W[(size_t)(k + 3) * 6144];
#pragma unroll
            for (int cb = 0; cb < 32; ++cb) { const float4 s = *(const float4*)(sil + cb * 1024 + k); acc[cb] += s.x * w0 + s.y * w1 + s.z * w2 + s.w * w3; }
        }
        __syncthreads();
#pragma unroll
        for (int cb = 0; cb < 32; ++cb) sil[(wid * 32 + cb) * 64 + lane] = acc[cb];
        __syncthreads();
#pragma unroll
        for (int j = 0; j < 4; ++j) { const int o = tid + 512 * j, cb = o >> 6, ln = o & 63; float s = C.b_ada()[l * 6144 + n0 + ln];
#pragma unroll
            for (int w = 0; w < 8; ++w) s += sil[(w * 32 + cb) * 64 + ln];
            C.MOD()[(size_t)(l * 32 + cb) * 6144 + n0 + ln] = s; }
    }
    __syncthreads();
    float* scr = (float*)smem + wid * 2112;
    const int gw = blockIdx.x * 8 + wid, NGW = gridDim.x * 8;
    for (int it = gw; it < 12800; it += NGW) {
        const int l = it / 6400; int r = it % 6400;
        if (r < 1664) { const int kb = r / 104, nb = r % 104, p = nb * 32 + (lane & 31);
            const int sc = p < 1024 ? p : p < 2560 ? p + 8 : p < 3072 ? p + 16 : (p < 3080 ? p - 3072 + 1024 : (p < 3088 ? p - 3080 + 2568 : -1));
            tr_item(C.w_in() + (size_t)l * 1024 * 3088, 3088, sc, C.WIN() + (size_t)l * NINP * 1024, 1024, nb * 32, kb * 64, scr, lane); continue; }
        r -= 1664;
        if (r < 512) { const int kb = r / 32, nb = r % 32;
            tr_item(C.w_o() + (size_t)l * 1024 * 1024, 1024, nb * 32 + (lane & 31), C.WO() + (size_t)l * 1024 * 1024, 1024, nb * 32, kb * 64, scr, lane); continue; }
        r -= 512;
        if (r < 2816) { const int kb = r / 176, nb = r % 176, pn = nb >> 3, wi = nb & 7;
            const float* src = (wi < 4 ? C.w_gate() : C.w_up()) + (size_t)l * 1024 * DFF;
            tr_item(src, DFF, 128 * pn + 32 * (wi & 3) + (lane & 31), C.WGU() + (size_t)l * 5632 * 1024, 1024, nb * 32, kb * 64, scr, lane); continue; }
        r -= 2816;
        { const int kb = r / 32, nb = r % 32;
            tr_item(C.w_down() + (size_t)l * DFF * 1024, 1024, nb * 32 + (lane & 31), C.WD() + (size_t)l * 1024 * DFF, DFF, nb * 32, kb * 64, scr, lane); }
    }
}

__device__ __forceinline__ void p0b(const Ctx& C) {
    const int lane = mk_tid() & 63, wid = mk_tid() >> 6;
    const int gw = blockIdx.x * 8 + wid, NGW = gridDim.x * 8;
    for (int row = gw; row < MT; row += NGW) {
        const float* xr = row < NPT ? C.x_prompt() + (size_t)row * DM : C.x_sample() + (size_t)(row - NPT) * DM;
        const float* md = C.MOD() + (size_t)row_cb(row) * 6144;
#pragma unroll
        for (int j = 0; j < 4; ++j) { const int c = 256 * j + 4 * lane;
            const float4 x = *(const float4*)(xr + c), sh = *(const float4*)(md + c), sc = *(const float4*)(md + 1024 + c);
            u32x2 o; o.x = pkbf(x.x * (1.f + sc.x) + sh.x, x.y * (1.f + sc.y) + sh.y); o.y = pkbf(x.z * (1.f + sc.z) + sh.z, x.w * (1.f + sc.w) + sh.w);
            *(u32x2*)(C.HA() + (size_t)row * DM + c) = o; }
    }
}

__device__ __forceinline__ void ln_apply(const bf16_t* R, const float* stats, const float* g, const float* b, const float* mod_sh, const float* mod_sc,
                                         bf16_t* obf, float* of_p, float* of_s) {
    const int lane = mk_tid() & 63, wid = mk_tid() >> 6;
    const int gw = blockIdx.x * 8 + wid, NGW = gridDim.x * 8;
    for (int row = gw; row < MT; row += NGW) {
        const float s = stats[row * 2], ss = stats[row * 2 + 1];
        const float mean = s * (1.f / 1024.f), var = fmaxf(ss * (1.f / 1024.f) - mean * mean, 0.f), rstd = rsqrtf(var + 1e-5f);
        const int cb = row_cb(row);
#pragma unroll
        for (int j = 0; j < 4; ++j) { const int c = 256 * j + 4 * lane;
            const u32x2 rr = *(const u32x2*)(R + (size_t)row * DM + c);
            const float4 gg = *(const float4*)(g + c), bb = *(const float4*)(b + c);
            float4 x;
            x.x = (bf2f(rr.x & 0xffffu) - mean) * rstd * gg.x + bb.x; x.y = (bf2f(rr.x >> 16) - mean) * rstd * gg.y + bb.y;
            x.z = (bf2f(rr.y & 0xffffu) - mean) * rstd * gg.z + bb.z; x.w = (bf2f(rr.y >> 16) - mean) * rstd * gg.w + bb.w;
            if (of_p) { float* o = row < NPT ? of_p + (size_t)row * DM : of_s + (size_t)(row - NPT) * DM; *(float4*)(o + c) = x; }
            if (obf) { const float4 sh = *(const float4*)(mod_sh + (size_t)cb * 6144 + c), sc = *(const float4*)(mod_sc + (size_t)cb * 6144 + c);
                u32x2 o; o.x = pkbf(x.x * (1.f + sc.x) + sh.x, x.y * (1.f + sc.y) + sh.y); o.y = pkbf(x.z * (1.f + sc.z) + sh.z, x.w * (1.f + sc.w) + sh.w);
                *(u32x2*)(obf + (size_t)row * DM + c) = o; }
        }
    }
}

using pg8::Unit;
struct EpiInProj {
    static constexpr bool PERM = true, AFTER_DRAIN = false;
    bf16_t* proj; float* gates; float* out; int layer; const float *bi, *bf, *bff;
    __device__ __forceinline__ void operator()(const f32x4 (&acc)[2][2][4][2], const Unit& u, int wr, int wc, int fr, int fq) const {
        const int row0 = u.pm * 256 + wr * 64 + fr, pn = u.pn;
        if (pn < 12) {
            const float sc = (pn == 4 || pn == 5) ? C2 : (pn == 1 ? 0.125f : 1.f);
            const bool f32o = pn >= 6 && pn < 10;
            const int colf0 = ((pn - 6) & 1) * 256 + wc * 32 + 8 * fq;
#pragma unroll
            for (int ai = 0; ai < 2; ++ai)
#pragma unroll
                for (int m = 0; m < 4; ++m) { const int row = row0 + ai * 128 + m * 16;
                    bf16_t* rowp = proj + (size_t)row * PW + pn * 256 + wc * 32 + 8 * fq;
                    float* fo = nullptr;
                    if (f32o) { fo = row < NPT ? out + (pn < 8 ? O_PFK : O_PFV) + ((size_t)layer * NPT + row) * 512 : out + (pn < 8 ? O_SFK : O_SFV) + ((size_t)layer * NST + (row - NPT)) * 512; fo += colf0; }
#pragma unroll
                    for (int bj = 0; bj < 2; ++bj) { const f32x4 v0 = acc[ai][bj][m][0], v1 = acc[ai][bj][m][1];
                        u32x4 w; w.x = pkbf(v0[0] * sc, v0[1] * sc); w.y = pkbf(v0[2] * sc, v0[3] * sc); w.z = pkbf(v1[0] * sc, v1[1] * sc); w.w = pkbf(v1[2] * sc, v1[3] * sc);
                        *(u32x4*)(rowp + bj * 128) = w;
                        if (f32o) { *(f32x4*)(fo + bj * 128) = v0; *(f32x4*)(fo + bj * 128 + 4) = v1; } } }
        } else if (wc == 0 && fq < 2) {
#pragma unroll
            for (int ai = 0; ai < 2; ++ai)
#pragma unroll
                for (int m = 0; m < 4; ++m) { const int row = row0 + ai * 128 + m * 16;
                    const f32x4 v0 = acc[ai][0][m][0], v1 = acc[ai][0][m][1];
                    float* gp = gates + (size_t)row * 16;
                    if (fq == 0) {
                        f32x4 li, lf;
#pragma unroll
                        for (int j = 0; j < 4; ++j) { li[j] = v0[j] + bi[j]; lf[j] = logsig(v1[j] + bf[j]); }
                        *(f32x4*)gp = li; *(f32x4*)(gp + 4) = lf;
                    } else {
                        f32x4 a, b;
#pragma unroll
                        for (int j = 0; j < 4; ++j) { a[j] = logsig(v0[j] + bff[j]); b[j] = logsig(v1[j] + bff[4 + j]); }
                        *(f32x4*)(gp + 8) = a; *(f32x4*)(gp + 12) = b;
                        float* lo = row < NPT ? out + O_PFL + ((size_t)layer * NPT + row) * 8 : out + O_SFL + ((size_t)layer * NST + (row - NPT)) * 8;
                        *(f32x4*)lo = a; *(f32x4*)(lo + 4) = b;
                    } }
        }
    }
};
struct EpiSwiGLU {
    static constexpr bool PERM = true, AFTER_DRAIN = false;
    bf16_t* hid;
    __device__ __forceinline__ void operator()(const f32x4 (&acc)[2][2][4][2], const Unit& u, int wr, int wc, int fr, int fq) const {
        const int row0 = u.pm * 256 + wr * 64 + fr;
#pragma unroll
        for (int ai = 0; ai < 2; ++ai)
#pragma unroll
            for (int m = 0; m < 4; ++m) { const int row = row0 + ai * 128 + m * 16;
                float h[8];
#pragma unroll
                for (int n = 0; n < 2; ++n)
#pragma unroll
                    for (int j = 0; j < 4; ++j) { const float g = acc[ai][0][m][n][j], up = acc[ai][1][m][n][j]; h[4 * n + j] = g * up / (1.f + __expf(-g)); }
                u32x4 w; w.x = pkbf(h[0], h[1]); w.y = pkbf(h[2], h[3]); w.z = pkbf(h[4], h[5]); w.w = pkbf(h[6], h[7]);
                *(u32x4*)(hid + (size_t)row * DFF + u.pn * 128 + wc * 32 + 8 * fq) = w; }
    }
};
template <bool XN> struct EpiRes {
    static constexpr bool PERM = false, AFTER_DRAIN = false;
    const float *xp, *xs;
    const bf16_t* Rp; const float *Sp, *gp, *bp;
    const float* gate;
    bf16_t* R; float* stats;
    __device__ __forceinline__ void operator()(const f32x4 (&acc)[2][2][4][2], const Unit& u, int wr, int wc, int fr, int fq) const {
        const int col0 = u.pn * 256 + wc * 32 + 4 * fq;
#pragma unroll
        for (int ai = 0; ai < 2; ++ai)
#pragma unroll
            for (int m = 0; m < 4; ++m) { const int row = u.pm * 256 + ai * 128 + wr * 64 + m * 16 + fr; const int cb = row_cb(row);
                float mean = 0.f, rstd = 0.f;
                if (XN) { const float s = Sp[row * 2], ss = Sp[row * 2 + 1]; mean = s * (1.f / 1024.f); rstd = rsqrtf(fmaxf(ss * (1.f / 1024.f) - mean * mean, 0.f) + 1e-5f); }
                const float* xr = XN ? nullptr : (row < NPT ? xp + (size_t)row * DM : xs + (size_t)(row - NPT) * DM);
                float ps = 0.f, pss = 0.f;
#pragma unroll
                for (int bj = 0; bj < 2; ++bj)
#pragma unroll
                    for (int n = 0; n < 2; ++n) { const int c = col0 + bj * 128 + n * 16;
                        f32x4 x;
                        if (XN) { const u32x2 rr = *(const u32x2*)(Rp + (size_t)row * DM + c); const f32x4 gg = *(const f32x4*)(gp + c), bb = *(const f32x4*)(bp + c);
                            x[0] = (bf2f(rr.x & 0xffffu) - mean) * rstd * gg[0] + bb[0]; x[1] = (bf2f(rr.x >> 16) - mean) * rstd * gg[1] + bb[1];
                            x[2] = (bf2f(rr.y & 0xffffu) - mean) * rstd * gg[2] + bb[2]; x[3] = (bf2f(rr.y >> 16) - mean) * rstd * gg[3] + bb[3];
                        } else x = *(const f32x4*)(xr + c);
                        const f32x4 gt = *(const f32x4*)(gate + (size_t)cb * 6144 + c);
                        const f32x4 a = acc[ai][bj][m][n];
                        f32x4 r;
#pragma unroll
                        for (int j = 0; j < 4; ++j) { r[j] = ALPHA * x[j] + (1.f + gt[j]) * a[j]; ps += r[j]; pss += r[j] * r[j]; }
                        u32x2 w; w.x = pkbf(r[0], r[1]); w.y = pkbf(r[2], r[3]);
                        *(u32x2*)(R + (size_t)row * DM + c) = w; }
                ps += __shfl_xor(ps, 16); ps += __shfl_xor(ps, 32); pss += __shfl_xor(pss, 16); pss += __shfl_xor(pss, 32);
                if (fq == 0) { atomicAdd(stats + row * 2, ps); atomicAdd(stats + row * 2 + 1, pss); } }
    }
};
__device__ __forceinline__ void fcum_unit(const Ctx& C, int b, unsigned char* smem) {
    const int tid = mk_tid();
    float* tot = (float*)smem;
    float pre[8][8];
    const float* gp = C.GATES() + ((size_t)b * SEQ + tid * 8) * 16 + 8;
    float run[8];
#pragma unroll
    for (int h = 0; h < 8; ++h) run[h] = 0.f;
#pragma unroll
    for (int j = 0; j < 8; ++j) { const float4 a = *(const float4*)(gp + j * 16), c = *(const float4*)(gp + j * 16 + 4);
        run[0] += a.x; run[1] += a.y; run[2] += a.z; run[3] += a.w; run[4] += c.x; run[5] += c.y; run[6] += c.z; run[7] += c.w;
#pragma unroll
        for (int h = 0; h < 8; ++h) pre[j][h] = run[h]; }
    __syncthreads();
#pragma unroll
    for (int h = 0; h < 8; ++h) tot[tid * 8 + h] = run[h];
    __syncthreads();
    int cur = 0;
    for (int d = 1; d < 512; d <<= 1) {
        float v[8];
#pragma unroll
        for (int h = 0; h < 8; ++h) { v[h] = tot[cur * 4096 + tid * 8 + h]; if (tid >= d) v[h] += tot[cur * 4096 + (tid - d) * 8 + h]; }
#pragma unroll
        for (int h = 0; h < 8; ++h) tot[(cur ^ 1) * 4096 + tid * 8 + h] = v[h];
        cur ^= 1;
        __syncthreads();
    }
#pragma unroll
    for (int h = 0; h < 8; ++h) { const float off = tid > 0 ? tot[cur * 4096 + (tid - 1) * 8 + h] : 0.f;
        float* o = C.FQ() + ((size_t)(b * 8 + h)) * SEQ + tid * 8;
        float4 a, c; a.x = (off + pre[0][h]) * LOG2E; a.y = (off + pre[1][h]) * LOG2E; a.z = (off + pre[2][h]) * LOG2E; a.w = (off + pre[3][h]) * LOG2E;
        c.x = (off + pre[4][h]) * LOG2E; c.y = (off + pre[5][h]) * LOG2E; c.z = (off + pre[6][h]) * LOG2E; c.w = (off + pre[7][h]) * LOG2E;
        *(float4*)o = a; *(float4*)(o + 4) = c; }
    __syncthreads();
}

constexpr int M1_PAIRB = 18944, TP = 72;
__device__ __forceinline__ void m1_quad(const Ctx& C, int quad, unsigned char* smem) {
    const int tid = mk_tid(), lane = tid & 63, wid = tid >> 6, p = wid >> 1, sub = wid & 1, r32 = lane & 31, hi = lane >> 5;
    const int gc = quad * 4 + p, bh = gc >> 6, c = gc & 63, b = bh >> 2, h = bh & 3;
    const int row0 = b * SEQ + c * 64;
    unsigned char* base = smem + p * M1_PAIRB;
    bf16_t* Kt = (bf16_t*)base; bf16_t* Vt = (bf16_t*)(base + 9216); float* wt = (float*)(base + 18432);
    if (sub == 0) {
        const float lf = C.GATES()[(size_t)(row0 + lane) * 16 + 4 + h], li = C.GATES()[(size_t)(row0 + lane) * 16 + h];
        float B = lf;
#pragma unroll
        for (int o = 1; o < 64; o <<= 1) { const float t = __shfl_up(B, o); if (lane >= o) B += t; }
        const float g = li - B, G = wmax(g), a = __shfl(B, 63);
        wt[lane] = __expf(g - G);
        if (lane == 0) { C.AB()[gc * 2] = a; C.AB()[gc * 2 + 1] = a + G; }
    }
    __syncthreads();
    const int tp = tid & 127;
#pragma unroll
    for (int j = 0; j < 4; ++j) { const int id = tp + 128 * j, s = id & 63, d8 = (id >> 6) * 8;
        const u32x4 kk = *(const u32x4*)(C.PROJ() + (size_t)(row0 + s) * PW + 256 + h * 64 + d8);
        const u32x4 vv = *(const u32x4*)(C.PROJ() + (size_t)(row0 + s) * PW + 512 + h * 64 + d8);
        float f[8]; unpack8(kk, f); const float w = wt[s];
        u32x4 kw; kw.x = pkbf(f[0] * w, f[1] * w); kw.y = pkbf(f[2] * w, f[3] * w); kw.z = pkbf(f[4] * w, f[5] * w); kw.w = pkbf(f[6] * w, f[7] * w);
        *(u32x4*)(Kt + s * TP + d8) = kw; *(u32x4*)(Vt + s * TP + d8) = vv; }
    __syncthreads();
    f32x16 acc[2]; acc[0] = f32x16{}; acc[1] = f32x16{};
#pragma unroll
    for (int ks = 0; ks < 4; ++ks) {
        const bf16x8 a = gather8(Kt + (16 * ks + 8 * hi) * TP + 32 * sub + r32, TP, 4);
#pragma unroll
        for (int bj = 0; bj < 2; ++bj) { const bf16x8 bb = gather8(Vt + (16 * ks + 8 * hi) * TP + 32 * bj + r32, TP, 4);
            acc[bj] = __builtin_amdgcn_mfma_f32_32x32x16_bf16(a, bb, acc[bj], 0, 0, 0); }
    }
    float* U = C.UT() + (size_t)gc * 4160;
#pragma unroll
    for (int bj = 0; bj < 2; ++bj)
#pragma unroll
        for (int a4 = 0; a4 < 4; ++a4) { f32x4 v; v[0] = acc[bj][4 * a4]; v[1] = acc[bj][4 * a4 + 1]; v[2] = acc[bj][4 * a4 + 2]; v[3] = acc[bj][4 * a4 + 3];
            *(f32x4*)(U + (32 * bj + r32) * 64 + 32 * sub + 8 * a4 + 4 * hi) = v; }
    { float su = 0.f;
#pragma unroll 8
        for (int s = 0; s < 32; ++s) su += bf2f(Kt[(32 * hi + s) * TP + 32 * sub + r32]);
        su += __shfl_xor(su, 32);
        if (hi == 0) U[4096 + 32 * sub + r32] = su; }
    __syncthreads();
}

__device__ __forceinline__ void scan_phase(const Ctx& C, int l) {
    const int gtid = blockIdx.x * 512 + mk_tid(), GT = gridDim.x * 512;
    for (int idx = gtid; idx < 64 * 4160; idx += GT) {
        const int bh = idx / 4160, e = idx % 4160;
        float s = 0.f, m = -INFINITY;
        const float* U = C.UT() + (size_t)bh * 64 * 4160 + e; const float* ab = C.AB() + bh * 128;
#pragma unroll 4
        for (int c = 0; c < 64; ++c) { const int gc = bh * 64 + c;
            if (e < 4096) C.CS()[(size_t)gc * 4096 + e] = (bf16_t)(pkbf(s, 0.f) & 0xffffu); else C.NS()[gc * 64 + e - 4096] = s;
            if (e == 0) C.MS()[gc] = m;
            const float a = ab[2 * c], b = ab[2 * c + 1], u = U[(size_t)c * 4160];
            const float mn = fmaxf(m + a, b);
            s = __expf(m + a - mn) * s + __expf(b - mn) * u; m = mn; }
        const int b_ = bh >> 2, h = bh & 3;
        if (e < 4096) { const int dv = e >> 6, dk = e & 63; C.out[O_PMC + ((size_t)((l * 16 + b_) * 4 + h)) * 4096 + dk * 64 + dv] = s; }
        else C.out[O_PMN + ((l * 16 + b_) * 4 + h) * 64 + e - 4096] = s;
        if (e == 0) C.out[O_PMM + (l * 16 + b_) * 4 + h] = m;
    }
}

constexpr int M3_PAIRB = 27136;
__device__ __forceinline__ void m3_quad(const Ctx& C, int l, int quad, unsigned char* smem) {
    const int tid = mk_tid(), lane = tid & 63, wid = tid >> 6, p = wid >> 1, tb = wid & 1, r32 = lane & 31, hi = lane >> 5;
    const int gc = quad * 4 + p, bh = gc >> 6, c = gc & 63, b = bh >> 2, h = bh & 3;
    const int row0 = b * SEQ + c * 64;
    unsigned char* base = smem + p * M3_PAIRB;
    bf16_t* Vt = (bf16_t*)base; float* tg = (float*)(base + 9216); float* tmu = tg + 64; float* te = tg + 128; float* tmt = tg + 192; float* tn0 = tg + 256;
    float* Hs = (float*)(base + 9216 + 1280) + tb * 2080;
    if (tb == 0) {
        const float lf = C.GATES()[(size_t)(row0 + lane) * 16 + 4 + h], li = C.GATES()[(size_t)(row0 + lane) * 16 + h];
        float B = lf;
#pragma unroll
        for (int o = 1; o < 64; o <<= 1) { const float t = __shfl_up(B, o); if (lane >= o) B += t; }
        const float g = li - B; float G = g;
#pragma unroll
        for (int o = 1; o < 64; o <<= 1) { const float t = __shfl_up(G, o); if (lane >= o) G = fmaxf(G, t); }
        const float m0 = C.MS()[gc], mu = fmaxf(m0, G);
        tg[lane] = g; tmu[lane] = mu; te[lane] = __expf(m0 - mu); tmt[lane] = B + mu; tn0[lane] = C.NS()[gc * 64 + lane];
    }
    { const int tp = tid & 127;
#pragma unroll
        for (int j = 0; j < 4; ++j) { const int id = tp + 128 * j, s = id & 63, d8 = (id >> 6) * 8;
            *(u32x4*)(Vt + s * TP + d8) = *(const u32x4*)(C.PROJ() + (size_t)(row0 + s) * PW + 512 + h * 64 + d8); } }
    __syncthreads();
    const int t = 32 * tb + r32;
    bf16x8 qf[4];
#pragma unroll
    for (int ds = 0; ds < 4; ++ds) qf[ds] = *(const bf16x8*)(C.PROJ() + (size_t)(row0 + t) * PW + h * 64 + 16 * ds + 8 * hi);
    f32x16 st[2]; st[0] = f32x16{}; st[1] = f32x16{};
#pragma unroll
    for (int sb = 0; sb < 2; ++sb) if (sb <= tb) {
#pragma unroll
        for (int ds = 0; ds < 4; ++ds) { const bf16x8 kf = *(const bf16x8*)(C.PROJ() + (size_t)(row0 + 32 * sb + r32) * PW + 256 + h * 64 + 16 * ds + 8 * hi);
            st[sb] = __builtin_amdgcn_mfma_f32_32x32x16_bf16(kf, qf[ds], st[sb], 0, 0, 0); } }
    const float mu_t = tmu[t], e_t = te[t];
    float den = 0.f;
#pragma unroll
    for (int sb = 0; sb < 2; ++sb) if (sb <= tb) {
#pragma unroll
        for (int r = 0; r < 16; ++r) { const int s = 32 * sb + crow(r, hi); const float w = (s <= t) ? __expf(tg[s] - mu_t) : 0.f; st[sb][r] *= w; den += st[sb][r]; } }
    den += __shfl_xor(den, 32);
    f32x16 acc[2]; acc[0] = f32x16{}; acc[1] = f32x16{};
#pragma unroll
    for (int sb = 0; sb < 2; ++sb) if (sb <= tb) {
#pragma unroll
        for (int kk = 0; kk < 2; ++kk) { u32x4 pw; pw.x = pkbf(st[sb][8 * kk], st[sb][8 * kk + 1]); pw.y = pkbf(st[sb][8 * kk + 2], st[sb][8 * kk + 3]);
            pw.z = pkbf(st[sb][8 * kk + 4], st[sb][8 * kk + 5]); pw.w = pkbf(st[sb][8 * kk + 6], st[sb][8 * kk + 7]);
            const bf16x8 pa = __builtin_bit_cast(bf16x8, pw);
#pragma unroll
            for (int bj = 0; bj < 2; ++bj) { const bf16x8 vb = gather8(Vt + (32 * sb + 16 * kk + 4 * hi) * TP + 32 * bj + r32, TP, 8);
                acc[bj] = __builtin_amdgcn_mfma_f32_32x32x16_bf16(pa, vb, acc[bj], 0, 0, 0); } } }
    float qn = 0.f;
#pragma unroll
    for (int ds = 0; ds < 4; ++ds) { float f[8]; unpack8(__builtin_bit_cast(u32x4, qf[ds]), f);
#pragma unroll
        for (int j = 0; j < 8; ++j) qn += f[j] * tn0[16 * ds + 8 * hi + j];
        u32x4 qs; qs.x = pkbf(f[0] * e_t, f[1] * e_t); qs.y = pkbf(f[2] * e_t, f[3] * e_t); qs.z = pkbf(f[4] * e_t, f[5] * e_t); qs.w = pkbf(f[6] * e_t, f[7] * e_t);
        const bf16x8 qa = __builtin_bit_cast(bf16x8, qs);
#pragma unroll
        for (int bj = 0; bj < 2; ++bj) { const bf16x8 cb = *(const bf16x8*)(C.CS() + (size_t)gc * 4096 + (32 * bj + r32) * 64 + 16 * ds + 8 * hi);
            acc[bj] = __builtin_amdgcn_mfma_f32_32x32x16_bf16(qa, cb, acc[bj], 0, 0, 0); } }
    qn += __shfl_xor(qn, 32);
    den += e_t * qn;
    const float rden = 1.f / fmaxf(fabsf(den), __expf(-tmt[t]));
#pragma unroll
    for (int bj = 0; bj < 2; ++bj)
#pragma unroll
        for (int r = 0; r < 16; ++r) Hs[crow(r, hi) * 65 + 32 * bj + r32] = acc[bj][r];
    asm volatile("s_waitcnt lgkmcnt(0)" ::: "memory");
    float hv[32]; float s1 = 0.f;
#pragma unroll
    for (int j = 0; j < 32; ++j) { hv[j] = Hs[r32 * 65 + 32 * hi + j] * rden; s1 += hv[j]; }
    s1 += __shfl_xor(s1, 32);
    const float mean = s1 * (1.f / 64.f); float s2 = 0.f;
#pragma unroll
    for (int j = 0; j < 32; ++j) { hv[j] -= mean; s2 += hv[j] * hv[j]; }
    s2 += __shfl_xor(s2, 32);
    const float rstd = rsqrtf(s2 * (1.f / 64.f) + 1e-6f);
    const size_t row = (size_t)row0 + t;
    const float* ng = C.norm_g() + l * 256 + h * 64 + 32 * hi;
#pragma unroll
    for (int j8 = 0; j8 < 4; ++j8) { float mo[8]; unpack8(*(const u32x4*)(C.PROJ() + row * PW + 768 + h * 64 + 32 * hi + 8 * j8), mo);
        float o[8];
#pragma unroll
        for (int j = 0; j < 8; ++j) o[j] = hv[8 * j8 + j] * rstd * ng[8 * j8 + j] * sigm(mo[j]);
        u32x4 w; w.x = pkbf(o[0], o[1]); w.y = pkbf(o[2], o[3]); w.z = pkbf(o[4], o[5]); w.w = pkbf(o[6], o[7]);
        *(u32x4*)(C.HA() + row * DM + h * 64 + 32 * hi + 8 * j8) = w; }
    __syncthreads();
}

constexpr int GP = 264;
__device__ __forceinline__ void gmlp_unit(const Ctx& C, int l, int unit, unsigned char* smem) {
    const int tid = mk_tid(), lane = tid & 63, wid = tid >> 6, r32 = lane & 31, hi = lane >> 5;
    const int row0 = unit * 128;
    bf16_t* vn = (bf16_t*)smem;
    const float4 lg = *(const float4*)(C.gln_g() + l * 256 + 4 * lane), lb = *(const float4*)(C.gln_b() + l * 256 + 4 * lane);
    for (int i = 0; i < 16; ++i) { const int s = wid * 16 + i;
        const u32x2 rr = *(const u32x2*)(C.PROJ() + (size_t)(row0 + s) * PW + 2816 + 4 * lane);
        float v0 = bf2f(rr.x & 0xffffu), v1 = bf2f(rr.x >> 16), v2 = bf2f(rr.y & 0xffffu), v3 = bf2f(rr.y >> 16);
        const float mean = wsum((v0 + v1) + (v2 + v3)) * (1.f / 256.f);
        v0 -= mean; v1 -= mean; v2 -= mean; v3 -= mean;
        const float rstd = rsqrtf(wsum((v0 * v0 + v1 * v1) + (v2 * v2 + v3 * v3)) * (1.f / 256.f) + 1e-5f);
        u32x2 o; o.x = pkbf(v0 * rstd * lg.x + lb.x, v1 * rstd * lg.y + lb.y); o.y = pkbf(v2 * rstd * lg.z + lb.z, v3 * rstd * lg.w + lb.w);
        *(u32x2*)(vn + s * GP + 4 * lane) = o; }
    __syncthreads();
    const int g = wid >> 1, th = wid & 1;
    const bf16_t* W = C.GW() + (size_t)(l * 4 + g) * 128 * 128;
    f32x16 acc[2][2];
#pragma unroll
    for (int i = 0; i < 2; ++i) { acc[i][0] = f32x16{}; acc[i][1] = f32x16{}; }
#pragma unroll
    for (int ks = 0; ks < 8; ++ks) {
        bf16x8 bfr[2];
        if (ks < 4 * th + 4) {
#pragma unroll
            for (int cbk = 0; cbk < 2; ++cbk) bfr[cbk] = gather8(vn + (16 * ks + 8 * hi) * GP + g * 64 + 32 * cbk + r32, GP, 4);
#pragma unroll
            for (int i = 0; i < 2; ++i) { const int tbk = 2 * th + i;
                if (ks < 2 * tbk + 2) { const bf16x8 a = *(const bf16x8*)(W + (32 * tbk + r32) * 128 + 16 * ks + 8 * hi);
                    acc[i][0] = __builtin_amdgcn_mfma_f32_32x32x16_bf16(a, bfr[0], acc[i][0], 0, 0, 0);
                    acc[i][1] = __builtin_amdgcn_mfma_f32_32x32x16_bf16(a, bfr[1], acc[i][1], 0, 0, 0); } }
        }
    }
    const float* bs = C.gbs() + (size_t)(l * 4 + g) * 128;
#pragma unroll
    for (int i = 0; i < 2; ++i)
#pragma unroll
        for (int cbk = 0; cbk < 2; ++cbk)
#pragma unroll
            for (int r = 0; r < 16; ++r) { const int t = 32 * (2 * th + i) + crow(r, hi), cc = g * 64 + 32 * cbk + r32;
                const float gu = bf2f(C.PROJ()[(size_t)(row0 + t) * PW + 2560 + cc]);
                C.HA()[(size_t)(row0 + t) * DM + 768 + cc] = (bf16_t)(pkbf(gu * (acc[i][cbk][r] + bs[t]), 0.f) & 0xffffu); }
    __syncthreads();
}

__device__ __forceinline__ void gmlp_sample_unit(const Ctx& C, int l, int bs_, unsigned char* smem) {
    const int tid = mk_tid(), lane = tid & 63, wid = tid >> 6;
    float* vn = (float*)smem;
    const int row0 = NPT + bs_ * 32;
    const float4 lg = *(const float4*)(C.gln_g() + l * 256 + 4 * lane), lb = *(const float4*)(C.gln_b() + l * 256 + 4 * lane);
    for (int i = 0; i < 4; ++i) { const int s = wid * 4 + i;
        const u32x2 rr = *(const u32x2*)(C.PROJ() + (size_t)(row0 + s) * PW + 2816 + 4 * lane);
        float v0 = bf2f(rr.x & 0xffffu), v1 = bf2f(rr.x >> 16), v2 = bf2f(rr.y & 0xffffu), v3 = bf2f(rr.y >> 16);
        const float mean = wsum((v0 + v1) + (v2 + v3)) * (1.f / 256.f);
        v0 -= mean; v1 -= mean; v2 -= mean; v3 -= mean;
        const float rstd = rsqrtf(wsum((v0 * v0 + v1 * v1) + (v2 * v2 + v3 * v3)) * (1.f / 256.f) + 1e-5f);
        float4 o; o.x = v0 * rstd * lg.x + lb.x; o.y = v1 * rstd * lg.y + lb.y; o.z = v2 * rstd * lg.z + lb.z; o.w = v3 * rstd * lg.w + lb.w;
        vn[s * 257 + 4 * lane] = o.x; vn[s * 257 + 4 * lane + 1] = o.y; vn[s * 257 + 4 * lane + 2] = o.z; vn[s * 257 + 4 * lane + 3] = o.w;
        *(float4*)(C.out + O_SGV + ((size_t)(l * 16 + bs_) * 32 + s) * 256 + 4 * lane) = o; }
    __syncthreads();
    for (int j = 0; j < 16; ++j) { const int o = tid + 512 * j, t = o >> 8, cc = o & 255, g = cc >> 6;
        const float* w = C.gws() + ((size_t)(l * 4 + g) * 128 + t) * 128;
        float z = C.gbs()[(l * 4 + g) * 128 + t];
        for (int s = 0; s <= t; ++s) z += w[s] * vn[s * 257 + cc];
        const float gu = bf2f(C.PROJ()[(size_t)(row0 + t) * PW + 2560 + cc]);
        C.HA()[(size_t)(row0 + t) * DM + 768 + cc] = (bf16_t)(pkbf(gu * z, 0.f) & 0xffffu); }
    __syncthreads();
}

__device__ __forceinline__ void mlstm_sample_unit(const Ctx& C, int l, int unit, unsigned char* smem) {
    const int tid = mk_tid(), bs_ = unit >> 2, h = unit & 3;
    const int row0 = NPT + bs_ * 32;
    float* q = (float*)smem; float* k = q + 32 * 65; float* v = k + 32 * 65; float* P = v + 32 * 65;
    float* Hh = P + 32 * 33;
    float* tB = Hh + 32 * 65; float* tg = tB + 32; float* tmu = tg + 32; float* te = tmu + 32; float* tmt = te + 32; float* trd = tmt + 32; float* tmean = trd + 32; float* trs = tmean + 32; float* tw = trs + 32;
    const size_t sidx = (size_t)(l * 16 + bs_) * 4 + h;
    int zo = 0; asm volatile("" : "+v"(zo));
    const float* C0 = C.st_C() + sidx * 4096; const float* n0 = C.st_n() + sidx * 64; const float m0 = C.st_m()[sidx];
    for (int i = tid; i < 32 * 64; i += 512) { const int t = i >> 6, d = i & 63; const bf16_t* pr = C.PROJ() + (size_t)(row0 + t) * PW + h * 64 + d;
        q[t * 65 + d] = bf2f(pr[0]); k[t * 65 + d] = bf2f(pr[256]); v[t * 65 + d] = bf2f(pr[512]); }
    if (tid == 0) { float B = 0.f, G = -INFINITY;
        for (int t = 0; t < 32; ++t) { const float lf = C.GATES()[(size_t)(row0 + t) * 16 + 4 + h], li = C.GATES()[(size_t)(row0 + t) * 16 + h];
            B += lf; const float g = li - B; G = fmaxf(G, g); const float mu = fmaxf(m0, G);
            tB[t] = B; tg[t] = g; tmu[t] = mu; te[t] = __expf(m0 - mu); tmt[t] = B + mu; }
        const float mend = B + fmaxf(m0, G);
        for (int s = 0; s < 32; ++s) tw[s] = __expf(B + tg[s] - mend);
        tw[32] = __expf(m0 + B - mend); tw[33] = mend; }
    __syncthreads();
    for (int j = 0; j < 2; ++j) { const int t = tid >> 4, s = (tid & 15) + 16 * j; float d = 0.f;
        if (s <= t) { for (int e = 0; e < 64; ++e) d += q[t * 65 + e] * k[s * 65 + e]; d *= __expf(tg[s] - tmu[t]); }
        P[t * 33 + s] = d; }
    __syncthreads();
    if (tid < 32) { const int t = tid; float den = 0.f, qn = 0.f;
        for (int s = 0; s < 32; ++s) den += P[t * 33 + s];
        for (int e = 0; e < 64; ++e) qn += q[t * 65 + e] * n0[e + zo];
        den += te[t] * qn; trd[t] = 1.f / fmaxf(fabsf(den), __expf(-tmt[t])); }
    __syncthreads();
    { const int t = tid >> 4, d4 = (tid & 15) * 4; float a0 = 0.f, a1 = 0.f, a2 = 0.f, a3 = 0.f, c0 = 0.f, c1 = 0.f, c2 = 0.f, c3 = 0.f;
        for (int s = 0; s < 32; ++s) { const float p = P[t * 33 + s]; a0 += p * v[s * 65 + d4]; a1 += p * v[s * 65 + d4 + 1]; a2 += p * v[s * 65 + d4 + 2]; a3 += p * v[s * 65 + d4 + 3]; }
        for (int e = 0; e < 64; ++e) { const float qq = q[t * 65 + e]; const float4 cc = *(const float4*)(C0 + e * 64 + d4); c0 += qq * cc.x; c1 += qq * cc.y; c2 += qq * cc.z; c3 += qq * cc.w; }
        const float et = te[t], rd = trd[t];
        Hh[t * 65 + d4] = (a0 + et * c0) * rd; Hh[t * 65 + d4 + 1] = (a1 + et * c1) * rd; Hh[t * 65 + d4 + 2] = (a2 + et * c2) * rd; Hh[t * 65 + d4 + 3] = (a3 + et * c3) * rd; }
    __syncthreads();
    if (tid < 32) { float s1 = 0.f; for (int e = 0; e < 64; ++e) s1 += Hh[tid * 65 + e]; const float mean = s1 * (1.f / 64.f); float s2 = 0.f;
        for (int e = 0; e < 64; ++e) { const float d = Hh[tid * 65 + e] - mean; s2 += d * d; }
        tmean[tid] = mean; trs[tid] = rsqrtf(s2 * (1.f / 64.f) + 1e-6f); }
    __syncthreads();
    { const int t = tid >> 4, d4 = (tid & 15) * 4; const size_t row = (size_t)row0 + t; float o[4];
#pragma unroll
        for (int j = 0; j < 4; ++j) { const float mo = bf2f(C.PROJ()[row * PW + 768 + h * 64 + d4 + j]);
            o[j] = (Hh[t * 65 + d4 + j] - tmean[t]) * trs[t] * C.norm_g()[l * 256 + h * 64 + d4 + j] * sigm(mo); }
        u32x2 w; w.x = pkbf(o[0], o[1]); w.y = pkbf(o[2], o[3]); *(u32x2*)(C.HA() + row * DM + h * 64 + d4) = w; }
    { const int dk = tid >> 3, dv8 = (tid & 7) * 8; const float d0 = tw[32]; float a[8];
#pragma unroll
        for (int j = 0; j < 8; ++j) a[j] = d0 * C0[dk * 64 + dv8 + j];
        for (int s = 0; s < 32; ++s) { const float wk = tw[s + zo] * k[s * 65 + dk];
#pragma unroll
            for (int j = 0; j < 8; ++j) a[j] += wk * v[s * 65 + dv8 + j]; }
        float* o = C.out + O_SMC + sidx * 4096 + dk * 64 + dv8;
#pragma unroll
        for (int j = 0; j < 8; ++j) o[j] = a[j]; }
    if (tid < 64) { float a = tw[32] * n0[tid]; for (int s = 0; s < 32; ++s) a += tw[s + zo] * k[s * 65 + tid]; C.out[O_SMN + sidx * 64 + tid] = a; }
    if (tid == 0) C.out[O_SMM + sidx] = tw[33];
    __syncthreads();
}

__device__ __forceinline__ void fox_sample_unit(const Ctx& C, int l, int unit, unsigned char* smem) {
    const int tid = mk_tid(), lane = tid & 63, wid = tid >> 6, bs_ = unit >> 3, h = unit & 7;
    constexpr int NS_ = 1056, SP = 1057;
    float* S = (float*)smem; float* F = S + 32 * SP; float* q = F + 1088;
    const int row0 = NPT + bs_ * 32;
    const size_t cbase = (size_t)(l * 16 + bs_);
    int zo = 0; asm volatile("" : "+v"(zo));
    if (wid == 0) {
        float v[17]; float tot = 0.f;
#pragma unroll
        for (int j = 0; j < 17; ++j) { const int s = lane * 17 + j; float x = 0.f;
            if (s < 1024) x = C.cache_logf()[(cbase * 1024 + s) * 8 + h]; else if (s < NS_) x = C.GATES()[(size_t)(row0 + s - 1024) * 16 + 8 + h];
            tot += x; v[j] = tot; }
        float inc = tot;
#pragma unroll
        for (int o = 1; o < 64; o <<= 1) { const float t = __shfl_up(inc, o); if (lane >= o) inc += t; }
        const float off = inc - tot;
#pragma unroll
        for (int j = 0; j < 17; ++j) { const int s = lane * 17 + j; if (s < NS_) F[s] = (off + v[j]) * LOG2E; }
    }
    for (int i = tid; i < 32 * 64; i += 512) { const int t = i >> 6, d = i & 63; q[i] = bf2f(C.PROJ()[(size_t)(row0 + t) * PW + 1024 + h * 64 + d]); }
    __syncthreads();
    for (int s = tid; s < NS_; s += 512) {
        const float* kp = s < 1024 ? C.cache_k() + ((cbase * 1024 + s) * 8 + h) * 64 : C.out + O_SFK + ((cbase * 32 + (s - 1024)) * 8 + h) * 64;
        float4 kr[16];
#pragma unroll
        for (int j = 0; j < 16; ++j) kr[j] = *(const float4*)(kp + 4 * j);
        const float fs = F[s];
#pragma unroll 2
        for (int t = 0; t < 32; ++t) { float d = 0.f;
#pragma unroll
            for (int j = 0; j < 16; ++j) { const float4 qq = *(const float4*)(q + t * 64 + 4 * j + zo); d += qq.x * kr[j].x + qq.y * kr[j].y + qq.z * kr[j].z + qq.w * kr[j].w; }
            S[t * SP + s] = (s <= 1024 + t) ? d + F[1024 + t + zo] - fs : -INFINITY; }
    }
    __syncthreads();
    for (int i = 0; i < 4; ++i) { const int t = wid * 4 + i; float m = -INFINITY;
        for (int s = lane; s < NS_; s += 64) m = fmaxf(m, S[t * SP + s]);
        m = wmax(m); float sum = 0.f;
        for (int s = lane; s < NS_; s += 64) { const float e = exp2f(S[t * SP + s] - m); S[t * SP + s] = e; sum += e; }
        sum = wsum(sum); const float inv = 1.f / sum;
        for (int s = lane; s < NS_; s += 64) S[t * SP + s] *= inv; }
    __syncthreads();
    { const int t = tid >> 4, c4 = (tid & 15) * 4; float4 a; a.x = a.y = a.z = a.w = 0.f;
        const float* vc = C.cache_v() + (cbase * 1024 * 8 + h) * 64 + c4;
#pragma unroll 8
        for (int s = 0; s < 1024; ++s) { const float p = S[t * SP + s]; const float4 vv = *(const float4*)(vc + (size_t)s * 512); a.x += p * vv.x; a.y += p * vv.y; a.z += p * vv.z; a.w += p * vv.w; }
        const float* vn_ = C.out + O_SFV + (cbase * 32 * 8 + h) * 64 + c4;
#pragma unroll 8
        for (int s = 0; s < 32; ++s) { const float p = S[t * SP + 1024 + s]; const float4 vv = *(const float4*)(vn_ + (size_t)s * 512); a.x += p * vv.x; a.y += p * vv.y; a.z += p * vv.z; a.w += p * vv.w; }
        u32x2 w; w.x = pkbf(a.x, a.y); w.y = pkbf(a.z, a.w);
        *(u32x2*)(C.HA() + (size_t)(row0 + t) * DM + 256 + h * 64 + c4) = w; }
    __syncthreads();
}
struct Args { const float* in[29]; float* out; unsigned char* ws; int ph_lo, ph_hi; };
constexpr int N_PHASES = 20;
#ifndef MK_ONLY
#define MK_ONLY -1
#endif
#define PH(k) (MK_ONLY < 0 || MK_ONLY == (k))
#ifndef MK_SUB
#define MK_SUB -1
#endif
#define SUB(j) (MK_SUB < 0 || MK_SUB == (j))

template <class Epi> __device__ __forceinline__ void run_gemm(int G, int bx, unsigned char* smem, const bf16_t* A, const bf16_t* Bt, int N, int K, const Epi& E) {
    pg8::Gemm g{A, Bt, MT, N, K}; pg8::StaticOrder S; S.init(MT, N, G, bx);
    pg8::gemm_phase<Epi, pg8::StaticOrder, true, true>((PG8_LAS unsigned char*)smem, g, S, E);
}

__global__ void __launch_bounds__(512, 2) mk_fwd(Args args) {
    extern __shared__ __attribute__((aligned(16))) unsigned char smem[];
    cg::grid_group grid = cg::this_grid();
    Ctx C; C.tab = (const PG8_LAS unsigned long long*)(smem + LDS_BYTES - 256);
    if (mk_tid() == 0) { PG8_LAS unsigned long long* tw = (PG8_LAS unsigned long long*)(smem + LDS_BYTES - 256);
#pragma unroll
        for (int i = 0; i < 29; ++i) tw[i] = (unsigned long long)args.in[i]; }
    __syncthreads();

    for (int ph = args.ph_lo; ph < args.ph_hi; ++ph) {
        { unsigned char* w_ = args.ws; float* o_ = args.out; asm volatile("" : "+s"(w_), "+s"(o_)); C.ws = w_; C.out = o_; }
        int G = (int)gridDim.x, bx = (int)blockIdx.x; asm volatile("" : "+s"(G), "+s"(bx));
        if (ph == 0) { if constexpr (PH(100)) p0a(C, smem); }
        else if (ph == 1) { if constexpr (PH(101)) p0b(C); }
        else {
            const int l = (ph - 2) / 9, k = (ph - 2) % 9;
            const float* mod = C.MOD() + (size_t)l * 32 * 6144;
            float* st1 = C.STATS() + (size_t)(l * 2) * MT * 2; float* st2 = C.STATS() + (size_t)(l * 2 + 1) * MT * 2;
            if (k == 0) { if constexpr (PH(0)) {
                EpiInProj E{C.PROJ(), C.GATES(), C.out, l, C.b_mi() + l * 4, C.b_mf() + l * 4, C.b_ff() + l * 8};
                run_gemm(G, bx, smem, C.HA(), C.WIN() + (size_t)l * NINP * 1024, NINP, 1024, E);
            } } else if (k == 1) { if constexpr (PH(1)) {
                if constexpr (SUB(0)) for (int q = bx; q < 1024; q += G) m1_quad(C, q, smem);
                if constexpr (SUB(1)) for (int u = bx; u < 512; u += G) gmlp_unit(C, l, u, smem);
                if constexpr (SUB(2)) for (int u = bx; u < 16; u += G) fcum_unit(C, u, smem);
                if constexpr (SUB(3)) for (int u = (bx + G - (16 % G)) % G; u < 64; u += G) mlstm_sample_unit(C, l, u, smem);
                if constexpr (SUB(4)) for (int u = (bx + G - (80 % G)) % G; u < 16; u += G) gmlp_sample_unit(C, l, u, smem);
            } } else if (k == 2) { if constexpr (PH(2)) {
                scan_phase(C, l);
            } } else if (k == 3) { if constexpr (PH(3)) {
                const attn_body::AttnTensors AT{(const attn_body::bf16*)(C.PROJ() + 1024), (const attn_body::bf16*)(C.PROJ() + 1536), (const attn_body::bf16*)(C.PROJ() + 2048), (attn_body::bf16*)(C.HA() + 256), C.FQ()};
                const int vcu0 = (G % 8 == 0) ? (bx % 8) * (G / 8) + bx / 8 : bx;
                if constexpr (SUB(0)) for (int v = vcu0; v < 256; v += G) { const attn_body::StaticOrder S(v); attn_body::attn_phase<attn_body::StaticOrder>((char*)smem, AT, S); }
                __syncthreads();
                if constexpr (SUB(1)) for (int q = bx; q < 1024; q += G) m3_quad(C, l, q, smem);
                if constexpr (SUB(2)) for (int u = G - 1 - bx; u < 128; u += G) fox_sample_unit(C, l, u, smem);
            } } else if (k == 4) { if constexpr (PH(4)) {
                if (l == 0) { EpiRes<false> E{C.x_prompt(), C.x_sample(), nullptr, nullptr, nullptr, nullptr, mod + 2048, C.R1(), st1};
                    run_gemm(G, bx, smem, C.HA(), C.WO() + (size_t)l * 1024 * 1024, 1024, 1024, E); }
                else { EpiRes<true> E{nullptr, nullptr, C.R2(), C.STATS() + (size_t)((l - 1) * 2 + 1) * MT * 2, C.ln2_g() + (l - 1) * 1024, C.ln2_b() + (l - 1) * 1024, mod + 2048, C.R1(), st1};
                    run_gemm(G, bx, smem, C.HA(), C.WO() + (size_t)l * 1024 * 1024, 1024, 1024, E); }
            } } else if (k == 5) { if constexpr (PH(5)) {
                ln_apply(C.R1(), st1, C.ln1_g() + l * 1024, C.ln1_b() + l * 1024, mod + 3072, mod + 4096, C.HA(), nullptr, nullptr);
            } } else if (k == 6) { if constexpr (PH(6)) {
                EpiSwiGLU E{C.PROJ()};
                run_gemm(G, bx, smem, C.HA(), C.WGU() + (size_t)l * 5632 * 1024, 5632, 1024, E);
            } } else if (k == 7) { if constexpr (PH(7)) {
                EpiRes<true> E{nullptr, nullptr, C.R1(), st1, C.ln1_g() + l * 1024, C.ln1_b() + l * 1024, mod + 5120, C.R2(), st2};
                run_gemm(G, bx, smem, C.PROJ(), C.WD() + (size_t)l * 1024 * DFF, 1024, DFF, E);
            } } else { if constexpr (PH(8)) {
                if (l == 0) ln_apply(C.R2(), st2, C.ln2_g(), C.ln2_b(), mod + 32 * 6144, mod + 32 * 6144 + 1024, C.HA(), nullptr, nullptr);
                else ln_apply(C.R2(), st2, C.ln2_g() + 1024, C.ln2_b() + 1024, nullptr, nullptr, nullptr, C.out + O_YP, C.out + O_YS);
            } }
        }
        if (ph + 1 < args.ph_hi) grid.sync();
    }
}
}

#ifndef MK_NLAUNCH
#define MK_NLAUNCH 1
#endif
extern "C" void kernel_launch(void* const* d_in, const int* in_sizes, int n_in, void* d_out, int out_size, void* d_ws, size_t ws_size, hipStream_t stream) {
    static int grid = 0;
    if (grid == 0) {
        if (n_in != 29 || (size_t)out_size != mk::O_END || ws_size < mk::WS_END) { fprintf(stderr, "kernel_launch: unexpected shapes: n_in %d out %d ws %zu (need %zu)\n", n_in, out_size, ws_size, (size_t)mk::WS_END); grid = -1; return; }
        int dev = 0, cus = 0, per_cu = 0;
        (void)hipGetDevice(&dev); (void)hipDeviceGetAttribute(&cus, hipDeviceAttributeMultiprocessorCount, dev);
        if (hipFuncSetAttribute((const void*)mk::mk_fwd, hipFuncAttributeMaxDynamicSharedMemorySize, mk::LDS_BYTES) != hipSuccess) { fprintf(stderr, "kernel_launch: hipFuncSetAttribute failed\n"); grid = -1; return; }
        if (hipOccupancyMaxActiveBlocksPerMultiprocessor(&per_cu, (const void*)mk::mk_fwd, 512, mk::LDS_BYTES) != hipSuccess || per_cu < 1) { fprintf(stderr, "kernel_launch: occupancy query failed (%d)\n", per_cu); per_cu = 1; (void)hipGetLastError(); }
        grid = cus * (per_cu > 1 ? 1 : per_cu);
        if (grid <= 0) grid = 256;
    }
    if (grid < 0) return;
    mk::Args a{};
    for (int i = 0; i < 29; ++i) a.in[i] = (const float*)d_in[i];
    a.out = (float*)d_out; a.ws = (unsigned char*)d_ws;
    for (int li = 0; li < MK_NLAUNCH; ++li) {
        a.ph_lo = (MK_NLAUNCH == 1) ? 0 : li * mk::N_PHASES / MK_NLAUNCH; a.ph_hi = (MK_NLAUNCH == 1) ? mk::N_PHASES : (li + 1) * mk::N_PHASES / MK_NLAUNCH;
        void* kargs[] = {&a};
        const hipError_t e = hipLaunchCooperativeKernel((const void*)mk::mk_fwd, dim3(grid), dim3(512), kargs, mk::LDS_BYTES, stream);
        if (e != hipSuccess) { fprintf(stderr, "kernel_launch: cooperative launch failed: %s (grid %d)\n", hipGetErrorString(e), grid); break; }
    }
}
```

```cpp
#include <hip/hip_runtime.h>
#include <hip/hip_bf16.h>
#include <hip/hip_cooperative_groups.h>
#include <cstdio>
#include <cstdint>
#include <cmath>
namespace cg = cooperative_groups;
__device__ __forceinline__ int mk_tid() { int t = threadIdx.x; asm volatile("" : "+v"(t)); return t; }
namespace pg8 {
#define PG8_LAS __attribute__((address_space(3)))
typedef unsigned short bf16_t;
typedef short bf16x8 __attribute__((ext_vector_type(8)));
typedef float f32x4 __attribute__((ext_vector_type(4)));
typedef unsigned u32x4 __attribute__((ext_vector_type(4)));
constexpr int BM = 256, BK = 64, HALF = 128, HTB = HALF * BK * 2  , STAGE_BYTES = 8 * HTB, NXCD = 8, WGM = 8;

__host__ __device__ __forceinline__ int lds_byte(int r, int c) { const int st = (r >> 4) * 2 + (c >> 5), rr = r & 15, cc = c & 31, ob = rr * 64 + cc * 2; return st * 1024 + (ob ^ (((ob >> 9) & 1) << 5)); }
__host__ __device__ __forceinline__ void stage_rc(int b, int& R, int& C) { const int st = b / 1024, sb = b % 1024, swz = sb ^ (((sb >> 9) & 1) << 5); R = (st >> 1) * 16 + swz / 64; C = (st & 1) * 32 + (swz % 64) / 2; }
__host__ __device__ __forceinline__ int perm32(int rho) { const int n = rho >> 4, i = rho & 15; return 8 * (i >> 2) + 4 * n + (i & 3); }

struct Unit { int pm, pn; };
struct Gemm { const bf16_t* A; const bf16_t* Bt; int M, N, K; };

struct StaticOrder {
    int nM, nN, nwg, G, c;
    __host__ __device__ void init(int M, int N, int G_, int c_) { nM = M / BM; nN = N / BM; nwg = nM * nN; G = G_; c = c_; }
    __host__ __device__ bool next(int i, Unit& u) const {
        const long L = (long)i * G + c; if (L >= nwg) return false;
        int wgid = (int)L; { const int q = nwg / NXCD, r = nwg % NXCD, xcd = wgid % NXCD, off = wgid / NXCD; wgid = (xcd < r ? xcd * (q + 1) : r * (q + 1) + (xcd - r) * q) + off; }
        const int nig = WGM * nN, gid = wgid / nig, fm = gid * WGM, gsz = (nM - fm) < WGM ? (nM - fm) : WGM;
        u.pm = fm + ((wgid % nig) % gsz); u.pn = (wgid % nig) / gsz; return true;
    }
    __device__ __forceinline__ void a_ready(const Unit&) const {}
    __device__ __forceinline__ void done(const Unit&) const {}
};

__device__ __forceinline__ unsigned cvt_pk_bf16(float lo, float hi) { unsigned r; asm volatile("v_cvt_pk_bf16_f32 %0, %1, %2" : "=v"(r) : "v"(lo), "v"(hi)); return r; }
typedef float f32x2 __attribute__((ext_vector_type(2)));
__device__ __forceinline__ f32x2 gelu_pk(f32x2 v) {
    const f32x2 av = __builtin_elementwise_abs(v), d = av * 0.2316418882f + 1.0f;
    f32x2 t; t.x = __builtin_amdgcn_rcpf(d.x); t.y = __builtin_amdgcn_rcpf(d.y);
    f32x2 q = t * 0.5307027145f + (-0.7265760135f); q = q * t + 0.7107068705f; q = q * t + (-0.142248368f); q = q * t + 0.127414796f; q = q * t;
    const f32x2 s = (v * v) * (-0.72134752044f);
    f32x2 e; e.x = __builtin_amdgcn_exp2f(s.x); e.y = __builtin_amdgcn_exp2f(s.y);
    const f32x2 m = v * (q * e), r = v - m;
    f32x2 o; o.x = v.x < 0.f ? m.x : r.x; o.y = v.y < 0.f ? m.y : r.y; return o;
}

template <int ACT  > struct EpiBf16 {
    static constexpr bool PERM = true, AFTER_DRAIN = false; static_assert(ACT == 0 || ACT == 1, "EpiBf16: ACT is 0 (none) or 1 (gelu_pk)");
    bf16_t* O; int ldc; const float* bias; int split_cols; size_t split_stride; float scale0;
    __device__ __forceinline__ void operator()(const f32x4 (&acc)[2][2][4][2], const Unit& u, int wr, int wc, int fr, int fq) const {
        const int row0 = u.pm * BM + wr * 64 + fr; int colt = u.pn * BM; bf16_t* base = O;
        float sc = 1.f; if (split_cols) { const int t = colt / split_cols; base += (size_t)t * split_stride; colt -= t * split_cols; if (t == 0) sc = scale0; }
        const int col0 = colt + wc * 32 + 8 * fq, bcol0 = u.pn * BM + wc * 32 + 8 * fq;
        f32x4 bv[2][2];
#pragma unroll
        for (int bj = 0; bj < 2; ++bj)
#pragma unroll
            for (int n = 0; n < 2; ++n) bv[bj][n] = bias ? *(const f32x4*)(bias + bcol0 + bj * HALF + 4 * n) : (f32x4){0.f, 0.f, 0.f, 0.f};
#pragma unroll
        for (int ai = 0; ai < 2; ++ai)
#pragma unroll
            for (int m = 0; m < 4; ++m) { bf16_t* rowp = base + (size_t)(row0 + ai * HALF + m * 16) * ldc + col0;
#pragma unroll
                for (int bj = 0; bj < 2; ++bj) { f32x4 v0 = acc[ai][bj][m][0] + bv[bj][0], v1 = acc[ai][bj][m][1] + bv[bj][1];
                    if (ACT == 1) { f32x2 a = gelu_pk((f32x2){v0[0], v0[1]}), b = gelu_pk((f32x2){v0[2], v0[3]}), c = gelu_pk((f32x2){v1[0], v1[1]}), d = gelu_pk((f32x2){v1[2], v1[3]});
                        v0 = (f32x4){a.x, a.y, b.x, b.y}; v1 = (f32x4){c.x, c.y, d.x, d.y}; }
                    v0 = v0 * sc; v1 = v1 * sc; u32x4 w; w.x = cvt_pk_bf16(v0[0], v0[1]); w.y = cvt_pk_bf16(v0[2], v0[3]); w.z = cvt_pk_bf16(v1[0], v1[1]); w.w = cvt_pk_bf16(v1[2], v1[3]);
                    *(u32x4*)(rowp + bj * HALF) = w; } }
    }
};

struct PanelStats {
    unsigned* xbuf;
    unsigned* cnt;
    unsigned* tmo;
    int ntn; float eps;
    unsigned code;
    __device__ __forceinline__ bool run(const f32x4 (&v)[2][2][4][2], const Unit& u, int wr, int wc, int fr, int fq, PG8_LAS unsigned char* lds, int wid, int lane) const {
        typedef float f32x2v __attribute__((ext_vector_type(2)));
        PG8_LAS f32x2v* P = (PG8_LAS f32x2v*)lds;
        PG8_LAS f32x2v* S = (PG8_LAS f32x2v*)(lds + 8192);
        PG8_LAS unsigned* flag = (PG8_LAS unsigned*)(lds + 8192 + 2048);
#pragma unroll
        for (int ai = 0; ai < 2; ++ai)
#pragma unroll
            for (int m = 0; m < 4; ++m) {
                float s = 0.f;
#pragma unroll
                for (int bj = 0; bj < 2; ++bj)
#pragma unroll
                    for (int n = 0; n < 2; ++n) { const f32x4 x = v[ai][bj][m][n]; s += (x[0] + x[1]) + (x[2] + x[3]); }
                s += __shfl_xor(s, 16); s += __shfl_xor(s, 32);
                const float mw = s * (1.0f / 64.0f); float q = 0.f;
#pragma unroll
                for (int bj = 0; bj < 2; ++bj)
#pragma unroll
                    for (int n = 0; n < 2; ++n) { const f32x4 d = v[ai][bj][m][n] - mw; q += (d[0] * d[0] + d[1] * d[1]) + (d[2] * d[2] + d[3] * d[3]); }
                q += __shfl_xor(q, 16); q += __shfl_xor(q, 32);
                if (fq == 0) P[(ai * HALF + wr * 64 + m * 16 + fr) * 4 + wc] = (f32x2v){mw, q};
            }
        asm volatile("s_waitcnt lgkmcnt(0)" ::: "memory"); __builtin_amdgcn_s_barrier(); asm volatile("" ::: "memory");
#if defined(BROKEN_EXCHANGE_NO_WAIT)
#warning BROKEN CONTROL BUILD: the row-statistics exchange does not wait; results are wrong by design
        if (blockIdx.x >= 64) { const long long t0_ = clock64(); while (clock64() - t0_ < 60000) __builtin_amdgcn_s_sleep(8); }
#endif
        const int row = wid * 32 + (lane & 31);
        if (lane < 32) {
            const f32x2v a = P[row * 4 + 0], b = P[row * 4 + 1], c = P[row * 4 + 2], d = P[row * 4 + 3];
            const float mt = (a.x + b.x + c.x + d.x) * 0.25f;
            const float da = a.x - mt, db = b.x - mt, dc = c.x - mt, dd = d.x - mt;
            const float m2 = (a.y + b.y) + (c.y + d.y) + 64.0f * ((da * da + db * db) + (dc * dc + dd * dd));
            unsigned long long* slot = (unsigned long long*)xbuf + ((size_t)(u.pm * BM + row) * 4 + u.pn);
            __hip_atomic_store(slot, ((unsigned long long)__float_as_uint(m2) << 32) | __float_as_uint(mt), __ATOMIC_RELAXED, __HIP_MEMORY_SCOPE_AGENT);
        }
        asm volatile("s_waitcnt vmcnt(0)" ::: "memory");
        if (lane == 0) __hip_atomic_fetch_add(cnt + 64 * u.pm, 1u, __ATOMIC_RELAXED, __HIP_MEMORY_SCOPE_AGENT);
        if (wid == 0) {
            bool dead = false; const unsigned long long t0 = __builtin_amdgcn_s_memrealtime(); const unsigned want = 8u * (unsigned)ntn;
            for (;;) {
#if defined(BROKEN_EXCHANGE_NO_WAIT)
                break;
#endif
                if ((unsigned)__builtin_amdgcn_readfirstlane(__hip_atomic_load(cnt + 64 * u.pm, __ATOMIC_RELAXED, __HIP_MEMORY_SCOPE_AGENT)) >= want) break;
                if (__builtin_amdgcn_s_memrealtime() - t0 > 2000000ull) {
                    if (lane == 0) { unsigned expect = 0u; __hip_atomic_compare_exchange_strong(tmo + 1, &expect, code | (unsigned)(u.pm & 0xff), __ATOMIC_RELAXED, __ATOMIC_RELAXED, __HIP_MEMORY_SCOPE_AGENT);
                                     __hip_atomic_store(tmo, 1u, __ATOMIC_RELAXED, __HIP_MEMORY_SCOPE_AGENT); }
                    dead = true; break; }
                __builtin_amdgcn_s_sleep(2);
            }
            __builtin_amdgcn_fence(__ATOMIC_ACQUIRE, "agent");
            if (lane == 0) flag[0] = dead ? 1u : 0u;
        }
        asm volatile("s_waitcnt vmcnt(0) lgkmcnt(0)" ::: "memory"); __builtin_amdgcn_s_barrier(); asm volatile("" ::: "memory");
        const bool bad = flag[0] != 0u;
        if (lane < 32) {
            const unsigned long long* slot = (const unsigned long long*)xbuf + (size_t)(u.pm * BM + row) * 4; float mt[4], m2[4]; float ms = 0.f;
#pragma unroll
            for (int t = 0; t < 4; ++t) { if (t < ntn) { const unsigned long long w = __hip_atomic_load(slot + t, __ATOMIC_RELAXED, __HIP_MEMORY_SCOPE_AGENT); mt[t] = __uint_as_float((unsigned)w); m2[t] = __uint_as_float((unsigned)(w >> 32)); } else { mt[t] = 0.f; m2[t] = 0.f; } ms += mt[t]; }
            const float mean = ms / (float)ntn; float q = 0.f;
#pragma unroll
            for (int t = 0; t < 4; ++t) if (t < ntn) { const float dm = mt[t] - mean; q += m2[t] + 256.0f * dm * dm; }
            S[row] = (f32x2v){mean, 1.0f / sqrtf(q / (256.0f * (float)ntn) + eps)};
        }
        asm volatile("s_waitcnt lgkmcnt(0)" ::: "memory"); __builtin_amdgcn_s_barrier(); asm volatile("" ::: "memory");
        return bad;
    }
};
struct EpiLnRes {
    static constexpr bool PERM = false, AFTER_DRAIN = true;
    const float* base; float* out; int ldc; const float* bias; PanelStats st; unsigned poison;
    __device__ __forceinline__ void fused(f32x4 (&acc)[2][2][4][2], const Unit& u, int wr, int wc, int fr, int fq, PG8_LAS unsigned char* lds, int wid, int lane) const {
        typedef float f32x2v __attribute__((ext_vector_type(2)));
        const PG8_LAS f32x2v* S = (const PG8_LAS f32x2v*)(lds + 8192);
        const int col0 = u.pn * BM + wc * 32 + 4 * fq;
#pragma unroll
        for (int bj = 0; bj < 2; ++bj)
#pragma unroll
            for (int n = 0; n < 2; ++n) { const f32x4 bv = bias ? *(const f32x4*)(bias + col0 + bj * HALF + n * 16) : (f32x4){0.f, 0.f, 0.f, 0.f};
#pragma unroll
                for (int ai = 0; ai < 2; ++ai)
#pragma unroll
                    for (int m = 0; m < 4; ++m) acc[ai][bj][m][n] += bv; }
        f32x4 pre[4][2][2];
#pragma unroll
        for (int m = 0; m < 4; ++m) { const size_t off = (size_t)(u.pm * BM + wr * 64 + m * 16 + fr) * ldc + col0;
#pragma unroll
            for (int bj = 0; bj < 2; ++bj)
#pragma unroll
                for (int n = 0; n < 2; ++n) pre[m][bj][n] = *(const f32x4*)(base + off + bj * HALF + n * 16); }
        const bool bad = st.run(acc, u, wr, wc, fr, fq, lds, wid, lane) || poison != 0u;
        const float qnan = __builtin_nanf("");
#pragma unroll
        for (int ai = 0; ai < 2; ++ai)
#pragma unroll
            for (int m = 0; m < 4; ++m) { const int r = ai * HALF + wr * 64 + m * 16 + fr; const f32x2v sr = S[r]; const size_t off = (size_t)(u.pm * BM + r) * ldc + col0;
#pragma unroll
                for (int bj = 0; bj < 2; ++bj)
#pragma unroll
                    for (int n = 0; n < 2; ++n) { const f32x4 bs = ai == 0 ? pre[m][bj][n] : *(const f32x4*)(base + off + bj * HALF + n * 16); f32x4 o = bs + (acc[ai][bj][m][n] - sr.x) * sr.y;
                        if (bad) o = (f32x4){qnan, qnan, qnan, qnan}; *(f32x4*)(out + off + bj * HALF + n * 16) = o; }
                if (m & 1) asm volatile("" ::: "memory"); }
    }
};
struct EpiLnResLn {
    static constexpr bool PERM = false, AFTER_DRAIN = true;
    const float* base; float* out; bf16_t* xn; int ldc; const float* bias; PanelStats st1, st2; unsigned poison;
    __device__ __forceinline__ void fused(f32x4 (&acc)[2][2][4][2], const Unit& u, int wr, int wc, int fr, int fq, PG8_LAS unsigned char* lds, int wid, int lane) const {
        typedef float f32x2v __attribute__((ext_vector_type(2))); typedef unsigned u32x2v __attribute__((ext_vector_type(2)));
        const PG8_LAS f32x2v* S = (const PG8_LAS f32x2v*)(lds + 8192);
        const int col0 = u.pn * BM + wc * 32 + 4 * fq;
#pragma unroll
        for (int bj = 0; bj < 2; ++bj)
#pragma unroll
            for (int n = 0; n < 2; ++n) { const f32x4 bv = bias ? *(const f32x4*)(bias + col0 + bj * HALF + n * 16) : (f32x4){0.f, 0.f, 0.f, 0.f};
#pragma unroll
                for (int ai = 0; ai < 2; ++ai)
#pragma unroll
                    for (int m = 0; m < 4; ++m) acc[ai][bj][m][n] += bv; }
        bool bad = st1.run(acc, u, wr, wc, fr, fq, lds, wid, lane) || poison != 0u;
        const float qnan = __builtin_nanf("");
#pragma unroll
        for (int ai = 0; ai < 2; ++ai)
#pragma unroll
            for (int m = 0; m < 4; ++m) { const int r = ai * HALF + wr * 64 + m * 16 + fr; const f32x2v sr = S[r]; const size_t off = (size_t)(u.pm * BM + r) * ldc + col0;
#pragma unroll
                for (int bj = 0; bj < 2; ++bj)
#pragma unroll
                    for (int n = 0; n < 2; ++n) { const f32x4 bs = *(const f32x4*)(base + off + bj * HALF + n * 16); acc[ai][bj][m][n] = bs + (acc[ai][bj][m][n] - sr.x) * sr.y; }
                asm volatile("" : "+v"(acc[ai][0][m][0]), "+v"(acc[ai][0][m][1]), "+v"(acc[ai][1][m][0]), "+v"(acc[ai][1][m][1]));
                if (m & 1) asm volatile("" ::: "memory"); }
        const bool bad1 = bad;
        bad = st2.run(acc, u, wr, wc, fr, fq, lds, wid, lane) || bad;
#pragma unroll
        for (int ai = 0; ai < 2; ++ai)
#pragma unroll
            for (int m = 0; m < 4; ++m) { const int r = ai * HALF + wr * 64 + m * 16 + fr; const f32x2v sr = S[r]; const size_t off = (size_t)(u.pm * BM + r) * ldc + col0;
#pragma unroll
                for (int bj = 0; bj < 2; ++bj)
#pragma unroll
                    for (int n = 0; n < 2; ++n) { const f32x4 x1 = acc[ai][bj][m][n]; *(f32x4*)(out + off + bj * HALF + n * 16) = bad1 ? (f32x4){qnan, qnan, qnan, qnan} : x1;
                        const f32x4 o = (x1 - sr.x) * sr.y; u32x2v w; w.x = cvt_pk_bf16(o[0], o[1]); w.y = cvt_pk_bf16(o[2], o[3]);
                        if (bad) { w.x = 0x7fc07fc0u; w.y = 0x7fc07fc0u; } *(u32x2v*)(xn + off + bj * HALF + n * 16) = w; }
                asm volatile("" ::: "memory"); }
    }
};

template <class Epi, class Sched, bool ALIGN_EPI = false, bool SP2 = false>
__device__ __forceinline__ void gemm_phase(PG8_LAS unsigned char* lds, const Gemm g, const Sched& S, const Epi& E) {
    const int tid = mk_tid(), wid = __builtin_amdgcn_readfirstlane(tid >> 6), lane = tid & 63, wr = wid >> 2, wc = wid & 3, fr = lane & 15, fq = lane >> 4;
    const int K = g.K, nt = K / BK;
    unsigned voffA[2], voffB[2];
#pragma unroll
    for (int i = 0; i < 2; ++i) { int R, C; stage_rc(tid * 16 + i * 8192, R, C); const int Rb = Epi::PERM ? ((R & ~31) + perm32(R & 31)) : R;
        voffA[i] = (unsigned)(R * K + C) * 2u; voffB[i] = (unsigned)(Rb * K + C) * 2u; }
    const size_t kstep = (size_t)(BK * 2);
    const size_t hstep = (size_t)HALF * K * 2;
    const size_t tstep = 2 * hstep;
    const unsigned ldsw = (unsigned)wid * 1024u;
    const int aoff = lds_byte(wr * 64 + fr, fq * 8), boff = lds_byte(wc * 32 + fr, fq * 8);
#define PG8_SA(b, h) (((b) * 2 + (h)) * HTB)
#define PG8_SB(b, h) ((4 + (b) * 2 + (h)) * HTB)
#define PG8_STAGE(bufoff, gbase, voff) do { _Pragma("unroll") for (int _i = 0; _i < 2; ++_i) \
        __builtin_amdgcn_global_load_lds((const unsigned*)((const char*)(gbase) + (voff)[_i]), (PG8_LAS unsigned*)(lds + (bufoff) + ldsw + _i * 8192), 16, 0, 0); } while (0)
#define PG8_LDA(dst, b, h) do { _Pragma("unroll") for (int m = 0; m < 4; ++m) _Pragma("unroll") for (int k = 0; k < 2; ++k) dst[m][k] = *(const PG8_LAS bf16x8*)(lds + PG8_SA(b, h) + aoff + m * 2048 + k * 1024); } while (0)
#define PG8_LDB(dst, b, h) do { _Pragma("unroll") for (int n = 0; n < 2; ++n) _Pragma("unroll") for (int k = 0; k < 2; ++k) dst[n][k] = *(const PG8_LAS bf16x8*)(lds + PG8_SB(b, h) + boff + n * 2048 + k * 1024); } while (0)
#define PG8_MMA(ai, bj, At, Bt) do { __builtin_amdgcn_s_setprio(1); _Pragma("unroll") for (int m = 0; m < 4; ++m) _Pragma("unroll") for (int n = 0; n < 2; ++n) _Pragma("unroll") for (int k = 0; k < 2; ++k) \
        acc[ai][bj][m][n] = __builtin_amdgcn_mfma_f32_16x16x32_bf16(Bt[n][k], At[m][k], acc[ai][bj][m][n], 0, 0, 0); __builtin_amdgcn_s_setprio(0); } while (0)
#define PG8_WAIT_V(n) asm volatile("s_waitcnt vmcnt(" #n ")" ::: "memory")
#define PG8_WAIT_L(n) asm volatile("s_waitcnt lgkmcnt(" #n ")" ::: "memory")
#define PG8_BAR __builtin_amdgcn_s_barrier()
#define PG8_SCHED __builtin_amdgcn_sched_barrier(0)
    Unit cur, nxt; int ui = 0;
    if (!S.next(0, cur)) return;
    f32x4 acc[2][2][4][2];
#pragma unroll
    for (int a = 0; a < 2; ++a)
#pragma unroll
        for (int b = 0; b < 2; ++b)
#pragma unroll
            for (int m = 0; m < 4; ++m)
#pragma unroll
                for (int n = 0; n < 2; ++n) acc[a][b][m][n] = (f32x4){0.f, 0.f, 0.f, 0.f};
    bf16x8 At[4][2], B0[2][2], B1[2][2];
    const char* cA = (const char*)g.A + (size_t)cur.pm * tstep; const char* cB = (const char*)g.Bt + (size_t)cur.pn * tstep;
    S.a_ready(cur);
    if constexpr (SP2) {
        PG8_STAGE(PG8_SB(0, 0), cB, voffB); PG8_STAGE(PG8_SB(0, 1), cB + hstep, voffB); PG8_STAGE(PG8_SA(0, 0), cA, voffA); PG8_STAGE(PG8_SA(0, 1), cA + hstep, voffA);
        if (wr == 1) PG8_BAR;
        PG8_WAIT_V(2); PG8_BAR;
        PG8_STAGE(PG8_SB(1, 0), cB + kstep, voffB); PG8_STAGE(PG8_SA(1, 0), cA + kstep, voffA); PG8_STAGE(PG8_SB(1, 1), cB + hstep + kstep, voffB);
        PG8_WAIT_V(6); PG8_BAR;
    } else {
        PG8_STAGE(PG8_SB(0, 0), cB, voffB); PG8_STAGE(PG8_SA(0, 0), cA, voffA); PG8_STAGE(PG8_SB(0, 1), cB + hstep, voffB); PG8_STAGE(PG8_SA(0, 1), cA + hstep, voffA);
        if (wr == 1) PG8_BAR;
        PG8_WAIT_V(4); PG8_BAR;
        PG8_STAGE(PG8_SB(1, 0), cB + kstep, voffB); PG8_STAGE(PG8_SA(1, 0), cA + kstep, voffA); PG8_STAGE(PG8_SB(1, 1), cB + hstep + kstep, voffB);
        PG8_WAIT_V(6); PG8_BAR;
    }
    for (;;) {
        const bool has_next = S.next(ui + 1, nxt);
        const char* nA = has_next ? (const char*)g.A + (size_t)nxt.pm * tstep : cA; const char* nB = has_next ? (const char*)g.Bt + (size_t)nxt.pn * tstep : cB;
        for (int t = 0; t < nt; t += 2) {
            const bool last = (t == nt - 2);
            const char* a1 = cA + (size_t)(t + 1) * kstep;
            const char* a2 = last ? nA : cA + (size_t)(t + 2) * kstep; const char* b2 = last ? nB : cB + (size_t)(t + 2) * kstep;
            const char* a3 = a2 + kstep; const char* b3 = b2 + kstep;
            if (last && has_next) S.a_ready(nxt);
            if constexpr (SP2) {
            PG8_LDB(B0, 0, 0); PG8_LDB(B1, 0, 1); PG8_SCHED; PG8_LDA(At, 0, 0); PG8_STAGE(PG8_SA(1, 1), a1 + hstep, voffA);
            PG8_WAIT_V(8); PG8_WAIT_L(0); PG8_BAR; PG8_MMA(0, 0, At, B0); PG8_MMA(0, 1, At, B1); PG8_BAR; PG8_SCHED;
            PG8_LDA(At, 0, 1); PG8_STAGE(PG8_SB(0, 0), b2, voffB); PG8_STAGE(PG8_SB(0, 1), b2 + hstep, voffB); PG8_STAGE(PG8_SA(0, 0), a2, voffA);
            PG8_WAIT_V(8); PG8_WAIT_L(0); PG8_BAR; PG8_MMA(1, 0, At, B0); PG8_MMA(1, 1, At, B1); PG8_BAR; PG8_SCHED;
            PG8_LDB(B0, 1, 0); PG8_LDB(B1, 1, 1); PG8_SCHED; PG8_LDA(At, 1, 0); PG8_STAGE(PG8_SA(0, 1), a2 + hstep, voffA);
            PG8_WAIT_V(8); PG8_WAIT_L(0); PG8_BAR; PG8_MMA(0, 0, At, B0); PG8_MMA(0, 1, At, B1); PG8_BAR; PG8_SCHED;
            PG8_LDA(At, 1, 1); PG8_STAGE(PG8_SB(1, 0), b3, voffB); PG8_STAGE(PG8_SB(1, 1), b3 + hstep, voffB); PG8_STAGE(PG8_SA(1, 0), a3, voffA);
            PG8_WAIT_V(8); PG8_WAIT_L(0); PG8_BAR; PG8_MMA(1, 0, At, B0); PG8_MMA(1, 1, At, B1); PG8_BAR; PG8_SCHED;
            } else {
            PG8_LDB(B0, 0, 0); PG8_SCHED; PG8_LDA(At, 0, 0); PG8_STAGE(PG8_SA(1, 1), a1 + hstep, voffA);
            PG8_WAIT_L(8); PG8_BAR; PG8_WAIT_L(0); PG8_MMA(0, 0, At, B0); PG8_BAR; PG8_SCHED;
            PG8_LDB(B1, 0, 1); PG8_STAGE(PG8_SB(0, 0), b2, voffB);
            PG8_BAR; PG8_WAIT_L(0); PG8_MMA(0, 1, At, B1); PG8_BAR;
            PG8_LDA(At, 0, 1); PG8_STAGE(PG8_SA(0, 0), a2, voffA);
            PG8_BAR; PG8_WAIT_L(0); PG8_MMA(1, 0, At, B0); PG8_BAR; PG8_SCHED;
            PG8_STAGE(PG8_SB(0, 1), b2 + hstep, voffB);
            PG8_WAIT_V(6); PG8_BAR; PG8_MMA(1, 1, At, B1); PG8_BAR;
            PG8_LDB(B0, 1, 0); PG8_SCHED; PG8_LDA(At, 1, 0); PG8_STAGE(PG8_SA(0, 1), a2 + hstep, voffA);
            PG8_WAIT_L(8); PG8_BAR; PG8_WAIT_L(0); PG8_MMA(0, 0, At, B0); PG8_BAR; PG8_SCHED;
            PG8_LDB(B1, 1, 1); PG8_STAGE(PG8_SB(1, 0), b3, voffB);
            PG8_BAR; PG8_WAIT_L(0); PG8_MMA(0, 1, At, B1); PG8_BAR;
            PG8_LDA(At, 1, 1); PG8_STAGE(PG8_SA(1, 0), a3, voffA);
            PG8_BAR; PG8_WAIT_L(0); PG8_MMA(1, 0, At, B0); PG8_BAR; PG8_SCHED;
            PG8_STAGE(PG8_SB(1, 1), b3 + hstep, voffB);
            PG8_WAIT_V(6); PG8_BAR; PG8_MMA(1, 1, At, B1); PG8_BAR;
            }
        }
        if constexpr (ALIGN_EPI) { if (wr == 0) PG8_BAR; }
        if constexpr (!Epi::AFTER_DRAIN) { E(acc, cur, wr, wc, fr, fq); S.done(cur); }
        if (!has_next) break;
#pragma unroll
        for (int a = 0; a < 2; ++a)
#pragma unroll
            for (int b = 0; b < 2; ++b)
#pragma unroll
                for (int m = 0; m < 4; ++m)
#pragma unroll
                    for (int n = 0; n < 2; ++n) acc[a][b][m][n] = (f32x4){0.f, 0.f, 0.f, 0.f};
        cur = nxt; cA = nA; cB = nB; ++ui;
        if constexpr (ALIGN_EPI) { if (wr == 1) PG8_BAR; }
    }
    PG8_WAIT_V(0);
    if constexpr (!ALIGN_EPI) { if (wr == 0) PG8_BAR; }
    PG8_BAR;
    if constexpr (Epi::AFTER_DRAIN) { E.fused(acc, cur, wr, wc, fr, fq, lds, wid, lane); S.done(cur); }
#undef PG8_SA
#undef PG8_SB
#undef PG8_STAGE
#undef PG8_LDA
#undef PG8_LDB
#undef PG8_MMA
#undef PG8_WAIT_V
#undef PG8_WAIT_L
#undef PG8_BAR
#undef PG8_SCHED
}
}

#ifndef PG8_SP2
#define PG8_SP2 true
#endif
namespace attn_body {
using bf16=__hip_bfloat16;
using bf16x8=__attribute__((ext_vector_type(8)))short;
using s16x4=__attribute__((ext_vector_type(4)))short;
using f32x16=__attribute__((ext_vector_type(16)))float;
using u32x4=__attribute__((ext_vector_type(4)))unsigned;
constexpr int BATCH=16,NHEAD=8,SEQ=4096,D=64,DM=3072,OPITCH=1024;
constexpr int NW=8,QBLK=32,QB=QBLK*NW,KVBLK=64,NQB=SEQ/QB;
constexpr int ATTN_PITCH=DM, ATTN_UNIT_ROWS=QB;
__device__ __forceinline__ int crow(int r,int hi){return (r&3)+8*(r>>2)+4*hi;}
#define SBAR() __builtin_amdgcn_sched_barrier(0)
__device__ __forceinline__ void cmask(f32x16&p0,f32x16&p1,int jb,int qrel,int hi){
  const float NEG=-INFINITY; int kb=64*jb+4*hi;
  #pragma unroll
  for(int r=0;r<16;++r){int kv=kb+(r&3)+8*(r>>2); if(kv>qrel)p0[r]=NEG; if(kv+32>qrel)p1[r]=NEG;}
}

constexpr int NSLOT=3, SLOTB=8192;
constexpr int LDS_K=0, LDS_V=NSLOT*SLOTB, LDS_WS=2*NSLOT*SLOTB, LDS_OST=LDS_WS+NW*64*4, LDS_BYTES=LDS_OST+NW*4096, LDS_F=86016;
constexpr float C2=0.125f*1.4426950408889634f;
__device__ __forceinline__ void glds16(const void*gsrc,unsigned lds_dst){unsigned keep;
  asm volatile("s_mov_b32 %0, m0\n\ts_mov_b32 m0, %2\n\ts_nop 0\n\tglobal_load_lds_dwordx4 %1, off\n\ts_mov_b32 m0, %0":"=&s"(keep):"v"(gsrc),"s"(lds_dst):"memory");}
__device__ __forceinline__ float max3f(float a,float b,float c){float r;asm("v_max3_f32 %0, %1, %2, %3":"=v"(r):"v"(a),"v"(b),"v"(c));return r;}
__device__ __forceinline__ float max2f(float a,float b){float r;asm("v_max_f32_e32 %0, %1, %2":"=v"(r):"v"(a),"v"(b));return r;}
__device__ __forceinline__ float fadd_s(float a,float b){float r;asm("v_add_f32_e32 %0, %1, %2":"=v"(r):"v"(a),"v"(b));return r;}
__device__ __forceinline__ float fsub_s(float a,float b){float r;asm("v_sub_f32_e32 %0, %1, %2":"=v"(r):"v"(a),"v"(b));return r;}
typedef float f32x2_t __attribute__((ext_vector_type(2))); typedef __bf16 bf16x2_t __attribute__((ext_vector_type(2)));
__device__ __forceinline__ unsigned cvtpk_s(float lo,float hi){f32x2_t v={lo,hi};bf16x2_t b=__builtin_convertvector(v,bf16x2_t);return __builtin_bit_cast(unsigned,b);}
#define WAIT_BAR(N) asm volatile("s_waitcnt vmcnt(" #N ") lgkmcnt(0)\n\ts_barrier":::"memory")

__device__ __forceinline__ void qkt(f32x16&p0,f32x16&p1,const char*Kslot,const bf16x8*qr,int r32,int hi){
  const char*kb=Kslot+hi*1024+r32*16;
  #pragma unroll
  for(int d0=0;d0<4;++d0){
    const bf16x8 b0=*reinterpret_cast<const bf16x8*>(kb+d0*2048);
    const bf16x8 b1=*reinterpret_cast<const bf16x8*>(kb+d0*2048+512);
    p0=__builtin_amdgcn_mfma_f32_32x32x16_bf16(b0,qr[d0],p0,0,0,0);p1=__builtin_amdgcn_mfma_f32_32x32x16_bf16(b1,qr[d0],p1,0,0,0);}
}
typedef __attribute__((address_space(3))) const char* lds_cptr;
typedef short v4i16_t __attribute__((ext_vector_type(4)));
__device__ __forceinline__ void kload8(bf16x8*kf,lds_cptr kp){
  kf[0]=*(const __attribute__((address_space(3))) bf16x8*)(kp);      kf[1]=*(const __attribute__((address_space(3))) bf16x8*)(kp+512);
  kf[2]=*(const __attribute__((address_space(3))) bf16x8*)(kp+2048); kf[3]=*(const __attribute__((address_space(3))) bf16x8*)(kp+2560);
  kf[4]=*(const __attribute__((address_space(3))) bf16x8*)(kp+4096); kf[5]=*(const __attribute__((address_space(3))) bf16x8*)(kp+4608);
  kf[6]=*(const __attribute__((address_space(3))) bf16x8*)(kp+6144); kf[7]=*(const __attribute__((address_space(3))) bf16x8*)(kp+6656);
}
__device__ __forceinline__ void kload2(bf16x8*kf,lds_cptr kp,int j){ kf[2*j]=*(const __attribute__((address_space(3))) bf16x8*)(kp+j*2048); kf[2*j+1]=*(const __attribute__((address_space(3))) bf16x8*)(kp+j*2048+512); }
__device__ __forceinline__ s16x4 vtr(lds_cptr p){ return __builtin_bit_cast(s16x4,__builtin_amdgcn_ds_read_tr16_b64_v4i16((__attribute__((address_space(3))) v4i16_t*)p)); }
__device__ __forceinline__ float rowmax(const f32x16&p0,const f32x16&p1){
  float a=max3f(p0[0],p0[1],p1[0]),b=max3f(p0[2],p0[3],p1[1]);a=max3f(a,p1[2],p1[3]);
  #pragma unroll
  for(int r=4;r<16;r+=4){a=max3f(a,p0[r],p0[r+1]);b=max3f(b,p0[r+2],p0[r+3]);a=max3f(a,p1[r],p1[r+1]);b=max3f(b,p1[r+2],p1[r+3]);}
  const float m=max2f(a,b);
  auto rr=__builtin_amdgcn_permlane32_swap(__float_as_uint(m),__float_as_uint(m),false,false);
  return max2f(__uint_as_float(rr[0]),__uint_as_float(rr[1]));
}
__device__ __forceinline__ void pv(f32x16*o,int vb,bf16x8 pa0,bf16x8 pa1,bf16x8 pa2,bf16x8 pa3){
  #pragma unroll
  for(int d0=0;d0<2;++d0){s16x4 lo[4],hi[4];
    #pragma unroll
    for(int ks=0;ks<4;++ks){
      asm volatile("ds_read_b64_tr_b16 %0,%1 offset:%c2":"=&v"(lo[ks]):"v"(vb),"i"(d0*4096+ks*1024):"memory");
      asm volatile("ds_read_b64_tr_b16 %0,%1 offset:%c2":"=&v"(hi[ks]):"v"(vb),"i"(d0*4096+ks*1024+512):"memory");}
    asm volatile("s_waitcnt lgkmcnt(0)":::"memory");SBAR();
    #define PK(k) (bf16x8){lo[k][0],lo[k][1],lo[k][2],lo[k][3],hi[k][0],hi[k][1],hi[k][2],hi[k][3]}
    o[d0]=__builtin_amdgcn_mfma_f32_32x32x16_bf16(pa0,PK(0),o[d0],0,0,0);
    o[d0]=__builtin_amdgcn_mfma_f32_32x32x16_bf16(pa1,PK(1),o[d0],0,0,0);
    o[d0]=__builtin_amdgcn_mfma_f32_32x32x16_bf16(pa2,PK(2),o[d0],0,0,0);
    o[d0]=__builtin_amdgcn_mfma_f32_32x32x16_bf16(pa3,PK(3),o[d0],0,0,0);
    #undef PK
  }
}

#ifndef ATTN_STORE16
#define ATTN_STORE16(p,v) (*(u32x4*)(p)=(v))
#endif
template<int THRL> __device__ __forceinline__ void attn_unit(int b,int h,int qb,const bf16*Q,const bf16*__restrict__ K,const bf16*__restrict__ V,bf16*O,const float*Fg,char*shm){
  const int tid=mk_tid(),lane=tid&63,r32=lane&31,hi=lane>>5; const int wid=__builtin_amdgcn_readfirstlane(tid>>6);
  const long rowbase=(long)b*SEQ; const int q0=qb*QB;
  const bf16*Qw=Q+(rowbase+q0+wid*QBLK)*DM+h*D;
  const bf16*Kh=K+rowbase*DM+h*D,*Vh=V+rowbase*DM+h*D;
  const unsigned lds0=(unsigned)(uintptr_t)shm;
  float*wsf=(float*)(shm+LDS_WS)+wid*64;
  const bf16*ksrc=Kh+(long)lane*DM+wid*8;
  const bf16*vsrc=Vh+(long)(16*(wid&3)+(lane>>2))*DM+(wid>>2)*32+(lane&3)*8;
  const unsigned kdst=lds0+LDS_K+wid*1024, vdst=lds0+LDS_V+wid*1024;
  #define DMA_K(t,slot) glds16(ksrc+(long)(t)*KVBLK*DM,(unsigned)__builtin_amdgcn_readfirstlane(kdst+(slot)))
  #define DMA_V(t,slot) glds16(vsrc+(long)(t)*KVBLK*DM,(unsigned)__builtin_amdgcn_readfirstlane(vdst+(slot)))
  const int vb0=(int)(lds0+LDS_V)+((lane>>4)&1)*32+(lane&3)*8+(4*hi+((lane&15)>>2))*64;
  const char*Kbase=shm+LDS_K; bf16x8 kf[8];
  const lds_cptr shm3=(lds_cptr)shm; const lds_cptr kp0=shm3+LDS_K+hi*1024+r32*16; const lds_cptr vp0=shm3+LDS_V+((lane>>4)&1)*32+(lane&3)*8+(4*hi+((lane&15)>>2))*64;
  const int NT=(q0+QB)/KVBLK;
  typedef float f4v_t __attribute__((ext_vector_type(4))); typedef __attribute__((address_space(3))) f4v_t lf4_t; lf4_t*Fl4=(lf4_t*)((__attribute__((address_space(3))) char*)shm+LDS_F);
  { const int nf4=(q0+QB)/4; const f4v_t*src=(const f4v_t*)Fg; for(int i=tid;i<nf4;i+=NW*64) Fl4[i]=-src[i]; }
  const float fq_l=Fg[q0+wid*QBLK+r32];
  #define BINIT(C0,C1,t) do{ const lf4_t*fp_=Fl4+(t)*16+hi; _Pragma("unroll") for(int a_=0;a_<4;++a_){ const f4v_t f0_=fp_[2*a_], f1_=fp_[8+2*a_]; \
      C0[4*a_]=nb+f0_.x; C0[4*a_+1]=nb+f0_.y; C0[4*a_+2]=nb+f0_.z; C0[4*a_+3]=nb+f0_.w; C1[4*a_]=nb+f1_.x; C1[4*a_+1]=nb+f1_.y; C1[4*a_+2]=nb+f1_.z; C1[4*a_+3]=nb+f1_.w; } }while(0)
  DMA_K(0,0);DMA_V(0,0);DMA_K(1,SLOTB);
  bf16x8 qr[4];
  #pragma unroll
  for(int d0=0;d0<4;++d0)qr[d0]=*reinterpret_cast<const bf16x8*>(&Qw[(long)r32*DM+d0*16+hi*8]);
  float mhat=0.f,l_reg=0.f;f32x16 o[2];o[0]=f32x16{};o[1]=f32x16{};float nb=fq_l;
  const int qrel=wid*QBLK+r32;
  #define CMASK(P0,P1,t) do{int jb_=(t)-(NT-4); if(jb_>=0)cmask(P0,P1,jb_,qrel,hi);}while(0)
  bool resc=false;
  #define START(P0,P1) do{ const float rm=rowmax(P0,P1); resc=false; \
    { const float dl=rm; mhat=fadd_s(mhat,dl); \
      _Pragma("unroll") for(int r=0;r<16;++r){P0[r]=fsub_s(P0[r],dl);P1[r]=fsub_s(P1[r],dl);} \
      nb=fq_l-mhat; } \
    _Pragma("unroll") for(int r=0;r<16;++r)P0[r]=__builtin_amdgcn_exp2f(P0[r]); }while(0)
  #define RESC() do{ if(resc){ asm volatile("s_waitcnt lgkmcnt(0)":::"memory"); \
      _Pragma("unroll") for(int d_=0;d_<2;++d_) _Pragma("unroll") for(int r=0;r<16;++r)o[d_][r]*=wsf[crow(r,hi)]; } }while(0)
  f32x16 pA0,pA1,pB0,pB1;
  int sl_prev=0,sl_cur=0,sl_next=SLOTB;
  #define ROT() do{sl_prev=sl_cur;sl_cur=sl_next;sl_next=(sl_next==(NSLOT-1)*SLOTB)?0:sl_next+SLOTB;}while(0)
  DMA_K(2,2*SLOTB);
  WAIT_BAR(3);
  BINIT(pA0,pA1,0); qkt(pA0,pA1,Kbase,qr,r32,hi);asm volatile("s_nop 15\n\ts_nop 7":"+v"(pA0),"+v"(pA1));CMASK(pA0,pA1,0);
  START(pA0,pA1); BINIT(pB0,pB1,1);
  _Pragma("unroll") for(int r=0;r<16;++r)pA1[r]=__builtin_amdgcn_exp2f(pA1[r]);
  WAIT_BAR(0);
  DMA_K(3,0);DMA_V(1,SLOTB);
  ROT();
  kload8(kf,kp0+sl_cur);
  WAIT_BAR(2);
  s16x4 vlo[8],vhi[8]; u32x4 pw0,pw1,pw2,pw3;
  #define PKW(P,B) cvtpk_s(P[B],P[B+1])
  #define PAF(k) __builtin_bit_cast(bf16x8,pw##k)
  #define VFR(i) (bf16x8){vlo[i][0],vlo[i][1],vlo[i][2],vlo[i][3],vhi[i][0],vhi[i][1],vhi[i][2],vhi[i][3]}
  #define PIN(x) asm volatile("":"+v"(x))
  #define MX3(a,b,c) __builtin_fmaxf(__builtin_fmaxf((a),(b)),(c))
  #define GAPA(MF,A0,A1,A2,A3,W0,W1,PW) do{ MF; sacc+=A0; sacc+=A1; sacc+=A2; sacc+=A3; PIN(sacc); W0; W1; PIN(PW); SBAR(); }while(0)
  #define EX(v) __builtin_amdgcn_exp2f(v)
  #define GAPB(MF,X,B,Y) do{ MF; X[B]=EX(X[B]); X[B+1]=EX(X[B+1]); X[B+2]=EX(X[B+2]); X[B+3]=EX(X[B+3]); PIN(X); Y[B]+=nb; Y[B+1]+=nb; Y[B+2]+=nb; Y[B+3]+=nb; PIN(Y); SBAR(); }while(0)
  #define BLOAD(P0,P1,t1) do{ const lf4_t*fp_=Fl4+(t1)*16+hi; _Pragma("unroll") for(int a_=0;a_<4;++a_){ const f4v_t f0_=fp_[2*a_], f1_=fp_[8+2*a_]; \
      P0[4*a_]=f0_.x; P0[4*a_+1]=f0_.y; P0[4*a_+2]=f0_.z; P0[4*a_+3]=f0_.w; P1[4*a_]=f1_.x; P1[4*a_+1]=f1_.y; P1[4*a_+2]=f1_.z; P1[4*a_+3]=f1_.w; } }while(0)
  #define VRD(i) do{ vlo[i]=vtr(vp_+(((i)>>2)*4096+((i)&3)*1024)); vhi[i]=vtr(vp_+(((i)>>2)*4096+((i)&3)*1024+512)); }while(0)
  #define KRD(G,j) do{ if(G){ kload2(kf,kp0+sl_next,j); SBAR(); } }while(0)
  #define STEP(C0,C1,P0,P1,t,GK,GV,GL) do{ SBAR(); \
    const lds_cptr vp_=vp0+sl_prev; \
    VRD(0); SBAR(); float sacc=(P0[0]+P0[1]); \
    GAPA(C0=__builtin_amdgcn_mfma_f32_32x32x16_bf16(kf[0],qr[0],C0,0,0,0), P0[2],P0[3],P0[4],P0[5],     pw0[0]=PKW(P0,0), pw0[1]=PKW(P0,2), pw0); \
    VRD(4); SBAR(); GAPA(C1=__builtin_amdgcn_mfma_f32_32x32x16_bf16(kf[1],qr[0],C1,0,0,0), P0[6],P0[7],P0[8],P0[9],     pw0[2]=PKW(P0,4), pw0[3]=PKW(P0,6), pw0); \
    VRD(1); SBAR(); GAPA(C0=__builtin_amdgcn_mfma_f32_32x32x16_bf16(kf[2],qr[1],C0,0,0,0),   P0[10],P0[11],P0[12],P0[13], pw1[0]=PKW(P0,8), pw1[1]=PKW(P0,10), pw1); \
    VRD(5); SBAR(); GAPA(C1=__builtin_amdgcn_mfma_f32_32x32x16_bf16(kf[3],qr[1],C1,0,0,0),   P0[14],P0[15],P1[0],P1[1],   pw1[2]=PKW(P0,12),pw1[3]=PKW(P0,14), pw1); \
    VRD(2); SBAR(); GAPA(C0=__builtin_amdgcn_mfma_f32_32x32x16_bf16(kf[4],qr[2],C0,0,0,0),   P1[2],P1[3],P1[4],P1[5],     pw2[0]=PKW(P1,0), pw2[1]=PKW(P1,2), pw2); \
    VRD(6); SBAR(); GAPA(C1=__builtin_amdgcn_mfma_f32_32x32x16_bf16(kf[5],qr[2],C1,0,0,0),   P1[6],P1[7],P1[8],P1[9],     pw2[2]=PKW(P1,4), pw2[3]=PKW(P1,6), pw2); \
    VRD(3); SBAR(); GAPA(C0=__builtin_amdgcn_mfma_f32_32x32x16_bf16(kf[6],qr[3],C0,0,0,0),   P1[10],P1[11],P1[12],P1[13], pw3[0]=PKW(P1,8), pw3[1]=PKW(P1,10), pw3); \
    VRD(7); SBAR(); GAPA(C1=__builtin_amdgcn_mfma_f32_32x32x16_bf16(kf[7],qr[3],C1,0,0,0),   P1[14],P1[15],0.f,0.f,       pw3[2]=PKW(P1,12),pw3[3]=PKW(P1,14), pw3); \
    l_reg+=sacc; \
    if(GK){DMA_K((t)+3,sl_cur);} if(GV){DMA_V((t)+1,sl_next);} \
    CMASK(C0,C1,t); \
    { float a=MX3(C0[0],C0[1],C1[0]),b=MX3(C0[2],C0[3],C1[1]); a=MX3(a,C1[2],C1[3]); \
      _Pragma("unroll") for(int r=4;r<16;r+=4){a=MX3(a,C0[r],C0[r+1]);b=MX3(b,C0[r+2],C0[r+3]);a=MX3(a,C1[r],C1[r+1]);b=MX3(b,C1[r+2],C1[r+3]);} \
      float rm=__builtin_fmaxf(a,b); { auto rr=__builtin_amdgcn_permlane32_swap(__float_as_uint(rm),__float_as_uint(rm),false,false); rm=__builtin_fmaxf(__uint_as_float(rr[0]),__uint_as_float(rr[1])); } \
      resc=false; \
      if(__builtin_expect(__any(rm>(float)THRL),0)){ const float dl=__builtin_fmaxf(rm,0.f); mhat+=dl; \
        _Pragma("unroll") for(int r=0;r<16;++r){C0[r]-=dl;C1[r]-=dl;} \
        nb-=dl; \
        const float f=__builtin_amdgcn_exp2f(-dl); l_reg*=f; if(hi==0)wsf[r32]=f; resc=true; } } \
    SBAR(); BLOAD(P0,P1,(t)+1); SBAR(); \
    GAPB(o[0]=__builtin_amdgcn_mfma_f32_32x32x16_bf16(PAF(0),VFR(0),o[0],0,0,0), C0,0,P0); \
    GAPB(o[1]=__builtin_amdgcn_mfma_f32_32x32x16_bf16(PAF(0),VFR(4),o[1],0,0,0), C0,4,P0); \
    KRD(GL,0); GAPB(o[0]=__builtin_amdgcn_mfma_f32_32x32x16_bf16(PAF(1),VFR(1),o[0],0,0,0), C0,8,P0); \
    KRD(GL,1); GAPB(o[1]=__builtin_amdgcn_mfma_f32_32x32x16_bf16(PAF(1),VFR(5),o[1],0,0,0), C0,12,P0); \
    KRD(GL,2); GAPB(o[0]=__builtin_amdgcn_mfma_f32_32x32x16_bf16(PAF(2),VFR(2),o[0],0,0,0), C1,0,P1); \
    KRD(GL,3); GAPB(o[1]=__builtin_amdgcn_mfma_f32_32x32x16_bf16(PAF(2),VFR(6),o[1],0,0,0), C1,4,P1); \
    GAPB(o[0]=__builtin_amdgcn_mfma_f32_32x32x16_bf16(PAF(3),VFR(3),o[0],0,0,0), C1,8,P1); \
    GAPB(o[1]=__builtin_amdgcn_mfma_f32_32x32x16_bf16(PAF(3),VFR(7),o[1],0,0,0), C1,12,P1); \
    }while(0)
  int t=1;
  #undef CMASK
  #define CMASK(P0,P1,t) do{}while(0)
  for(;t+5<NT;t+=2){
    STEP(pB0,pB1,pA0,pA1,t,true,true,true);     WAIT_BAR(2); RESC(); ROT();
    STEP(pA0,pA1,pB0,pB1,t+1,true,true,true);   WAIT_BAR(2); RESC(); ROT();
  }
  #undef CMASK
  #define CMASK(P0,P1,t) do{int jb_=(t)-(NT-4); if(jb_>=0)cmask(P0,P1,jb_,qrel,hi);}while(0)
  #define ENDW(tt) do{ if((tt)+3<NT){WAIT_BAR(2);} else if((tt)+2<NT){WAIT_BAR(1);} else {WAIT_BAR(0);} }while(0)
  for(;t+1<NT;t+=2){
    STEP(pB0,pB1,pA0,pA1,t,(t+3<NT),(t+1<NT),(t+1<NT));       ENDW(t);   RESC(); ROT();
    STEP(pA0,pA1,pB0,pB1,t+1,(t+4<NT),(t+2<NT),(t+2<NT));     ENDW(t+1); RESC(); ROT();
  }
  STEP(pB0,pB1,pA0,pA1,NT-1,false,false,false); RESC();
  { float sacc=pB0[0]+pB0[1]; _Pragma("unroll") for(int r=2;r<16;++r)sacc+=pB0[r]; _Pragma("unroll") for(int r=0;r<16;++r)sacc+=pB1[r]; l_reg+=sacc;
    pw0=(u32x4){PKW(pB0,0),PKW(pB0,2),PKW(pB0,4),PKW(pB0,6)};pw1=(u32x4){PKW(pB0,8),PKW(pB0,10),PKW(pB0,12),PKW(pB0,14)};pw2=(u32x4){PKW(pB1,0),PKW(pB1,2),PKW(pB1,4),PKW(pB1,6)};pw3=(u32x4){PKW(pB1,8),PKW(pB1,10),PKW(pB1,12),PKW(pB1,14)};
    SBAR(); pv(o,vb0+sl_cur,PAF(0),PAF(1),PAF(2),PAF(3)); }
  #undef PKW
  #undef PAF
  #undef VFR
  #undef PIN
  #undef MX3
  #undef GAPA
  #undef GAPB
  #undef BLOAD
  #undef EX
  #undef VRD
  #undef KRD
  #undef STEP
  #undef ENDW
  {auto rr=__builtin_amdgcn_permlane32_swap(__float_as_uint(l_reg),__float_as_uint(l_reg),false,false);l_reg=__uint_as_float(rr[0])+__uint_as_float(rr[1]);}
  if(hi==0)wsf[32+r32]=l_reg;asm volatile("s_waitcnt lgkmcnt(0)":::"memory");
  float rli[16];
  #pragma unroll
  for(int r=0;r<16;++r)rli[r]=__builtin_amdgcn_rcpf(wsf[32+crow(r,hi)]);
  bf16*Ow=O+(rowbase+q0+wid*QBLK)*OPITCH+h*D;
  { bf16*stg=(bf16*)(shm+LDS_OST)+wid*2048;
    #pragma unroll
    for(int r=0;r<16;++r){const int orow=crow(r,hi);
      #pragma unroll
      for(int d0=0;d0<2;++d0)stg[orow*64+d0*32+r32]=__float2bfloat16(o[d0][r]*rli[r]);}
    asm volatile("s_waitcnt lgkmcnt(0)":::"memory");
    #pragma unroll
    for(int i=0;i<4;++i){const int row=i*8+(lane>>3),ch=lane&7; const u32x4 v=*(const u32x4*)(stg+row*64+ch*8); ATTN_STORE16(Ow+(long)row*OPITCH+ch*8,v);} }
  asm volatile("s_waitcnt lgkmcnt(0)\n\ts_barrier":::"memory");
  #undef DMA_K
  #undef DMA_V
  #undef CMASK
  #undef START
  #undef RESC
  #undef ROT
  #undef BINIT
}
constexpr int ATTN_LDS_BYTES=LDS_BYTES;
struct AttnTensors { const bf16* Q; const bf16* K; const bf16* V; bf16* O; const float* F; };
struct AttnUnit { int bh; int qb; };
struct StaticOrder {
  int vcu;
  __device__ __forceinline__ explicit StaticOrder(int v):vcu(v){}
  __device__ __forceinline__ bool next(int i,AttnUnit&u)const{ if(i>=8)return false; const int s=4*(vcu&1)+(i>>1); u.bh=vcu>>1; u.qb=(i&1)?15-s:s; return true; }
};
template<class Sched,int THRL=48> __device__ __forceinline__ void attn_phase(char*lds,const AttnTensors&T,const Sched&S){
  AttnUnit u;
  for(int i=0;S.next(i,u);++i){ attn_unit<THRL>(u.bh/NHEAD,u.bh%NHEAD,u.qb,T.Q,T.K,T.V,T.O,T.F+(size_t)u.bh*SEQ,lds); }
}
#undef SBAR
#undef WAIT_BAR
}
namespace mk {
typedef unsigned short bf16_t;
typedef short bf16x8 __attribute__((ext_vector_type(8)));
typedef float f32x4 __attribute__((ext_vector_type(4)));
typedef float f32x16 __attribute__((ext_vector_type(16)));
typedef unsigned u32x4 __attribute__((ext_vector_type(4)));
typedef unsigned u32x2 __attribute__((ext_vector_type(2)));

constexpr int DM = 1024, NPT = 65536, NST = 512, MT = NPT + NST, SEQ = 4096, DFF = 2816, PW = 3072, NINP = 3328;
constexpr float LOG2E = 1.4426950408889634f;
constexpr float C2 = 0.125f * LOG2E;
constexpr float ALPHA = 1.4142135623730951f;
constexpr size_t O_YP = 0, O_YS = O_YP + 67108864, O_PFK = O_YS + 524288, O_PFV = O_PFK + 67108864, O_PFL = O_PFV + 67108864,
    O_PMC = O_PFL + 1048576, O_PMN = O_PMC + 524288, O_PMM = O_PMN + 8192, O_SFK = O_PMM + 128, O_SFV = O_SFK + 524288,
    O_SFL = O_SFV + 524288, O_SMC = O_SFL + 8192, O_SMN = O_SMC + 524288, O_SMM = O_SMN + 8192, O_SGV = O_SMM + 128, O_END = O_SGV + 262144;
constexpr size_t MiB = 1u << 20;
constexpr size_t WS_MOD = 1 * MiB, WS_STATS = 3 * MiB, WS_GATES = 6 * MiB, WS_FQ = 11 * MiB, WS_AB = 13 * MiB, WS_MS = 13 * MiB + 65536, WS_NS = 14 * MiB,
    WS_WIN = 16 * MiB, WS_WO = 29 * MiB, WS_WGU = 33 * MiB, WS_WD = 55 * MiB, WS_GW = 66 * MiB, WS_HA = 67 * MiB, WS_PROJ = 196 * MiB,
    WS_R1 = 583 * MiB, WS_R2 = 712 * MiB, WS_UT = 841 * MiB, WS_CS = 906 * MiB, WS_END = 938 * MiB;
constexpr int LDS_BYTES = 155648;

struct Ctx {
    unsigned char* ws; float* out; const PG8_LAS unsigned long long* tab;
    __device__ __forceinline__ const float* in(int i) const { const unsigned long long v = tab[i]; const unsigned lo = __builtin_amdgcn_readfirstlane((unsigned)v), hi = __builtin_amdgcn_readfirstlane((unsigned)(v >> 32)); return (const float*)(const __attribute__((address_space(1))) float*)(((unsigned long long)hi << 32) | lo); }
    __device__ __forceinline__ const float* x_prompt() const { return in(0); }
    __device__ __forceinline__ const float* x_sample() const { return in(1); }
    __device__ __forceinline__ const float* cache_k() const { return in(2); }
    __device__ __forceinline__ const float* cache_v() const { return in(3); }
    __device__ __forceinline__ const float* cache_logf() const { return in(4); }
    __device__ __forceinline__ const float* st_C() const { return in(5); }
    __device__ __forceinline__ const float* st_n() const { return in(6); }
    __device__ __forceinline__ const float* st_m() const { return in(7); }
    __device__ __forceinline__ const float* c_prompt() const { return in(8); }
    __device__ __forceinline__ const float* c_sample() const { return in(9); }
    __device__ __forceinline__ const float* w_ada() const { return in(10); }
    __device__ __forceinline__ const float* b_ada() const { return in(11); }
    __device__ __forceinline__ const float* w_in() const { return in(12); }
    __device__ __forceinline__ const float* b_mi() const { return in(13); }
    __device__ __forceinline__ const float* b_mf() const { return in(14); }
    __device__ __forceinline__ const float* norm_g() const { return in(15); }
    __device__ __forceinline__ const float* b_ff() const { return in(16); }
    __device__ __forceinline__ const float* gln_g() const { return in(17); }
    __device__ __forceinline__ const float* gln_b() const { return in(18); }
    __device__ __forceinline__ const float* gws() const { return in(19); }
    __device__ __forceinline__ const float* gbs() const { return in(20); }
    __device__ __forceinline__ const float* w_o() const { return in(21); }
    __device__ __forceinline__ const float* ln1_g() const { return in(22); }
    __device__ __forceinline__ const float* ln1_b() const { return in(23); }
    __device__ __forceinline__ const float* w_gate() const { return in(24); }
    __device__ __forceinline__ const float* w_up() const { return in(25); }
    __device__ __forceinline__ const float* w_down() const { return in(26); }
    __device__ __forceinline__ const float* ln2_g() const { return in(27); }
    __device__ __forceinline__ const float* ln2_b() const { return in(28); }
    __device__ __forceinline__ float* MOD() const { return (float*)(ws + WS_MOD); }
    __device__ __forceinline__ float* STATS() const { return (float*)(ws + WS_STATS); }
    __device__ __forceinline__ float* GATES() const { return (float*)(ws + WS_GATES); }
    __device__ __forceinline__ float* FQ() const { return (float*)(ws + WS_FQ); }
    __device__ __forceinline__ float* AB() const { return (float*)(ws + WS_AB); }
    __device__ __forceinline__ float* MS() const { return (float*)(ws + WS_MS); }
    __device__ __forceinline__ float* NS() const { return (float*)(ws + WS_NS); }
    __device__ __forceinline__ float* UT() const { return (float*)(ws + WS_UT); }
    __device__ __forceinline__ bf16_t* WIN() const { return (bf16_t*)(ws + WS_WIN); }
    __device__ __forceinline__ bf16_t* WO() const { return (bf16_t*)(ws + WS_WO); }
    __device__ __forceinline__ bf16_t* WGU() const { return (bf16_t*)(ws + WS_WGU); }
    __device__ __forceinline__ bf16_t* WD() const { return (bf16_t*)(ws + WS_WD); }
    __device__ __forceinline__ bf16_t* GW() const { return (bf16_t*)(ws + WS_GW); }
    __device__ __forceinline__ bf16_t* HA() const { return (bf16_t*)(ws + WS_HA); }
    __device__ __forceinline__ bf16_t* PROJ() const { return (bf16_t*)(ws + WS_PROJ); }
    __device__ __forceinline__ bf16_t* R1() const { return (bf16_t*)(ws + WS_R1); }
    __device__ __forceinline__ bf16_t* R2() const { return (bf16_t*)(ws + WS_R2); }
    __device__ __forceinline__ bf16_t* CS() const { return (bf16_t*)(ws + WS_CS); }
};

__device__ __forceinline__ float bf2f(unsigned u16) { return __uint_as_float(u16 << 16); }
__device__ __forceinline__ unsigned pkbf(float lo, float hi) { unsigned r; asm("v_cvt_pk_bf16_f32 %0, %1, %2" : "=v"(r) : "v"(lo), "v"(hi)); return r; }
__device__ __forceinline__ float logsig(float x) { return fminf(x, 0.f) - __logf(1.f + __expf(-fabsf(x))); }
__device__ __forceinline__ float sigm(float x) { return 1.f / (1.f + __expf(-x)); }
__device__ __forceinline__ float wsum(float v) {
#pragma unroll
    for (int o = 32; o > 0; o >>= 1) v += __shfl_xor(v, o);
    return v;
}
__device__ __forceinline__ float wmax(float v) {
#pragma unroll
    for (int o = 32; o > 0; o >>= 1) v = fmaxf(v, __shfl_xor(v, o));
    return v;
}
__device__ __forceinline__ int row_cb(int row) { return row < NPT ? (row >> 12) : 16 + ((row - NPT) >> 5); }
__device__ __forceinline__ int crow(int r, int hi) { return (r & 3) + 8 * (r >> 2) + 4 * hi; }
__device__ __forceinline__ bf16x8 gather8(const bf16_t* p, int stride, int o4) {
    unsigned v[8];
#pragma unroll
    for (int j = 0; j < 4; ++j) { v[j] = p[j * stride]; v[4 + j] = p[(o4 + j) * stride]; }
    u32x4 w; w.x = v[0] | (v[1] << 16); w.y = v[2] | (v[3] << 16); w.z = v[4] | (v[5] << 16); w.w = v[6] | (v[7] << 16);
    return __builtin_bit_cast(bf16x8, w);
}
__device__ __forceinline__ void unpack8(const u32x4 w, float* f) {
    f[0] = bf2f(w.x & 0xffffu); f[1] = bf2f(w.x >> 16); f[2] = bf2f(w.y & 0xffffu); f[3] = bf2f(w.y >> 16);
    f[4] = bf2f(w.z & 0xffffu); f[5] = bf2f(w.z >> 16); f[6] = bf2f(w.w & 0xffffu); f[7] = bf2f(w.w >> 16);
}

__device__ __forceinline__ void tr_item(const float* W, int ldw, int srccol, bf16_t* WT, int K, int dst_row0, int k0, float* scr, int lane) {
#pragma unroll 8
    for (int i = 0; i < 32; ++i) { const int kk = 2 * i + (lane >> 5); scr[kk * 33 + (lane & 31)] = srccol >= 0 ? W[(size_t)(k0 + kk) * ldw + srccol] : 0.f; }
    asm volatile("s_waitcnt lgkmcnt(0)" ::: "memory");
    const int c = lane & 7;
#pragma unroll
    for (int j = 0; j < 4; ++j) { const int n = (lane >> 3) + 8 * j; const float* s = scr + (8 * c) * 33 + n;
        u32x4 o; o.x = pkbf(s[0 * 33], s[1 * 33]); o.y = pkbf(s[2 * 33], s[3 * 33]); o.z = pkbf(s[4 * 33], s[5 * 33]); o.w = pkbf(s[6 * 33], s[7 * 33]);
        *(u32x4*)(WT + (size_t)(dst_row0 + n) * K + k0 + 8 * c) = o; }
    asm volatile("s_waitcnt lgkmcnt(0)" ::: "memory");
}

__device__ __forceinline__ void p0a(const Ctx& C, unsigned char* smem) {
    const int tid = mk_tid(), lane = tid & 63, wid = tid >> 6;
    const int gtid = blockIdx.x * 512 + tid, GT = gridDim.x * 512;
    for (int i = gtid; i < 4 * MT * 2; i += GT) C.STATS()[i] = 0.f;
    for (int i = gtid; i < 2 * 4 * 128 * 128; i += GT) { const int t = (i >> 7) & 127, s = i & 127; C.GW()[i] = (bf16_t)(pkbf(s <= t ? C.gws()[i] : 0.f, 0.f) & 0xffffu); }
    float* sil = (float*)smem;
    for (int u = blockIdx.x; u < 192; u += gridDim.x) {
        __syncthreads();
        for (int i = tid; i < 32 * 1024; i += 512) { const int cb = i >> 10, k = i & 1023; const float c = cb < 16 ? C.c_prompt()[cb * 1024 + k] : C.c_sample()[(cb - 16) * 1024 + k]; sil[i] = c / (1.f + __expf(-c)); }
        __syncthreads();
        const int l = u / 96, n0 = (u % 96) * 64;
        float acc[32];
#pragma unroll
        for (int cb = 0; cb < 32; ++cb) acc[cb] = 0.f;
        const float* W = C.w_ada() + (size_t)l * 1024 * 6144 + n0 + lane;
        for (int k = wid * 128; k < wid * 128 + 128; k += 4) {
            const float w0 = W[(size_t)k * 6144], w1 = W[(size_t)(k + 1) * 6144], w2 = W[(size_t)(k + 2) * 6144], w3 = W[(size_t)(k + 3) * 6144];
#pragma unroll
            for (int cb = 0; cb < 32; ++cb) { const float4 s = *(const float4*)(sil + cb * 1024 + k); acc[cb] += s.x * w0 + s.y * w1 + s.z * w2 + s.w * w3; }
        }
        __syncthreads();
#pragma unroll
        for (int cb = 0; cb < 32; ++cb) sil[(wid * 32 + cb) * 64 + lane] = acc[cb];
        __syncthreads();
#pragma unroll
        for (int j = 0; j < 4; ++j) { const int o = tid + 512 * j, cb = o >> 6, ln = o & 63; float s = C.b_ada()[l * 6144 + n0 + ln];
#pragma unroll
            for (int w = 0; w < 8; ++w) s += sil[(w * 32 + cb) * 64 + ln];
            C.MOD()[(size_t)(l * 32 + cb) * 6144 + n0 + ln] = s; }
    }
    __syncthreads();
    float* scr = (float*)smem + wid * 2112;
    const int gw = blockIdx.x * 8 + wid, NGW = gridDim.x * 8;
    for (int it = gw; it < 12800; it += NGW) {
        const int l = it / 6400; int r = it % 6400;
        if (r < 1664) { const int kb = r / 104, nb = r % 104, p = nb * 32 + (lane & 31);
            const int sc = p < 1024 ? p : p < 2560 ? p + 8 : p < 3072 ? p + 16 : (p < 3080 ? p - 3072 + 1024 : (p < 3088 ? p - 3080 + 2568 : -1));
            tr_item(C.w_in() + (size_t)l * 1024 * 3088, 3088, sc, C.WIN() + (size_t)l * NINP * 1024, 1024, nb * 32, kb * 64, scr, lane); continue; }
        r -= 1664;
        if (r < 512) { const int kb = r / 32, nb = r % 32;
            tr_item(C.w_o() + (size_t)l * 1024 * 1024, 1024, nb * 32 + (lane & 31), C.WO() + (size_t)l * 1024 * 1024, 1024, nb * 32, kb * 64, scr, lane); continue; }
        r -= 512;
        if (r < 2816) { const int kb = r / 176, nb = r % 176, pn = nb >> 3, wi = nb & 7;
            const float* src = (wi < 4 ? C.w_gate() : C.w_up()) + (size_t)l * 1024 * DFF;
            tr_item(src, DFF, 128 * pn + 32 * (wi & 3) + (lane & 31), C.WGU() + (size_t)l * 5632 * 1024, 1024, nb * 32, kb * 64, scr, lane); continue; }
        r -= 2816;
        { const int kb = r / 32, nb = r % 32;
            tr_item(C.w_down() + (size_t)l * DFF * 1024, 1024, nb * 32 + (lane & 31), C.WD() + (size_t)l * 1024 * DFF, DFF, nb * 32, kb * 64, scr, lane); }
    }
}

__device__ __forceinline__ void p0b(const Ctx& C) {
    const int lane = mk_tid() & 63, wid = mk_tid() >> 6;
    const int gw = blockIdx.x * 8 + wid, NGW = gridDim.x * 8;
    const float* xp = C.x_prompt(); const float* xs = C.x_sample(); const float* MODp = C.MOD(); bf16_t* HAp = C.HA();
    for (int row0 = gw; row0 < MT; row0 += 4 * NGW) {
        float4 xv[4][4];
#pragma unroll
        for (int q = 0; q < 4; ++q) { const int row = row0 + q * NGW < MT ? row0 + q * NGW : row0;
            const float* xr = row < NPT ? xp + (size_t)row * DM : xs + (size_t)(row - NPT) * DM;
#pragma unroll
            for (int j = 0; j < 4; ++j) xv[q][j] = *(const float4*)(xr + 256 * j + 4 * lane); }
#pragma unroll
        for (int q = 0; q < 4; ++q) { const int row = row0 + q * NGW; if (row >= MT) break;
            const float* md = MODp + (size_t)row_cb(row) * 6144;
#pragma unroll
            for (int j = 0; j < 4; ++j) { const int c = 256 * j + 4 * lane; const float4 x = xv[q][j];
                const float4 sh = *(const float4*)(md + c), sc = *(const float4*)(md + 1024 + c);
                u32x2 o; o.x = pkbf(x.x * (1.f + sc.x) + sh.x, x.y * (1.f + sc.y) + sh.y); o.y = pkbf(x.z * (1.f + sc.z) + sh.z, x.w * (1.f + sc.w) + sh.w);
                *(u32x2*)(HAp + (size_t)row * DM + c) = o; } }
    }
}

__device__ __forceinline__ void ln_apply(const bf16_t* __restrict__ R, const float* __restrict__ stats, const float* __restrict__ g, const float* __restrict__ b, const float* __restrict__ mod_sh, const float* __restrict__ mod_sc,
                                         bf16_t* __restrict__ obf, float* __restrict__ of_p, float* __restrict__ of_s, int row_lo, int row_hi, int gw, int NGW) {
    const int lane = mk_tid() & 63;
    for (int row0 = row_lo + gw; row0 < row_hi; row0 += 4 * NGW) {
        u32x2 rr[4][4]; float mean[4], rstd[4];
#pragma unroll
        for (int q = 0; q < 4; ++q) { const int row = row0 + q * NGW < row_hi ? row0 + q * NGW : row0;
#pragma unroll
            for (int j = 0; j < 4; ++j) rr[q][j] = *(const u32x2*)(R + (size_t)row * DM + 256 * j + 4 * lane);
            const float s = __hip_atomic_load(stats + row * 2, __ATOMIC_RELAXED, __HIP_MEMORY_SCOPE_AGENT), ss = __hip_atomic_load(stats + row * 2 + 1, __ATOMIC_RELAXED, __HIP_MEMORY_SCOPE_AGENT);
            mean[q] = s * (1.f / 1024.f); rstd[q] = rsqrtf(fmaxf(ss * (1.f / 1024.f) - mean[q] * mean[q], 0.f) + 1e-5f); }
#pragma unroll
        for (int q = 0; q < 4; ++q) { const int row = row0 + q * NGW; if (row >= row_hi) break;
            const int cb = row_cb(row);
#pragma unroll
            for (int j = 0; j < 4; ++j) { const int c = 256 * j + 4 * lane;
                const float4 gg = *(const float4*)(g + c), bb = *(const float4*)(b + c);
                float4 x;
                x.x = (bf2f(rr[q][j].x & 0xffffu) - mean[q]) * rstd[q] * gg.x + bb.x; x.y = (bf2f(rr[q][j].x >> 16) - mean[q]) * rstd[q] * gg.y + bb.y;
                x.z = (bf2f(rr[q][j].y & 0xffffu) - mean[q]) * rstd[q] * gg.z + bb.z; x.w = (bf2f(rr[q][j].y >> 16) - mean[q]) * rstd[q] * gg.w + bb.w;
                if (of_p) { float* o = row < NPT ? of_p + (size_t)row * DM : of_s + (size_t)(row - NPT) * DM; f32x4 xv_; xv_[0] = x.x; xv_[1] = x.y; xv_[2] = x.z; xv_[3] = x.w; *(f32x4*)(o + c) = xv_; }
                if (obf) { const float4 sh = *(const float4*)(mod_sh + (size_t)cb * 6144 + c), sc = *(const float4*)(mod_sc + (size_t)cb * 6144 + c);
                    u32x2 o; o.x = pkbf(x.x * (1.f + sc.x) + sh.x, x.y * (1.f + sc.y) + sh.y); o.y = pkbf(x.z * (1.f + sc.z) + sh.z, x.w * (1.f + sc.w) + sh.w);
                    *(u32x2*)(obf + (size_t)row * DM + c) = o; }
            } }
    }
}

using pg8::Unit;
struct PanelOrder {
    int c, G, np;
    __device__ __forceinline__ void init(int G_, int c_) { G = G_; c = c_; np = c_ < 256 ? (256 - c_ + G_ - 1) / G_ : 0; }
    __device__ __forceinline__ bool next(int i, Unit& u) const {
        if (i < 4 * np) { u.pm = c + (i >> 2) * G; u.pn = i & 3; return true; }
        const int s = c + (i - 4 * np) * G; if (s < 8) { u.pm = 256 + (s >> 2); u.pn = s & 3; return true; }
        return false; }
    __device__ __forceinline__ void a_ready(const Unit&) const {}
    __device__ __forceinline__ void done(const Unit&) const {}
};
struct EpiInProj {
    static constexpr bool PERM = true, AFTER_DRAIN = false;
    bf16_t* proj; float* gates; float* out; int layer; const float *bi, *bf, *bff;
    __device__ __forceinline__ void operator()(const f32x4 (&acc)[2][2][4][2], const Unit& u, int wr, int wc, int fr, int fq) const {
        const int row0 = u.pm * 256 + wr * 64 + fr, pn = u.pn;
        if (pn < 12) {
            const float sc = (pn == 4 || pn == 5) ? C2 : (pn == 1 ? 0.125f : 1.f);
            const bool f32o = pn >= 6 && pn < 10;
            const int colf0 = ((pn - 6) & 1) * 256 + wc * 32 + 8 * fq;
#pragma unroll
            for (int ai = 0; ai < 2; ++ai)
#pragma unroll
                for (int m = 0; m < 4; ++m) { const int row = row0 + ai * 128 + m * 16;
                    bf16_t* rowp = proj + (size_t)row * PW + pn * 256 + wc * 32 + 8 * fq;
                    float* fo = nullptr;
                    if (f32o) { fo = row < NPT ? out + (pn < 8 ? O_PFK : O_PFV) + ((size_t)layer * NPT + row) * 512 : out + (pn < 8 ? O_SFK : O_SFV) + ((size_t)layer * NST + (row - NPT)) * 512; fo += colf0; }
#pragma unroll
                    for (int bj = 0; bj < 2; ++bj) { const f32x4 v0 = acc[ai][bj][m][0], v1 = acc[ai][bj][m][1];
                        u32x4 w; w.x = pkbf(v0[0] * sc, v0[1] * sc); w.y = pkbf(v0[2] * sc, v0[3] * sc); w.z = pkbf(v1[0] * sc, v1[1] * sc); w.w = pkbf(v1[2] * sc, v1[3] * sc);
                        *(u32x4*)(rowp + bj * 128) = w;
                        if (f32o) { *(f32x4*)(fo + bj * 128) = v0; *(f32x4*)(fo + bj * 128 + 4) = v1; } } }
        } else if (wc == 0 && fq < 2) {
#pragma unroll
            for (int ai = 0; ai < 2; ++ai)
#pragma unroll
                for (int m = 0; m < 4; ++m) { const int row = row0 + ai * 128 + m * 16;
                    const f32x4 v0 = acc[ai][0][m][0], v1 = acc[ai][0][m][1];
                    float* gp = gates + (size_t)row * 16;
                    if (fq == 0) {
                        f32x4 li, lf;
#pragma unroll
                        for (int j = 0; j < 4; ++j) { li[j] = v0[j] + bi[j]; lf[j] = logsig(v1[j] + bf[j]); }
                        *(f32x4*)gp = li; *(f32x4*)(gp + 4) = lf;
                    } else {
                        f32x4 a, b;
#pragma unroll
                        for (int j = 0; j < 4; ++j) { a[j] = logsig(v0[j] + bff[j]); b[j] = logsig(v1[j] + bff[4 + j]); }
                        *(f32x4*)(gp + 8) = a; *(f32x4*)(gp + 12) = b;
                        float* lo = row < NPT ? out + O_PFL + ((size_t)layer * NPT + row) * 8 : out + O_SFL + ((size_t)layer * NST + (row - NPT)) * 8;
                        *(f32x4*)lo = a; *(f32x4*)(lo + 4) = b;
                    } }
        }
    }
};
struct EpiSwiGLU {
    static constexpr bool PERM = true, AFTER_DRAIN = false;
    bf16_t* hid;
    __device__ __forceinline__ void operator()(const f32x4 (&acc)[2][2][4][2], const Unit& u, int wr, int wc, int fr, int fq) const {
        const int row0 = u.pm * 256 + wr * 64 + fr;
#pragma unroll
        for (int ai = 0; ai < 2; ++ai)
#pragma unroll
            for (int m = 0; m < 4; ++m) { const int row = row0 + ai * 128 + m * 16;
                float h[8];
#pragma unroll
                for (int n = 0; n < 2; ++n)
#pragma unroll
                    for (int j = 0; j < 4; ++j) { const float g = acc[ai][0][m][n][j], up = acc[ai][1][m][n][j]; h[4 * n + j] = g * up / (1.f + __expf(-g)); }
                u32x4 w; w.x = pkbf(h[0], h[1]); w.y = pkbf(h[2], h[3]); w.z = pkbf(h[4], h[5]); w.w = pkbf(h[6], h[7]);
                *(u32x4*)(hid + (size_t)row * DFF + u.pn * 128 + wc * 32 + 8 * fq) = w; }
    }
};
template <bool XN> struct EpiRes {
    static constexpr bool PERM = false, AFTER_DRAIN = false;
    const float *xp, *xs;
    const bf16_t* Rp; const float *Sp, *gp, *bp;
    const float* gate;
    bf16_t* R; float* stats;
    __device__ __forceinline__ void operator()(const f32x4 (&acc)[2][2][4][2], const Unit& u, int wr, int wc, int fr, int fq) const {
        const int col0 = u.pn * 256 + wc * 32 + 4 * fq;
#pragma unroll
        for (int ai = 0; ai < 2; ++ai)
#pragma unroll
            for (int m = 0; m < 4; ++m) { const int row = u.pm * 256 + ai * 128 + wr * 64 + m * 16 + fr; const int cb = row_cb(row);
                float mean = 0.f, rstd = 0.f;
                if (XN) { const float s = Sp[row * 2], ss = Sp[row * 2 + 1]; mean = s * (1.f / 1024.f); rstd = rsqrtf(fmaxf(ss * (1.f / 1024.f) - mean * mean, 0.f) + 1e-5f); }
                const float* xr = XN ? nullptr : (row < NPT ? xp + (size_t)row * DM : xs + (size_t)(row - NPT) * DM);
                float ps = 0.f, pss = 0.f;
#pragma unroll
                for (int bj = 0; bj < 2; ++bj)
#pragma unroll
                    for (int n = 0; n < 2; ++n) { const int c = col0 + bj * 128 + n * 16;
                        f32x4 x;
                        if (XN) { const u32x2 rr = *(const u32x2*)(Rp + (size_t)row * DM + c); const f32x4 gg = *(const f32x4*)(gp + c), bb = *(const f32x4*)(bp + c);
                            x[0] = (bf2f(rr.x & 0xffffu) - mean) * rstd * gg[0] + bb[0]; x[1] = (bf2f(rr.x >> 16) - mean) * rstd * gg[1] + bb[1];
                            x[2] = (bf2f(rr.y & 0xffffu) - mean) * rstd * gg[2] + bb[2]; x[3] = (bf2f(rr.y >> 16) - mean) * rstd * gg[3] + bb[3];
                        } else x = *(const f32x4*)(xr + c);
                        const f32x4 gt = *(const f32x4*)(gate + (size_t)cb * 6144 + c);
                        const f32x4 a = acc[ai][bj][m][n];
                        f32x4 r;
#pragma unroll
                        for (int j = 0; j < 4; ++j) { r[j] = ALPHA * x[j] + (1.f + gt[j]) * a[j]; ps += r[j]; pss += r[j] * r[j]; }
                        u32x2 w; w.x = pkbf(r[0], r[1]); w.y = pkbf(r[2], r[3]);
                        *(u32x2*)(R + (size_t)row * DM + c) = w; }
                ps += __shfl_xor(ps, 16); ps += __shfl_xor(ps, 32); pss += __shfl_xor(pss, 16); pss += __shfl_xor(pss, 32);
                if (fq == 0) { atomicAdd(stats + row * 2, ps); atomicAdd(stats + row * 2 + 1, pss); } }
    }
};
__device__ __forceinline__ void fcum_unit(const Ctx& C, int b, unsigned char* smem) {
    const int tid = mk_tid();
    float* tot = (float*)smem;
    float pre[8][8];
    const float* gp = C.GATES() + ((size_t)b * SEQ + tid * 8) * 16 + 8;
    float run[8];
#pragma unroll
    for (int h = 0; h < 8; ++h) run[h] = 0.f;
#pragma unroll
    for (int j = 0; j < 8; ++j) { const float4 a = *(const float4*)(gp + j * 16), c = *(const float4*)(gp + j * 16 + 4);
        run[0] += a.x; run[1] += a.y; run[2] += a.z; run[3] += a.w; run[4] += c.x; run[5] += c.y; run[6] += c.z; run[7] += c.w;
#pragma unroll
        for (int h = 0; h < 8; ++h) pre[j][h] = run[h]; }
    __syncthreads();
#pragma unroll
    for (int h = 0; h < 8; ++h) tot[tid * 8 + h] = run[h];
    __syncthreads();
    int cur = 0;
    for (int d = 1; d < 512; d <<= 1) {
        float v[8];
#pragma unroll
        for (int h = 0; h < 8; ++h) { v[h] = tot[cur * 4096 + tid * 8 + h]; if (tid >= d) v[h] += tot[cur * 4096 + (tid - d) * 8 + h]; }
#pragma unroll
        for (int h = 0; h < 8; ++h) tot[(cur ^ 1) * 4096 + tid * 8 + h] = v[h];
        cur ^= 1;
        __syncthreads();
    }
#pragma unroll
    for (int h = 0; h < 8; ++h) { const float off = tid > 0 ? tot[cur * 4096 + (tid - 1) * 8 + h] : 0.f;
        float* o = C.FQ() + ((size_t)(b * 8 + h)) * SEQ + tid * 8;
        float4 a, c; a.x = (off + pre[0][h]) * LOG2E; a.y = (off + pre[1][h]) * LOG2E; a.z = (off + pre[2][h]) * LOG2E; a.w = (off + pre[3][h]) * LOG2E;
        c.x = (off + pre[4][h]) * LOG2E; c.y = (off + pre[5][h]) * LOG2E; c.z = (off + pre[6][h]) * LOG2E; c.w = (off + pre[7][h]) * LOG2E;
        *(float4*)o = a; *(float4*)(o + 4) = c; }
    __syncthreads();
}

constexpr int M1_PAIRB = 18944, TP = 72;
__device__ __forceinline__ void m1_quad(const Ctx& C, int quad, unsigned char* smem) {
    const int tid = mk_tid(), lane = tid & 63, wid = __builtin_amdgcn_readfirstlane(tid >> 6), p = wid >> 1, sub = wid & 1, r32 = lane & 31, hi = lane >> 5;
    const int gc = quad * 4 + p, bh = gc >> 6, c = gc & 63, b = bh >> 2, h = bh & 3;
    const int row0 = b * SEQ + c * 64;
    unsigned char* base = smem + p * M1_PAIRB;
    bf16_t* Kt = (bf16_t*)base; bf16_t* Vt = (bf16_t*)(base + 9216); float* wt = (float*)(base + 18432);
    const int tp = tid & 127;
    u32x4 kpre[4], vpre[4];
#pragma unroll
    for (int j = 0; j < 4; ++j) { const int id = tp + 128 * j, s = id & 63, d8 = (id >> 6) * 8;
        kpre[j] = *(const u32x4*)(C.PROJ() + (size_t)(row0 + s) * PW + 256 + h * 64 + d8);
        vpre[j] = *(const u32x4*)(C.PROJ() + (size_t)(row0 + s) * PW + 512 + h * 64 + d8); }
    if (sub == 0) {
        const float lf = C.GATES()[(size_t)(row0 + lane) * 16 + 4 + h], li = C.GATES()[(size_t)(row0 + lane) * 16 + h];
        float B = lf;
#pragma unroll
        for (int o = 1; o < 64; o <<= 1) { const float t = __shfl_up(B, o); if (lane >= o) B += t; }
        const float g = li - B, G = wmax(g), a = __shfl(B, 63);
        wt[lane] = __expf(g - G);
        if (lane == 0) { C.AB()[gc * 2] = a; C.AB()[gc * 2 + 1] = a + G; }
    }
    __syncthreads();
#pragma unroll
    for (int j = 0; j < 4; ++j) { const int id = tp + 128 * j, s = id & 63, d8 = (id >> 6) * 8;
        const u32x4 kk = kpre[j], vv = vpre[j];
        float f[8]; unpack8(kk, f); const float w = wt[s];
        u32x4 kw; kw.x = pkbf(f[0] * w, f[1] * w); kw.y = pkbf(f[2] * w, f[3] * w); kw.z = pkbf(f[4] * w, f[5] * w); kw.w = pkbf(f[6] * w, f[7] * w);
        *(u32x4*)(Kt + s * TP + d8) = kw; *(u32x4*)(Vt + s * TP + d8) = vv; }
    __syncthreads();
    f32x16 acc[2]; acc[0] = f32x16{}; acc[1] = f32x16{};
#pragma unroll
    for (int ks = 0; ks < 4; ++ks) {
        const bf16x8 a = gather8(Kt + (16 * ks + 8 * hi) * TP + 32 * sub + r32, TP, 4);
#pragma unroll
        for (int bj = 0; bj < 2; ++bj) { const bf16x8 bb = gather8(Vt + (16 * ks + 8 * hi) * TP + 32 * bj + r32, TP, 4);
            acc[bj] = __builtin_amdgcn_mfma_f32_32x32x16_bf16(a, bb, acc[bj], 0, 0, 0); }
    }
    float* U = C.UT() + (size_t)gc * 4160;
#pragma unroll
    for (int bj = 0; bj < 2; ++bj)
#pragma unroll
        for (int a4 = 0; a4 < 4; ++a4) { f32x4 v; v[0] = acc[bj][4 * a4]; v[1] = acc[bj][4 * a4 + 1]; v[2] = acc[bj][4 * a4 + 2]; v[3] = acc[bj][4 * a4 + 3];
            *(f32x4*)(U + (32 * bj + r32) * 64 + 32 * sub + 8 * a4 + 4 * hi) = v; }
    { float su = 0.f;
#pragma unroll 8
        for (int s = 0; s < 32; ++s) su += bf2f(Kt[(32 * hi + s) * TP + 32 * sub + r32]);
        su += __shfl_xor(su, 32);
        if (hi == 0) U[4096 + 32 * sub + r32] = su; }
    __syncthreads();
}

__device__ __forceinline__ void scan_phase(const Ctx& C, int l) {
    const int gtid = blockIdx.x * 512 + mk_tid(), GT = gridDim.x * 512;
    for (int idx = gtid; idx < 64 * 2080; idx += GT) {
        const int bh = idx / 2080, e = (idx % 2080) * 2;
        float s0 = 0.f, s1 = 0.f, m = -INFINITY;
        const float* U = C.UT() + (size_t)bh * 64 * 4160 + e; const float* ab = C.AB() + bh * 128;
#pragma unroll 8
        for (int c = 0; c < 64; ++c) { const int gc = bh * 64 + c;
            if (e < 4096) *(unsigned*)(C.CS() + (size_t)gc * 4096 + e) = pkbf(s0, s1); else { float2 o; o.x = s0; o.y = s1; *(float2*)(C.NS() + gc * 64 + e - 4096) = o; }
            if (e == 0) C.MS()[gc] = m;
            const float2 abv = *(const float2*)(ab + 2 * c); const float2 u = *(const float2*)(U + (size_t)c * 4160);
            const float mn = fmaxf(m + abv.x, abv.y);
            const float f0 = __expf(m + abv.x - mn), f1 = __expf(abv.y - mn);
            s0 = f0 * s0 + f1 * u.x; s1 = f0 * s1 + f1 * u.y; m = mn; }
        const int b_ = bh >> 2, h = bh & 3;
        if (e < 4096) { const int dv = e >> 6, dk = e & 63; float* o = C.out + O_PMC + ((size_t)((l * 16 + b_) * 4 + h)) * 4096 + dk * 64 + dv; o[0] = s0; o[64] = s1; }
        else { float* o = C.out + O_PMN + ((l * 16 + b_) * 4 + h) * 64 + e - 4096; o[0] = s0; o[1] = s1; }
        if (e == 0) C.out[O_PMM + (l * 16 + b_) * 4 + h] = m;
    }
}

constexpr int M3_PAIRB = 27136;
__device__ __forceinline__ void m3_quad(const Ctx& C, int l, int quad, unsigned char* smem) {
    const int tid = mk_tid(), lane = tid & 63, wid = __builtin_amdgcn_readfirstlane(tid >> 6), p = wid >> 1, tb = wid & 1, r32 = lane & 31, hi = lane >> 5;
    const int gc = quad * 4 + p, bh = gc >> 6, c = gc & 63, b = bh >> 2, h = bh & 3;
    const int row0 = b * SEQ + c * 64;
    unsigned char* base = smem + p * M3_PAIRB;
    bf16_t* Vt = (bf16_t*)base; float* tg = (float*)(base + 9216); float* tmu = tg + 64; float* te = tg + 128; float* tmt = tg + 192; float* tn0 = tg + 256;
    float* Hs = (float*)(base + 9216 + 1280) + tb * 2080;
    const int t = 32 * tb + r32;
    bf16x8 qf[4], kfr[2][4], cbf[2][4]; u32x4 mof[4];
#pragma unroll
    for (int ds = 0; ds < 4; ++ds) qf[ds] = *(const bf16x8*)(C.PROJ() + (size_t)(row0 + t) * PW + h * 64 + 16 * ds + 8 * hi);
#pragma unroll
    for (int sb = 0; sb < 2; ++sb) if (sb <= tb) {
#pragma unroll
        for (int ds = 0; ds < 4; ++ds) kfr[sb][ds] = *(const bf16x8*)(C.PROJ() + (size_t)(row0 + 32 * sb + r32) * PW + 256 + h * 64 + 16 * ds + 8 * hi); }
#pragma unroll
    for (int bj = 0; bj < 2; ++bj)
#pragma unroll
        for (int ds = 0; ds < 4; ++ds) cbf[bj][ds] = *(const bf16x8*)(C.CS() + (size_t)gc * 4096 + (32 * bj + r32) * 64 + 16 * ds + 8 * hi);
#pragma unroll
    for (int j8 = 0; j8 < 4; ++j8) mof[j8] = *(const u32x4*)(C.PROJ() + (size_t)(row0 + t) * PW + 768 + h * 64 + 32 * hi + 8 * j8);
    if (tb == 0) {
        const float lf = C.GATES()[(size_t)(row0 + lane) * 16 + 4 + h], li = C.GATES()[(size_t)(row0 + lane) * 16 + h];
        float B = lf;
#pragma unroll
        for (int o = 1; o < 64; o <<= 1) { const float t = __shfl_up(B, o); if (lane >= o) B += t; }
        const float g = li - B; float G = g;
#pragma unroll
        for (int o = 1; o < 64; o <<= 1) { const float t = __shfl_up(G, o); if (lane >= o) G = fmaxf(G, t); }
        const float m0 = C.MS()[gc], mu = fmaxf(m0, G);
        tg[lane] = g; tmu[lane] = mu; te[lane] = __expf(m0 - mu); tmt[lane] = B + mu; tn0[lane] = C.NS()[gc * 64 + lane];
    }
    { const int tp = tid & 127;
#pragma unroll
        for (int j = 0; j < 4; ++j) { const int id = tp + 128 * j, s = id & 63, d8 = (id >> 6) * 8;
            *(u32x4*)(Vt + s * TP + d8) = *(const u32x4*)(C.PROJ() + (size_t)(row0 + s) * PW + 512 + h * 64 + d8); } }
    __syncthreads();
    f32x16 st[2]; st[0] = f32x16{}; st[1] = f32x16{};
#pragma unroll
    for (int sb = 0; sb < 2; ++sb) if (sb <= tb) {
#pragma unroll
        for (int ds = 0; ds < 4; ++ds) st[sb] = __builtin_amdgcn_mfma_f32_32x32x16_bf16(kfr[sb][ds], qf[ds], st[sb], 0, 0, 0); }
    const float mu_t = tmu[t], e_t = te[t];
    float den = 0.f;
#pragma unroll
    for (int sb = 0; sb < 2; ++sb) if (sb <= tb) {
#pragma unroll
        for (int r = 0; r < 16; ++r) { const int s = 32 * sb + crow(r, hi); const float w = (s <= t) ? __expf(tg[s] - mu_t) : 0.f; st[sb][r] *= w; den += st[sb][r]; } }
    den += __shfl_xor(den, 32);
    f32x16 acc[2]; acc[0] = f32x16{}; acc[1] = f32x16{};
#pragma unroll
    for (int sb = 0; sb < 2; ++sb) if (sb <= tb) {
#pragma unroll
        for (int kk = 0; kk < 2; ++kk) { u32x4 pw; pw.x = pkbf(st[sb][8 * kk], st[sb][8 * kk + 1]); pw.y = pkbf(st[sb][8 * kk + 2], st[sb][8 * kk + 3]);
            pw.z = pkbf(st[sb][8 * kk + 4], st[sb][8 * kk + 5]); pw.w = pkbf(st[sb][8 * kk + 6], st[sb][8 * kk + 7]);
            const bf16x8 pa = __builtin_bit_cast(bf16x8, pw);
#pragma unroll
            for (int bj = 0; bj < 2; ++bj) { const bf16x8 vb = gather8(Vt + (32 * sb + 16 * kk + 4 * hi) * TP + 32 * bj + r32, TP, 8);
                acc[bj] = __builtin_amdgcn_mfma_f32_32x32x16_bf16(pa, vb, acc[bj], 0, 0, 0); } } }
    float qn = 0.f;
#pragma unroll
    for (int ds = 0; ds < 4; ++ds) { float f[8]; unpack8(__builtin_bit_cast(u32x4, qf[ds]), f);
#pragma unroll
        for (int j = 0; j < 8; ++j) qn += f[j] * tn0[16 * ds + 8 * hi + j];
        u32x4 qs; qs.x = pkbf(f[0] * e_t, f[1] * e_t); qs.y = pkbf(f[2] * e_t, f[3] * e_t); qs.z = pkbf(f[4] * e_t, f[5] * e_t); qs.w = pkbf(f[6] * e_t, f[7] * e_t);
        const bf16x8 qa = __builtin_bit_cast(bf16x8, qs);
#pragma unroll
        for (int bj = 0; bj < 2; ++bj) acc[bj] = __builtin_amdgcn_mfma_f32_32x32x16_bf16(qa, cbf[bj][ds], acc[bj], 0, 0, 0); }
    qn += __shfl_xor(qn, 32);
    den += e_t * qn;
    const float rden = 1.f / fmaxf(fabsf(den), __expf(-tmt[t]));
#pragma unroll
    for (int bj = 0; bj < 2; ++bj)
#pragma unroll
        for (int r = 0; r < 16; ++r) Hs[crow(r, hi) * 65 + 32 * bj + r32] = acc[bj][r];
    asm volatile("s_waitcnt lgkmcnt(0)" ::: "memory");
    float hv[32]; float s1 = 0.f;
#pragma unroll
    for (int j = 0; j < 32; ++j) { hv[j] = Hs[r32 * 65 + 32 * hi + j] * rden; s1 += hv[j]; }
    s1 += __shfl_xor(s1, 32);
    const float mean = s1 * (1.f / 64.f); float s2 = 0.f;
#pragma unroll
    for (int j = 0; j < 32; ++j) { hv[j] -= mean; s2 += hv[j] * hv[j]; }
    s2 += __shfl_xor(s2, 32);
    const float rstd = rsqrtf(s2 * (1.f / 64.f) + 1e-6f);
    const size_t row = (size_t)row0 + t;
    const float* ng = C.norm_g() + l * 256 + h * 64 + 32 * hi;
#pragma unroll
    for (int j8 = 0; j8 < 4; ++j8) { float mo[8]; unpack8(mof[j8], mo);
        float o[8];
#pragma unroll
        for (int j = 0; j < 8; ++j) o[j] = hv[8 * j8 + j] * rstd * ng[8 * j8 + j] * sigm(mo[j]);
        u32x4 w; w.x = pkbf(o[0], o[1]); w.y = pkbf(o[2], o[3]); w.z = pkbf(o[4], o[5]); w.w = pkbf(o[6], o[7]);
        *(u32x4*)(C.HA() + row * DM + h * 64 + 32 * hi + 8 * j8) = w; }
    __syncthreads();
}

constexpr int GP = 264;
__device__ __forceinline__ void gmlp_unit(const Ctx& C, int l, int unit, unsigned char* smem) {
    const int tid = mk_tid(), lane = tid & 63, wid = __builtin_amdgcn_readfirstlane(tid >> 6), r32 = lane & 31, hi = lane >> 5;
    const int row0 = unit * 128;
    bf16_t* vn = (bf16_t*)smem;
    const float4 lg = *(const float4*)(C.gln_g() + l * 256 + 4 * lane), lb = *(const float4*)(C.gln_b() + l * 256 + 4 * lane);
    u32x2 rpre[16];
#pragma unroll
    for (int i = 0; i < 16; ++i) rpre[i] = *(const u32x2*)(C.PROJ() + (size_t)(row0 + wid * 16 + i) * PW + 2816 + 4 * lane);
#pragma unroll
    for (int i = 0; i < 16; ++i) { const int s = wid * 16 + i;
        const u32x2 rr = rpre[i];
        float v0 = bf2f(rr.x & 0xffffu), v1 = bf2f(rr.x >> 16), v2 = bf2f(rr.y & 0xffffu), v3 = bf2f(rr.y >> 16);
        const float mean = wsum((v0 + v1) + (v2 + v3)) * (1.f / 256.f);
        v0 -= mean; v1 -= mean; v2 -= mean; v3 -= mean;
        const float rstd = rsqrtf(wsum((v0 * v0 + v1 * v1) + (v2 * v2 + v3 * v3)) * (1.f / 256.f) + 1e-5f);
        u32x2 o; o.x = pkbf(v0 * rstd * lg.x + lb.x, v1 * rstd * lg.y + lb.y); o.y = pkbf(v2 * rstd * lg.z + lb.z, v3 * rstd * lg.w + lb.w);
        *(u32x2*)(vn + s * GP + 4 * lane) = o; }
    __syncthreads();
    const int g = wid >> 1, th = wid & 1;
    const bf16_t* W = C.GW() + (size_t)(l * 4 + g) * 128 * 128;
    f32x16 acc[2][2];
#pragma unroll
    for (int i = 0; i < 2; ++i) { acc[i][0] = f32x16{}; acc[i][1] = f32x16{}; }
#pragma unroll
    for (int ks = 0; ks < 8; ++ks) {
        bf16x8 bfr[2];
        if (ks < 4 * th + 4) {
#pragma unroll
            for (int cbk = 0; cbk < 2; ++cbk) bfr[cbk] = gather8(vn + (16 * ks + 8 * hi) * GP + g * 64 + 32 * cbk + r32, GP, 4);
#pragma unroll
            for (int i = 0; i < 2; ++i) { const int tbk = 2 * th + i;
                if (ks < 2 * tbk + 2) { const bf16x8 a = *(const bf16x8*)(W + (32 * tbk + r32) * 128 + 16 * ks + 8 * hi);
                    acc[i][0] = __builtin_amdgcn_mfma_f32_32x32x16_bf16(a, bfr[0], acc[i][0], 0, 0, 0);
                    acc[i][1] = __builtin_amdgcn_mfma_f32_32x32x16_bf16(a, bfr[1], acc[i][1], 0, 0, 0); } }
        }
    }
    __syncthreads();
    float* Z = (float*)smem;
#pragma unroll
    for (int i = 0; i < 2; ++i)
#pragma unroll
        for (int cbk = 0; cbk < 2; ++cbk)
#pragma unroll
            for (int r = 0; r < 16; ++r) Z[(32 * (2 * th + i) + crow(r, hi)) * 257 + g * 64 + 32 * cbk + r32] = acc[i][cbk][r];
    __syncthreads();
#pragma unroll
    for (int j = 0; j < 8; ++j) { const int id = tid + 512 * j, t = id >> 5, c8 = (id & 31) * 8;
        float gu[8]; unpack8(*(const u32x4*)(C.PROJ() + (size_t)(row0 + t) * PW + 2560 + c8), gu);
        const float bsv = C.gbs()[(size_t)(l * 4 + (c8 >> 6)) * 128 + t];
        const float* z = Z + t * 257 + c8;
        u32x4 w; w.x = pkbf(gu[0] * (z[0] + bsv), gu[1] * (z[1] + bsv)); w.y = pkbf(gu[2] * (z[2] + bsv), gu[3] * (z[3] + bsv));
        w.z = pkbf(gu[4] * (z[4] + bsv), gu[5] * (z[5] + bsv)); w.w = pkbf(gu[6] * (z[6] + bsv), gu[7] * (z[7] + bsv));
        *(u32x4*)(C.HA() + (size_t)(row0 + t) * DM + 768 + c8) = w; }
    __syncthreads();
}

__device__ __forceinline__ void gmlp_sample_unit(const Ctx& C, int l, int bs_, unsigned char* smem) {
    const int tid = mk_tid(), lane = tid & 63, wid = __builtin_amdgcn_readfirstlane(tid >> 6);
    float* vn = (float*)smem;
    float* wl = vn + 32 * 257;
    const int row0 = NPT + bs_ * 32;
    for (int i = tid; i < 4096; i += 512) { const int g = i >> 10, t = (i >> 5) & 31, s2 = i & 31; wl[(g * 32 + t) * 33 + s2] = C.gws()[((size_t)(l * 4 + g) * 128 + t) * 128 + s2]; }
    const float4 lg = *(const float4*)(C.gln_g() + l * 256 + 4 * lane), lb = *(const float4*)(C.gln_b() + l * 256 + 4 * lane);
    for (int i = 0; i < 4; ++i) { const int s = wid * 4 + i;
        const u32x2 rr = *(const u32x2*)(C.PROJ() + (size_t)(row0 + s) * PW + 2816 + 4 * lane);
        float v0 = bf2f(rr.x & 0xffffu), v1 = bf2f(rr.x >> 16), v2 = bf2f(rr.y & 0xffffu), v3 = bf2f(rr.y >> 16);
        const float mean = wsum((v0 + v1) + (v2 + v3)) * (1.f / 256.f);
        v0 -= mean; v1 -= mean; v2 -= mean; v3 -= mean;
        const float rstd = rsqrtf(wsum((v0 * v0 + v1 * v1) + (v2 * v2 + v3 * v3)) * (1.f / 256.f) + 1e-5f);
        float4 o; o.x = v0 * rstd * lg.x + lb.x; o.y = v1 * rstd * lg.y + lb.y; o.z = v2 * rstd * lg.z + lb.z; o.w = v3 * rstd * lg.w + lb.w;
        vn[s * 257 + 4 * lane] = o.x; vn[s * 257 + 4 * lane + 1] = o.y; vn[s * 257 + 4 * lane + 2] = o.z; vn[s * 257 + 4 * lane + 3] = o.w;
        *(float4*)(C.out + O_SGV + ((size_t)(l * 16 + bs_) * 32 + s) * 256 + 4 * lane) = o; }
    __syncthreads();
    for (int j = 0; j < 16; ++j) { const int o = tid + 512 * j, t = o >> 8, cc = o & 255, g = cc >> 6;
        const float* w = wl + (g * 32 + t) * 33;
        float z = C.gbs()[(l * 4 + g) * 128 + t];
        for (int s = 0; s <= t; ++s) z += w[s] * vn[s * 257 + cc];
        const float gu = bf2f(C.PROJ()[(size_t)(row0 + t) * PW + 2560 + cc]);
        C.HA()[(size_t)(row0 + t) * DM + 768 + cc] = (bf16_t)(pkbf(gu * z, 0.f) & 0xffffu); }
    __syncthreads();
}

__device__ __forceinline__ void mlstm_sample_unit(const Ctx& C, int l, int unit, unsigned char* smem) {
    const int tid = mk_tid(), bs_ = unit >> 2, h = unit & 3;
    const int row0 = NPT + bs_ * 32;
    float* q = (float*)smem; float* k = q + 32 * 65; float* v = k + 32 * 65; float* P = v + 32 * 65;
    float* Hh = P + 32 * 33;
    float* tB = Hh + 32 * 65; float* tg = tB + 32; float* tmu = tg + 32; float* te = tmu + 32; float* tmt = te + 32; float* trd = tmt + 32; float* tmean = trd + 32; float* trs = tmean + 32; float* tw = trs + 32; float* C0s = tw + 64; float* n0s = C0s + 4096; float* tlf = n0s + 64; float* tli = tlf + 32;
    const size_t sidx = (size_t)(l * 16 + bs_) * 4 + h;
    int zo = 0; asm volatile("" : "+v"(zo));
    const float* C0g = C.st_C() + sidx * 4096; const float* n0g = C.st_n() + sidx * 64; const float m0 = C.st_m()[sidx];
    for (int i = tid; i < 1024; i += 512) *(float4*)(C0s + 4 * i) = *(const float4*)(C0g + 4 * i);
    if (tid < 64) n0s[tid] = n0g[tid];
    if (tid >= 64 && tid < 96) { const int t = tid - 64; tlf[t] = C.GATES()[(size_t)(row0 + t) * 16 + 4 + h]; tli[t] = C.GATES()[(size_t)(row0 + t) * 16 + h]; }
    const float* C0 = C0s; const float* n0 = n0s;
    for (int i = tid; i < 32 * 64; i += 512) { const int t = i >> 6, d = i & 63; const bf16_t* pr = C.PROJ() + (size_t)(row0 + t) * PW + h * 64 + d;
        q[t * 65 + d] = bf2f(pr[0]); k[t * 65 + d] = bf2f(pr[256]); v[t * 65 + d] = bf2f(pr[512]); }
    __syncthreads();
    if (tid == 0) { float B = 0.f, G = -INFINITY;
        for (int t = 0; t < 32; ++t) { const float lf = tlf[t], li = tli[t];
            B += lf; const float g = li - B; G = fmaxf(G, g); const float mu = fmaxf(m0, G);
            tB[t] = B; tg[t] = g; tmu[t] = mu; te[t] = __expf(m0 - mu); tmt[t] = B + mu; }
        const float mend = B + fmaxf(m0, G);
        for (int s = 0; s < 32; ++s) tw[s] = __expf(B + tg[s] - mend);
        tw[32] = __expf(m0 + B - mend); tw[33] = mend; }
    __syncthreads();
    for (int j = 0; j < 2; ++j) { const int t = tid >> 4, s = (tid & 15) + 16 * j; float d = 0.f;
        if (s <= t) { for (int e = 0; e < 64; ++e) d += q[t * 65 + e] * k[s * 65 + e]; d *= __expf(tg[s] - tmu[t]); }
        P[t * 33 + s] = d; }
    __syncthreads();
    if (tid < 32) { const int t = tid; float den = 0.f, qn = 0.f;
        for (int s = 0; s < 32; ++s) den += P[t * 33 + s];
        for (int e = 0; e < 64; ++e) qn += q[t * 65 + e] * n0[e + zo];
        den += te[t] * qn; trd[t] = 1.f / fmaxf(fabsf(den), __expf(-tmt[t])); }
    __syncthreads();
    { const int t = tid >> 4, d4 = (tid & 15) * 4; float a0 = 0.f, a1 = 0.f, a2 = 0.f, a3 = 0.f, c0 = 0.f, c1 = 0.f, c2 = 0.f, c3 = 0.f;
        for (int s = 0; s < 32; ++s) { const float p = P[t * 33 + s]; a0 += p * v[s * 65 + d4]; a1 += p * v[s * 65 + d4 + 1]; a2 += p * v[s * 65 + d4 + 2]; a3 += p * v[s * 65 + d4 + 3]; }
        for (int e = 0; e < 64; ++e) { const float qq = q[t * 65 + e]; const float4 cc = *(const float4*)(C0 + e * 64 + d4); c0 += qq * cc.x; c1 += qq * cc.y; c2 += qq * cc.z; c3 += qq * cc.w; }
        const float et = te[t], rd = trd[t];
        Hh[t * 65 + d4] = (a0 + et * c0) * rd; Hh[t * 65 + d4 + 1] = (a1 + et * c1) * rd; Hh[t * 65 + d4 + 2] = (a2 + et * c2) * rd; Hh[t * 65 + d4 + 3] = (a3 + et * c3) * rd; }
    __syncthreads();
    if (tid < 32) { float s1 = 0.f; for (int e = 0; e < 64; ++e) s1 += Hh[tid * 65 + e]; const float mean = s1 * (1.f / 64.f); float s2 = 0.f;
        for (int e = 0; e < 64; ++e) { const float d = Hh[tid * 65 + e] - mean; s2 += d * d; }
        tmean[tid] = mean; trs[tid] = rsqrtf(s2 * (1.f / 64.f) + 1e-6f); }
    __syncthreads();
    { const int t = tid >> 4, d4 = (tid & 15) * 4; const size_t row = (size_t)row0 + t; float o[4];
#pragma unroll
        for (int j = 0; j < 4; ++j) { const float mo = bf2f(C.PROJ()[row * PW + 768 + h * 64 + d4 + j]);
            o[j] = (Hh[t * 65 + d4 + j] - tmean[t]) * trs[t] * C.norm_g()[l * 256 + h * 64 + d4 + j] * sigm(mo); }
        u32x2 w; w.x = pkbf(o[0], o[1]); w.y = pkbf(o[2], o[3]); *(u32x2*)(C.HA() + row * DM + h * 64 + d4) = w; }
    { const int dk = tid >> 3, dv8 = (tid & 7) * 8; const float d0 = tw[32]; float a[8];
#pragma unroll
        for (int j = 0; j < 8; ++j) a[j] = d0 * C0[dk * 64 + dv8 + j];
        for (int s = 0; s < 32; ++s) { const float wk = tw[s + zo] * k[s * 65 + dk];
#pragma unroll
            for (int j = 0; j < 8; ++j) a[j] += wk * v[s * 65 + dv8 + j]; }
        float* o = C.out + O_SMC + sidx * 4096 + dk * 64 + dv8;
#pragma unroll
        for (int j = 0; j < 8; ++j) o[j] = a[j]; }
    if (tid < 64) { float a = tw[32] * n0[tid]; for (int s = 0; s < 32; ++s) a += tw[s + zo] * k[s * 65 + tid]; C.out[O_SMN + sidx * 64 + tid] = a; }
    if (tid == 0) C.out[O_SMM + sidx] = tw[33];
    __syncthreads();
}

__device__ __forceinline__ bf16x8 cvt8(const float* p) {
    const float4 a = *(const float4*)p, b = *(const float4*)(p + 4);
    u32x4 w; w.x = pkbf(a.x, a.y); w.y = pkbf(a.z, a.w); w.z = pkbf(b.x, b.y); w.w = pkbf(b.z, b.w);
    return __builtin_bit_cast(bf16x8, w);
}
__device__ __forceinline__ void fox_sample_unit(const Ctx& C, int l, int unit, unsigned char* smem) {
    const int tid = mk_tid(), lane = tid & 63, wid = __builtin_amdgcn_readfirstlane(tid >> 6), r32 = lane & 31, hi = lane >> 5, bs_ = unit >> 3, h = unit & 7;
    constexpr int NS_ = 1056;
    float* F = (float*)smem;
    float* pm = F + 1088;
    float* pl = pm + 256;
    float* wsc = pl + 256;
    float* pO = wsc + 256;
    const int row0 = NPT + bs_ * 32;
    const size_t cbase = (size_t)(l * 16 + bs_);
    if (wid == 0) {
        float v[17]; float tot = 0.f;
#pragma unroll
        for (int j = 0; j < 17; ++j) { const int s = lane * 17 + j; float x = 0.f;
            if (s < 1024) x = C.cache_logf()[(cbase * 1024 + s) * 8 + h]; else if (s < NS_) x = C.GATES()[(size_t)(row0 + s - 1024) * 16 + 8 + h];
            tot += x; v[j] = tot; }
        float inc = tot;
#pragma unroll
        for (int o = 1; o < 64; o <<= 1) { const float t = __shfl_up(inc, o); if (lane >= o) inc += t; }
        const float off = inc - tot;
#pragma unroll
        for (int j = 0; j < 17; ++j) { const int s = lane * 17 + j; if (s < NS_) F[s] = (off + v[j]) * LOG2E; }
    }
    bf16x8 qf[4];
#pragma unroll
    for (int ds = 0; ds < 4; ++ds) qf[ds] = *(const bf16x8*)(C.PROJ() + (size_t)(row0 + r32) * PW + 1024 + h * 64 + 16 * ds + 8 * hi);
    __syncthreads();
    const float Fq = F[1024 + r32];
    float m_run = -INFINITY, l_run = 0.f;
    f32x16 o[2]; o[0] = f32x16{}; o[1] = f32x16{};
    float* mysc = wsc + wid * 32;
    for (int kb = wid; kb < 33; kb += 8) {
        const int key0 = 32 * kb;
        const float* kbase = kb < 32 ? C.cache_k() + ((cbase * 1024 + key0) * 8 + h) * 64 : C.out + O_SFK + ((cbase * 32) * 8 + h) * 64;
        const float* vbase = kb < 32 ? C.cache_v() + ((cbase * 1024 + key0) * 8 + h) * 64 : C.out + O_SFV + ((cbase * 32) * 8 + h) * 64;
        f32x16 st = f32x16{};
#pragma unroll
        for (int ds = 0; ds < 4; ++ds) { const bf16x8 a = cvt8(kbase + (size_t)r32 * 512 + 16 * ds + 8 * hi); st = __builtin_amdgcn_mfma_f32_32x32x16_bf16(a, qf[ds], st, 0, 0, 0); }
        float mx = -INFINITY;
#pragma unroll
        for (int r = 0; r < 16; ++r) { const int key = key0 + crow(r, hi); float v = st[r] + Fq - F[key]; if (key > 1024 + r32) v = -INFINITY; st[r] = v; mx = fmaxf(mx, v); }
        mx = fmaxf(mx, __shfl_xor(mx, 32));
        const float m_new = fmaxf(m_run, mx), sc = exp2f(m_run - m_new);
        m_run = m_new; l_run *= sc;
        if (hi == 0) mysc[r32] = sc;
        float ps = 0.f;
#pragma unroll
        for (int r = 0; r < 16; ++r) { st[r] = exp2f(st[r] - m_new); ps += st[r]; }
        l_run += ps;
        asm volatile("s_waitcnt lgkmcnt(0)" ::: "memory");
#pragma unroll
        for (int r = 0; r < 16; ++r) { const float f = mysc[crow(r, hi)]; o[0][r] *= f; o[1][r] *= f; }
#pragma unroll
        for (int kk = 0; kk < 2; ++kk) { u32x4 pw; pw.x = pkbf(st[8 * kk], st[8 * kk + 1]); pw.y = pkbf(st[8 * kk + 2], st[8 * kk + 3]); pw.z = pkbf(st[8 * kk + 4], st[8 * kk + 5]); pw.w = pkbf(st[8 * kk + 6], st[8 * kk + 7]);
            const bf16x8 pa = __builtin_bit_cast(bf16x8, pw);
#pragma unroll
            for (int bj = 0; bj < 2; ++bj) { const float* vp = vbase + (size_t)(16 * kk + 4 * hi) * 512 + 32 * bj + r32;
                u32x4 vw; vw.x = pkbf(vp[0], vp[512]); vw.y = pkbf(vp[1024], vp[1536]); vw.z = pkbf(vp[4096], vp[4608]); vw.w = pkbf(vp[5120], vp[5632]);
                o[bj] = __builtin_amdgcn_mfma_f32_32x32x16_bf16(pa, __builtin_bit_cast(bf16x8, vw), o[bj], 0, 0, 0); } }
    }
    l_run += __shfl_xor(l_run, 32);
    if (hi == 0) { pm[wid * 32 + r32] = m_run; pl[wid * 32 + r32] = l_run; }
#pragma unroll
    for (int bj = 0; bj < 2; ++bj)
#pragma unroll
        for (int r = 0; r < 16; ++r) pO[(wid * 32 + crow(r, hi)) * 65 + 32 * bj + r32] = o[bj][r];
    __syncthreads();
    { const int t = tid >> 4, c4 = (tid & 15) * 4; float M = -INFINITY;
#pragma unroll
        for (int w = 0; w < 8; ++w) M = fmaxf(M, pm[w * 32 + t]);
        float den = 0.f, n0 = 0.f, n1 = 0.f, n2 = 0.f, n3 = 0.f;
#pragma unroll
        for (int w = 0; w < 8; ++w) { const float f = exp2f(pm[w * 32 + t] - M); den += f * pl[w * 32 + t]; const float* po = pO + (w * 32 + t) * 65 + c4;
            n0 += f * po[0]; n1 += f * po[1]; n2 += f * po[2]; n3 += f * po[3]; }
        const float inv = 1.f / den;
        u32x2 w2; w2.x = pkbf(n0 * inv, n1 * inv); w2.y = pkbf(n2 * inv, n3 * inv);
        *(u32x2*)(C.HA() + (size_t)(row0 + t) * DM + 256 + h * 64 + c4) = w2; }
    __syncthreads();
}
#define LAS __attribute__((address_space(3)))
#define XB_TMO      128
#define XB_XCNT(j)  (256  + 64 * (j))
#define XB_XSUB(j)  (1280 + 64 * (j))
#define XB_XGEN(j)  (2304 + 64 * (j))
#define XB_TOP      3328
#define XB_TOPGEN   3392
#define XCD_BAR_WORDS 3456
#define XB_SPIN_CAP (1u << 18)

__device__ __forceinline__ unsigned xb_ld(unsigned* p)              { return __hip_atomic_load(p, __ATOMIC_RELAXED, __HIP_MEMORY_SCOPE_AGENT); }
__device__ __forceinline__ unsigned xb_add(unsigned* p, unsigned v) { return __hip_atomic_fetch_add(p, v, __ATOMIC_RELAXED, __HIP_MEMORY_SCOPE_AGENT); }
__device__ __forceinline__ unsigned xb_xcc_id() { return (unsigned)__builtin_amdgcn_s_getreg((3 << 11) | 20) & 0xFu; }
#define XB_SPIN(cond, bar) do { unsigned _sp = 0; while (cond) { __builtin_amdgcn_s_sleep(1); \
    if ((++_sp & 255u) == 0u) { if (xb_ld(&(bar)[XB_TMO])) break; if (_sp > XB_SPIN_CAP) { atomicAdd(&(bar)[XB_TMO], 1u); break; } } } } while (0)

struct XcdBarrier {
    unsigned* bar; unsigned x;
    volatile LAS unsigned* st;
};

__device__ __forceinline__ XcdBarrier xcd_barrier_post(unsigned* bar, volatile LAS unsigned* st) {
    XcdBarrier b; b.bar = bar; b.x = xb_xcc_id(); b.st = st;
    if (threadIdx.x == 0) (void)xb_add(&bar[XB_XCNT(b.x)], 1u);
    return b;
}
__device__ __forceinline__ void xcd_barrier_complete(unsigned* bar, unsigned x, unsigned& nloc, unsigned& nx) {
    const unsigned G = gridDim.x * gridDim.y * gridDim.z;
    unsigned sum, cnt, mine, sp = 0u;
    for (;;) {
        sum = 0u; cnt = 0u; mine = 0u;
#pragma unroll
        for (unsigned j = 0; j < 16; ++j) { const unsigned c = xb_ld(&bar[XB_XCNT(j)]); sum += c; cnt += (c > 0u) ? 1u : 0u; mine = (j == x) ? c : mine; }
        if (sum == G) break;
        __builtin_amdgcn_s_sleep(1);
        if ((++sp & 255u) == 0u) { if (xb_ld(&bar[XB_TMO])) break; if (sp > XB_SPIN_CAP) { atomicAdd(&bar[XB_TMO], 1u); break; } }
    }
    nloc = mine > 0u ? mine : 1u; nx = cnt > 0u ? cnt : 1u;
}

__device__ __forceinline__ void xcd_barrier(const XcdBarrier& b) {
    asm volatile("s_waitcnt vmcnt(0)" ::: "memory");
    __syncthreads();
    if (threadIdx.x == 0) {
        unsigned* bar = b.bar;
        __builtin_amdgcn_s_waitcnt(0);
        unsigned nloc = b.st[0], nx = b.st[1];
        if (nloc == 0u) { xcd_barrier_complete(bar, b.x, nloc, nx); b.st[0] = nloc; b.st[1] = nx; }
        const unsigned old = xb_add(&bar[XB_XSUB(b.x)], 1u);
        const unsigned gen = old / nloc;
        if (old + 1u == (gen + 1u) * nloc) {
            __builtin_amdgcn_fence(__ATOMIC_RELEASE, "agent");
            asm volatile("s_waitcnt vmcnt(0)" ::: "memory");
            const unsigned og = xb_add(&bar[XB_TOP], 1u);
            const unsigned tg = og / nx;
            if (og + 1u == (tg + 1u) * nx) xb_add(&bar[XB_TOPGEN], 1u);
            else XB_SPIN(xb_ld(&bar[XB_TOPGEN]) == tg, bar);
            __builtin_amdgcn_fence(__ATOMIC_ACQUIRE, "agent");
            xb_add(&bar[XB_XGEN(b.x)], 1u);
            asm volatile("s_waitcnt vmcnt(0)" ::: "memory");
        } else {
            XB_SPIN(xb_ld(&bar[XB_XGEN(b.x)]) == gen, bar);
            __builtin_amdgcn_fence(__ATOMIC_ACQUIRE, "agent");
            asm volatile("s_waitcnt vmcnt(0)" ::: "memory");
        }
    }
    __syncthreads();
}

struct Args { const float* in[29]; float* out; unsigned char* ws; int ph_lo, ph_hi; };
constexpr int N_PHASES = 20;
#ifndef MK_ONLY
#define MK_ONLY -1
#endif
#define PH(k) (MK_ONLY < 0 || MK_ONLY == (k))
#ifndef MK_SUB
#define MK_SUB -1
#endif
#define SUB(j) ((MK_SUB < 0 || MK_SUB == (j)) && (rep == 0 || MK_REP_SUB < 0 || MK_REP_SUB == (j)))
#ifndef MK_REP_K
#define MK_REP_K -1000
#endif
#ifndef MK_REP_MASK
#define MK_REP_MASK 0
#endif
#ifndef MK_REP_N
#define MK_REP_N 1
#endif
#ifndef MK_REP_SUB
#define MK_REP_SUB -1
#endif

template <class Epi> __device__ __forceinline__ void run_gemm(int G, int bx, unsigned char* smem, const bf16_t* A, const bf16_t* Bt, int N, int K, const Epi& E) {
    pg8::Gemm g{A, Bt, MT, N, K}; pg8::StaticOrder S; S.init(MT, N, G, bx);
    pg8::gemm_phase<Epi, pg8::StaticOrder, true, true>((PG8_LAS unsigned char*)smem, g, S, E);
}

template <class Epi> __device__ __forceinline__ void run_gemm_panel(int G, int bx, unsigned char* smem, const bf16_t* A, const bf16_t* Bt, int N, int K, const Epi& E) {
    pg8::Gemm g{A, Bt, MT, N, K}; PanelOrder S; S.init(G, bx);
    pg8::gemm_phase<Epi, PanelOrder, true, true>((PG8_LAS unsigned char*)smem, g, S, E);
}

__global__ void __launch_bounds__(512, 2) mk_fwd(Args args) {
    extern __shared__ __attribute__((aligned(16))) unsigned char smem[];
    cg::grid_group grid = cg::this_grid();
    Ctx C; C.tab = (const PG8_LAS unsigned long long*)(smem + LDS_BYTES - 256);
    if (mk_tid() == 0) { PG8_LAS unsigned long long* tw = (PG8_LAS unsigned long long*)(smem + LDS_BYTES - 256);
#pragma unroll
        for (int i = 0; i < 29; ++i) tw[i] = (unsigned long long)args.in[i]; }
    if (mk_tid() < 2) ((volatile LAS unsigned*)(smem + LDS_BYTES - 16))[mk_tid()] = 0u;
    __syncthreads();
    XcdBarrier xbar = xcd_barrier_post((unsigned*)(args.ws + 4096), (volatile LAS unsigned*)(smem + LDS_BYTES - 16));

#ifdef MK_EXTRA_SYNCS
    for (int i = 0; i < MK_EXTRA_SYNCS; ++i) xcd_barrier(xbar);
#endif
    for (int ph = args.ph_lo; ph < args.ph_hi; ++ph) {
        { unsigned long long w_ = (unsigned long long)args.ws, o_ = (unsigned long long)args.out; asm volatile("" : "+s"(w_), "+s"(o_)); C.ws = (unsigned char*)(__attribute__((address_space(1))) unsigned char*)w_; C.out = (float*)(__attribute__((address_space(1))) float*)o_; }
        int G = (int)gridDim.x, bx = (int)blockIdx.x; asm volatile("" : "+s"(G), "+s"(bx));
        const int ptype = ph < 2 ? 100 + ph : (ph - 2) % 9; const int pbit = ptype >= 100 ? ptype - 91 : ptype; const int nrep = (ptype == MK_REP_K || ((MK_REP_MASK >> pbit) & 1)) ? MK_REP_N : 1;
        for (int rep = 0; rep < nrep; ++rep) {
        if (rep > 0) { XcdBarrier xb_ = xbar; unsigned long long bp_ = (unsigned long long)xb_.bar; asm volatile("" : "+s"(bp_)); xb_.bar = (unsigned*)(__attribute__((address_space(1))) unsigned*)bp_; xcd_barrier(xb_); }
        if (ph == 0) { if constexpr (PH(100)) p0a(C, smem); }
        else if (ph == 1) { if constexpr (PH(101)) p0b(C); }
        else {
            const int l = (ph - 2) / 9, k = (ph - 2) % 9;
            const float* mod = C.MOD() + (size_t)l * 32 * 6144;
            float* st1 = C.STATS() + (size_t)(l * 2) * MT * 2; float* st2 = C.STATS() + (size_t)(l * 2 + 1) * MT * 2; float* stw1 = rep > 0 ? C.STATS() + (size_t)4 * MT * 2 : st1; float* stw2 = rep > 0 ? C.STATS() + (size_t)4 * MT * 2 : st2;
            if (k == 0) { if constexpr (PH(0)) {
                EpiInProj E{C.PROJ(), C.GATES(), C.out, l, C.b_mi() + l * 4, C.b_mf() + l * 4, C.b_ff() + l * 8};
                run_gemm(G, bx, smem, C.HA(), C.WIN() + (size_t)l * NINP * 1024, NINP, 1024, E);
            } } else if (k == 1) { if constexpr (PH(1)) {
                if (SUB(0)) for (int q = bx; q < 1024; q += G) m1_quad(C, q, smem);
                if (SUB(1)) for (int u = bx; u < 512; u += G) gmlp_unit(C, l, u, smem);
                if (SUB(2)) for (int u = bx; u < 16; u += G) fcum_unit(C, u, smem);
                if (SUB(3)) for (int u = (bx + G - (16 % G)) % G; u < 64; u += G) mlstm_sample_unit(C, l, u, smem);
                if (SUB(4)) for (int u = (bx + G - (80 % G)) % G; u < 16; u += G) gmlp_sample_unit(C, l, u, smem);
            } } else if (k == 2) { if constexpr (PH(2)) {
                scan_phase(C, l);
            } } else if (k == 3) { if constexpr (PH(3)) {
                const attn_body::AttnTensors AT{(const attn_body::bf16*)(C.PROJ() + 1024), (const attn_body::bf16*)(C.PROJ() + 1536), (const attn_body::bf16*)(C.PROJ() + 2048), (attn_body::bf16*)(C.HA() + 256), C.FQ()};
                const int vcu0 = (G % 8 == 0) ? (bx % 8) * (G / 8) + bx / 8 : bx;
                if (SUB(0)) for (int v = vcu0; v < 256; v += G) { const attn_body::StaticOrder S(v); attn_body::attn_phase<attn_body::StaticOrder>((char*)smem, AT, S); }
                __syncthreads();
                if (SUB(1)) for (int q = bx; q < 1024; q += G) m3_quad(C, l, q, smem);
                if (SUB(2)) for (int u = G - 1 - bx; u < 128; u += G) fox_sample_unit(C, l, u, smem);
            } } else if (k == 4) { if constexpr (PH(4)) {
                if (l == 0) { EpiRes<false> E{C.x_prompt(), C.x_sample(), nullptr, nullptr, nullptr, nullptr, mod + 2048, C.R1(), stw1};
                    run_gemm_panel(G, bx, smem, C.HA(), C.WO() + (size_t)l * 1024 * 1024, 1024, 1024, E); }
                else { EpiRes<true> E{nullptr, nullptr, C.R2(), C.STATS() + (size_t)((l - 1) * 2 + 1) * MT * 2, C.ln2_g() + (l - 1) * 1024, C.ln2_b() + (l - 1) * 1024, mod + 2048, C.R1(), stw1};
                    run_gemm_panel(G, bx, smem, C.HA(), C.WO() + (size_t)l * 1024 * 1024, 1024, 1024, E); }
                if (rep == 0) { __syncthreads(); const int wv_ = __builtin_amdgcn_readfirstlane((int)(mk_tid() >> 6));
                    for (int p = bx; p < 256; p += G) ln_apply(C.R1(), st1, C.ln1_g() + l * 1024, C.ln1_b() + l * 1024, mod + 3072, mod + 4096, C.HA(), nullptr, nullptr, 256 * p, 256 * p + 256, wv_, 8); }
            } } else if (k == 5) { if constexpr (PH(5)) {
                { const int wv_ = __builtin_amdgcn_readfirstlane((int)(mk_tid() >> 6));
                  ln_apply(C.R1(), st1, C.ln1_g() + l * 1024, C.ln1_b() + l * 1024, mod + 3072, mod + 4096, C.HA(), nullptr, nullptr, rep == 0 ? NPT : 0, MT, bx * 8 + wv_, G * 8); }
            } } else if (k == 6) { if constexpr (PH(6)) {
                EpiSwiGLU E{C.PROJ()};
                run_gemm(G, bx, smem, C.HA(), C.WGU() + (size_t)l * 5632 * 1024, 5632, 1024, E);
            } } else if (k == 7) { if constexpr (PH(7)) {
                EpiRes<true> E{nullptr, nullptr, C.R1(), st1, C.ln1_g() + l * 1024, C.ln1_b() + l * 1024, mod + 5120, C.R2(), stw2};
                run_gemm(G, bx, smem, C.PROJ(), C.WD() + (size_t)l * 1024 * DFF, 1024, DFF, E);
            } } else { if constexpr (PH(8)) {
                if (l == 0) ln_apply(C.R2(), st2, C.ln2_g(), C.ln2_b(), mod + 32 * 6144, mod + 32 * 6144 + 1024, C.HA(), nullptr, nullptr, 0, MT, bx * 8 + __builtin_amdgcn_readfirstlane((int)(mk_tid() >> 6)), G * 8);
                else ln_apply(C.R2(), st2, C.ln2_g() + 1024, C.ln2_b() + 1024, nullptr, nullptr, nullptr, C.out + O_YP, C.out + O_YS, 0, MT, bx * 8 + __builtin_amdgcn_readfirstlane((int)(mk_tid() >> 6)), G * 8);
            } }
        }
        }
        if (ph + 1 < args.ph_hi) { if (args.ph_hi < 0) grid.sync(); else { XcdBarrier xb_ = xbar; unsigned long long bp_ = (unsigned long long)xb_.bar; asm volatile("" : "+s"(bp_)); xb_.bar = (unsigned*)(__attribute__((address_space(1))) unsigned*)bp_; xcd_barrier(xb_); } }
    }
}
}

#ifndef MK_NLAUNCH
#define MK_NLAUNCH 1
#endif
extern "C" void kernel_launch(void* const* d_in, const int* in_sizes, int n_in, void* d_out, int out_size, void* d_ws, size_t ws_size, hipStream_t stream) {
    static int grid = 0;
    if (grid == 0) {
        if (n_in != 29 || (size_t)out_size != mk::O_END || ws_size < mk::WS_END) { fprintf(stderr, "kernel_launch: unexpected shapes: n_in %d out %d ws %zu (need %zu)\n", n_in, out_size, ws_size, (size_t)mk::WS_END); grid = -1; return; }
        int dev = 0, cus = 0, per_cu = 0;
        (void)hipGetDevice(&dev); (void)hipDeviceGetAttribute(&cus, hipDeviceAttributeMultiprocessorCount, dev);
        if (hipFuncSetAttribute((const void*)mk::mk_fwd, hipFuncAttributeMaxDynamicSharedMemorySize, mk::LDS_BYTES) != hipSuccess) { fprintf(stderr, "kernel_launch: hipFuncSetAttribute failed\n"); grid = -1; return; }
        if (hipOccupancyMaxActiveBlocksPerMultiprocessor(&per_cu, (const void*)mk::mk_fwd, 512, mk::LDS_BYTES) != hipSuccess || per_cu < 1) { fprintf(stderr, "kernel_launch: occupancy query failed (%d)\n", per_cu); per_cu = 1; (void)hipGetLastError(); }
        grid = cus * (per_cu > 1 ? 1 : per_cu);
        if (grid <= 0) grid = 256;
    }
    if (grid < 0) return;
    if (hipMemsetAsync(d_ws, 0, 65536, stream) != hipSuccess) { fprintf(stderr, "kernel_launch: memset failed\n"); return; }
    mk::Args a{};
    for (int i = 0; i < 29; ++i) a.in[i] = (const float*)d_in[i];
    a.out = (float*)d_out; a.ws = (unsigned char*)d_ws;
    for (int li = 0; li < MK_NLAUNCH; ++li) {
        a.ph_lo = (MK_NLAUNCH == 1) ? 0 : li * mk::N_PHASES / MK_NLAUNCH; a.ph_hi = (MK_NLAUNCH == 1) ? mk::N_PHASES : (li + 1) * mk::N_PHASES / MK_NLAUNCH;
        void* kargs[] = {&a};
        const hipError_t e = hipLaunchCooperativeKernel((const void*)mk::mk_fwd, dim3(grid), dim3(512), kargs, mk::LDS_BYTES, stream);
        if (e != hipSuccess) { fprintf(stderr, "kernel_launch: cooperative launch failed: %s (grid %d)\n", hipGetErrorString(e), grid); break; }
    }
}
```

```cpp
#include <hip/hip_runtime.h>
#include <hip/hip_bf16.h>
#include <hip/hip_cooperative_groups.h>
#include <cstdio>
#include <cstdint>
#include <cmath>
namespace cg = cooperative_groups;
__device__ __forceinline__ int mk_tid() { int t = threadIdx.x; asm volatile("" : "+v"(t)); return t; }
namespace pg8 {
#define PG8_LAS __attribute__((address_space(3)))
typedef unsigned short bf16_t;
typedef short bf16x8 __attribute__((ext_vector_type(8)));
typedef float f32x4 __attribute__((ext_vector_type(4)));
typedef unsigned u32x4 __attribute__((ext_vector_type(4)));
constexpr int BM = 256, BK = 64, HALF = 128, HTB = HALF * BK * 2  , STAGE_BYTES = 8 * HTB, NXCD = 8, WGM = 8;

__host__ __device__ __forceinline__ int lds_byte(int r, int c) { const int st = (r >> 4) * 2 + (c >> 5), rr = r & 15, cc = c & 31, ob = rr * 64 + cc * 2; return st * 1024 + (ob ^ (((ob >> 9) & 1) << 5)); }
__host__ __device__ __forceinline__ void stage_rc(int b, int& R, int& C) { const int st = b / 1024, sb = b % 1024, swz = sb ^ (((sb >> 9) & 1) << 5); R = (st >> 1) * 16 + swz / 64; C = (st & 1) * 32 + (swz % 64) / 2; }
__host__ __device__ __forceinline__ int perm32(int rho) { const int n = rho >> 4, i = rho & 15; return 8 * (i >> 2) + 4 * n + (i & 3); }

struct Unit { int pm, pn; };
struct Gemm { const bf16_t* A; const bf16_t* Bt; int M, N, K; };

struct StaticOrder {
    int nM, nN, nwg, G, c;
    __host__ __device__ void init(int M, int N, int G_, int c_) { nM = M / BM; nN = N / BM; nwg = nM * nN; G = G_; c = c_; }
    __host__ __device__ bool next(int i, Unit& u) const {
        const long L = (long)i * G + c; if (L >= nwg) return false;
        int wgid = (int)L; { const int q = nwg / NXCD, r = nwg % NXCD, xcd = wgid % NXCD, off = wgid / NXCD; wgid = (xcd < r ? xcd * (q + 1) : r * (q + 1) + (xcd - r) * q) + off; }
        const int nig = WGM * nN, gid = wgid / nig, fm = gid * WGM, gsz = (nM - fm) < WGM ? (nM - fm) : WGM;
        u.pm = fm + ((wgid % nig) % gsz); u.pn = (wgid % nig) / gsz; return true;
    }
    __device__ __forceinline__ void a_ready(const Unit&) const {}
    __device__ __forceinline__ void done(const Unit&) const {}
};

__device__ __forceinline__ unsigned cvt_pk_bf16(float lo, float hi) { unsigned r; asm volatile("v_cvt_pk_bf16_f32 %0, %1, %2" : "=v"(r) : "v"(lo), "v"(hi)); return r; }
typedef float f32x2 __attribute__((ext_vector_type(2)));
__device__ __forceinline__ f32x2 gelu_pk(f32x2 v) {
    const f32x2 av = __builtin_elementwise_abs(v), d = av * 0.2316418882f + 1.0f;
    f32x2 t; t.x = __builtin_amdgcn_rcpf(d.x); t.y = __builtin_amdgcn_rcpf(d.y);
    f32x2 q = t * 0.5307027145f + (-0.7265760135f); q = q * t + 0.7107068705f; q = q * t + (-0.142248368f); q = q * t + 0.127414796f; q = q * t;
    const f32x2 s = (v * v) * (-0.72134752044f);
    f32x2 e; e.x = __builtin_amdgcn_exp2f(s.x); e.y = __builtin_amdgcn_exp2f(s.y);
    const f32x2 m = v * (q * e), r = v - m;
    f32x2 o; o.x = v.x < 0.f ? m.x : r.x; o.y = v.y < 0.f ? m.y : r.y; return o;
}

template <int ACT  > struct EpiBf16 {
    static constexpr bool PERM = true, AFTER_DRAIN = false; static_assert(ACT == 0 || ACT == 1, "EpiBf16: ACT is 0 (none) or 1 (gelu_pk)");
    bf16_t* O; int ldc; const float* bias; int split_cols; size_t split_stride; float scale0;
    __device__ __forceinline__ void operator()(const f32x4 (&acc)[2][2][4][2], const Unit& u, int wr, int wc, int fr, int fq) const {
        const int row0 = u.pm * BM + wr * 64 + fr; int colt = u.pn * BM; bf16_t* base = O;
        float sc = 1.f; if (split_cols) { const int t = colt / split_cols; base += (size_t)t * split_stride; colt -= t * split_cols; if (t == 0) sc = scale0; }
        const int col0 = colt + wc * 32 + 8 * fq, bcol0 = u.pn * BM + wc * 32 + 8 * fq;
        f32x4 bv[2][2];
#pragma unroll
        for (int bj = 0; bj < 2; ++bj)
#pragma unroll
            for (int n = 0; n < 2; ++n) bv[bj][n] = bias ? *(const f32x4*)(bias + bcol0 + bj * HALF + 4 * n) : (f32x4){0.f, 0.f, 0.f, 0.f};
#pragma unroll
        for (int ai = 0; ai < 2; ++ai)
#pragma unroll
            for (int m = 0; m < 4; ++m) { bf16_t* rowp = base + (size_t)(row0 + ai * HALF + m * 16) * ldc + col0;
#pragma unroll
                for (int bj = 0; bj < 2; ++bj) { f32x4 v0 = acc[ai][bj][m][0] + bv[bj][0], v1 = acc[ai][bj][m][1] + bv[bj][1];
                    if (ACT == 1) { f32x2 a = gelu_pk((f32x2){v0[0], v0[1]}), b = gelu_pk((f32x2){v0[2], v0[3]}), c = gelu_pk((f32x2){v1[0], v1[1]}), d = gelu_pk((f32x2){v1[2], v1[3]});
                        v0 = (f32x4){a.x, a.y, b.x, b.y}; v1 = (f32x4){c.x, c.y, d.x, d.y}; }
                    v0 = v0 * sc; v1 = v1 * sc; u32x4 w; w.x = cvt_pk_bf16(v0[0], v0[1]); w.y = cvt_pk_bf16(v0[2], v0[3]); w.z = cvt_pk_bf16(v1[0], v1[1]); w.w = cvt_pk_bf16(v1[2], v1[3]);
                    *(u32x4*)(rowp + bj * HALF) = w; } }
    }
};

struct PanelStats {
    unsigned* xbuf;
    unsigned* cnt;
    unsigned* tmo;
    int ntn; float eps;
    unsigned code;
    __device__ __forceinline__ bool run(const f32x4 (&v)[2][2][4][2], const Unit& u, int wr, int wc, int fr, int fq, PG8_LAS unsigned char* lds, int wid, int lane) const {
        typedef float f32x2v __attribute__((ext_vector_type(2)));
        PG8_LAS f32x2v* P = (PG8_LAS f32x2v*)lds;
        PG8_LAS f32x2v* S = (PG8_LAS f32x2v*)(lds + 8192);
        PG8_LAS unsigned* flag = (PG8_LAS unsigned*)(lds + 8192 + 2048);
#pragma unroll
        for (int ai = 0; ai < 2; ++ai)
#pragma unroll
            for (int m = 0; m < 4; ++m) {
                float s = 0.f;
#pragma unroll
                for (int bj = 0; bj < 2; ++bj)
#pragma unroll
                    for (int n = 0; n < 2; ++n) { const f32x4 x = v[ai][bj][m][n]; s += (x[0] + x[1]) + (x[2] + x[3]); }
                s += __shfl_xor(s, 16); s += __shfl_xor(s, 32);
                const float mw = s * (1.0f / 64.0f); float q = 0.f;
#pragma unroll
                for (int bj = 0; bj < 2; ++bj)
#pragma unroll
                    for (int n = 0; n < 2; ++n) { const f32x4 d = v[ai][bj][m][n] - mw; q += (d[0] * d[0] + d[1] * d[1]) + (d[2] * d[2] + d[3] * d[3]); }
                q += __shfl_xor(q, 16); q += __shfl_xor(q, 32);
                if (fq == 0) P[(ai * HALF + wr * 64 + m * 16 + fr) * 4 + wc] = (f32x2v){mw, q};
            }
        asm volatile("s_waitcnt lgkmcnt(0)" ::: "memory"); __builtin_amdgcn_s_barrier(); asm volatile("" ::: "memory");
#if defined(BROKEN_EXCHANGE_NO_WAIT)
#warning BROKEN CONTROL BUILD: the row-statistics exchange does not wait; results are wrong by design
        if (blockIdx.x >= 64) { const long long t0_ = clock64(); while (clock64() - t0_ < 60000) __builtin_amdgcn_s_sleep(8); }
#endif
        const int row = wid * 32 + (lane & 31);
        if (lane < 32) {
            const f32x2v a = P[row * 4 + 0], b = P[row * 4 + 1], c = P[row * 4 + 2], d = P[row * 4 + 3];
            const float mt = (a.x + b.x + c.x + d.x) * 0.25f;
            const float da = a.x - mt, db = b.x - mt, dc = c.x - mt, dd = d.x - mt;
            const float m2 = (a.y + b.y) + (c.y + d.y) + 64.0f * ((da * da + db * db) + (dc * dc + dd * dd));
            unsigned long long* slot = (unsigned long long*)xbuf + ((size_t)(u.pm * BM + row) * 4 + u.pn);
            __hip_atomic_store(slot, ((unsigned long long)__float_as_uint(m2) << 32) | __float_as_uint(mt), __ATOMIC_RELAXED, __HIP_MEMORY_SCOPE_AGENT);
        }
        asm volatile("s_waitcnt vmcnt(0)" ::: "memory");
        if (lane == 0) __hip_atomic_fetch_add(cnt + 64 * u.pm, 1u, __ATOMIC_RELAXED, __HIP_MEMORY_SCOPE_AGENT);
        if (wid == 0) {
            bool dead = false; const unsigned long long t0 = __builtin_amdgcn_s_memrealtime(); const unsigned want = 8u * (unsigned)ntn;
            for (;;) {
#if defined(BROKEN_EXCHANGE_NO_WAIT)
                break;
#endif
                if ((unsigned)__builtin_amdgcn_readfirstlane(__hip_atomic_load(cnt + 64 * u.pm, __ATOMIC_RELAXED, __HIP_MEMORY_SCOPE_AGENT)) >= want) break;
                if (__builtin_amdgcn_s_memrealtime() - t0 > 2000000ull) {
                    if (lane == 0) { unsigned expect = 0u; __hip_atomic_compare_exchange_strong(tmo + 1, &expect, code | (unsigned)(u.pm & 0xff), __ATOMIC_RELAXED, __ATOMIC_RELAXED, __HIP_MEMORY_SCOPE_AGENT);
                                     __hip_atomic_store(tmo, 1u, __ATOMIC_RELAXED, __HIP_MEMORY_SCOPE_AGENT); }
                    dead = true; break; }
                __builtin_amdgcn_s_sleep(2);
            }
            __builtin_amdgcn_fence(__ATOMIC_ACQUIRE, "agent");
            if (lane == 0) flag[0] = dead ? 1u : 0u;
        }
        asm volatile("s_waitcnt vmcnt(0) lgkmcnt(0)" ::: "memory"); __builtin_amdgcn_s_barrier(); asm volatile("" ::: "memory");
        const bool bad = flag[0] != 0u;
        if (lane < 32) {
            const unsigned long long* slot = (const unsigned long long*)xbuf + (size_t)(u.pm * BM + row) * 4; float mt[4], m2[4]; float ms = 0.f;
#pragma unroll
            for (int t = 0; t < 4; ++t) { if (t < ntn) { const unsigned long long w = __hip_atomic_load(slot + t, __ATOMIC_RELAXED, __HIP_MEMORY_SCOPE_AGENT); mt[t] = __uint_as_float((unsigned)w); m2[t] = __uint_as_float((unsigned)(w >> 32)); } else { mt[t] = 0.f; m2[t] = 0.f; } ms += mt[t]; }
            const float mean = ms / (float)ntn; float q = 0.f;
#pragma unroll
            for (int t = 0; t < 4; ++t) if (t < ntn) { const float dm = mt[t] - mean; q += m2[t] + 256.0f * dm * dm; }
            S[row] = (f32x2v){mean, 1.0f / sqrtf(q / (256.0f * (float)ntn) + eps)};
        }
        asm volatile("s_waitcnt lgkmcnt(0)" ::: "memory"); __builtin_amdgcn_s_barrier(); asm volatile("" ::: "memory");
        return bad;
    }
};
struct EpiLnRes {
    static constexpr bool PERM = false, AFTER_DRAIN = true;
    const float* base; float* out; int ldc; const float* bias; PanelStats st; unsigned poison;
    __device__ __forceinline__ void fused(f32x4 (&acc)[2][2][4][2], const Unit& u, int wr, int wc, int fr, int fq, PG8_LAS unsigned char* lds, int wid, int lane) const {
        typedef float f32x2v __attribute__((ext_vector_type(2)));
        const PG8_LAS f32x2v* S = (const PG8_LAS f32x2v*)(lds + 8192);
        const int col0 = u.pn * BM + wc * 32 + 4 * fq;
#pragma unroll
        for (int bj = 0; bj < 2; ++bj)
#pragma unroll
            for (int n = 0; n < 2; ++n) { const f32x4 bv = bias ? *(const f32x4*)(bias + col0 + bj * HALF + n * 16) : (f32x4){0.f, 0.f, 0.f, 0.f};
#pragma unroll
                for (int ai = 0; ai < 2; ++ai)
#pragma unroll
                    for (int m = 0; m < 4; ++m) acc[ai][bj][m][n] += bv; }
        f32x4 pre[4][2][2];
#pragma unroll
        for (int m = 0; m < 4; ++m) { const size_t off = (size_t)(u.pm * BM + wr * 64 + m * 16 + fr) * ldc + col0;
#pragma unroll
            for (int bj = 0; bj < 2; ++bj)
#pragma unroll
                for (int n = 0; n < 2; ++n) pre[m][bj][n] = *(const f32x4*)(base + off + bj * HALF + n * 16); }
        const bool bad = st.run(acc, u, wr, wc, fr, fq, lds, wid, lane) || poison != 0u;
        const float qnan = __builtin_nanf("");
#pragma unroll
        for (int ai = 0; ai < 2; ++ai)
#pragma unroll
            for (int m = 0; m < 4; ++m) { const int r = ai * HALF + wr * 64 + m * 16 + fr; const f32x2v sr = S[r]; const size_t off = (size_t)(u.pm * BM + r) * ldc + col0;
#pragma unroll
                for (int bj = 0; bj < 2; ++bj)
#pragma unroll
                    for (int n = 0; n < 2; ++n) { const f32x4 bs = ai == 0 ? pre[m][bj][n] : *(const f32x4*)(base + off + bj * HALF + n * 16); f32x4 o = bs + (acc[ai][bj][m][n] - sr.x) * sr.y;
                        if (bad) o = (f32x4){qnan, qnan, qnan, qnan}; *(f32x4*)(out + off + bj * HALF + n * 16) = o; }
                if (m & 1) asm volatile("" ::: "memory"); }
    }
};
struct EpiLnResLn {
    static constexpr bool PERM = false, AFTER_DRAIN = true;
    const float* base; float* out; bf16_t* xn; int ldc; const float* bias; PanelStats st1, st2; unsigned poison;
    __device__ __forceinline__ void fused(f32x4 (&acc)[2][2][4][2], const Unit& u, int wr, int wc, int fr, int fq, PG8_LAS unsigned char* lds, int wid, int lane) const {
        typedef float f32x2v __attribute__((ext_vector_type(2))); typedef unsigned u32x2v __attribute__((ext_vector_type(2)));
        const PG8_LAS f32x2v* S = (const PG8_LAS f32x2v*)(lds + 8192);
        const int col0 = u.pn * BM + wc * 32 + 4 * fq;
#pragma unroll
        for (int bj = 0; bj < 2; ++bj)
#pragma unroll
            for (int n = 0; n < 2; ++n) { const f32x4 bv = bias ? *(const f32x4*)(bias + col0 + bj * HALF + n * 16) : (f32x4){0.f, 0.f, 0.f, 0.f};
#pragma unroll
                for (int ai = 0; ai < 2; ++ai)
#pragma unroll
                    for (int m = 0; m < 4; ++m) acc[ai][bj][m][n] += bv; }
        bool bad = st1.run(acc, u, wr, wc, fr, fq, lds, wid, lane) || poison != 0u;
        const float qnan = __builtin_nanf("");
#pragma unroll
        for (int ai = 0; ai < 2; ++ai)
#pragma unroll
            for (int m = 0; m < 4; ++m) { const int r = ai * HALF + wr * 64 + m * 16 + fr; const f32x2v sr = S[r]; const size_t off = (size_t)(u.pm * BM + r) * ldc + col0;
#pragma unroll
                for (int bj = 0; bj < 2; ++bj)
#pragma unroll
                    for (int n = 0; n < 2; ++n) { const f32x4 bs = *(const f32x4*)(base + off + bj * HALF + n * 16); acc[ai][bj][m][n] = bs + (acc[ai][bj][m][n] - sr.x) * sr.y; }
                asm volatile("" : "+v"(acc[ai][0][m][0]), "+v"(acc[ai][0][m][1]), "+v"(acc[ai][1][m][0]), "+v"(acc[ai][1][m][1]));
                if (m & 1) asm volatile("" ::: "memory"); }
        const bool bad1 = bad;
        bad = st2.run(acc, u, wr, wc, fr, fq, lds, wid, lane) || bad;
#pragma unroll
        for (int ai = 0; ai < 2; ++ai)
#pragma unroll
            for (int m = 0; m < 4; ++m) { const int r = ai * HALF + wr * 64 + m * 16 + fr; const f32x2v sr = S[r]; const size_t off = (size_t)(u.pm * BM + r) * ldc + col0;
#pragma unroll
                for (int bj = 0; bj < 2; ++bj)
#pragma unroll
                    for (int n = 0; n < 2; ++n) { const f32x4 x1 = acc[ai][bj][m][n]; *(f32x4*)(out + off + bj * HALF + n * 16) = bad1 ? (f32x4){qnan, qnan, qnan, qnan} : x1;
                        const f32x4 o = (x1 - sr.x) * sr.y; u32x2v w; w.x = cvt_pk_bf16(o[0], o[1]); w.y = cvt_pk_bf16(o[2], o[3]);
                        if (bad) { w.x = 0x7fc07fc0u; w.y = 0x7fc07fc0u; } *(u32x2v*)(xn + off + bj * HALF + n * 16) = w; }
                asm volatile("" ::: "memory"); }
    }
};

template <class Epi, class Sched, bool ALIGN_EPI = false, bool SP2 = false>
__device__ __forceinline__ void gemm_phase(PG8_LAS unsigned char* lds, const Gemm g, const Sched& S, const Epi& E) {
    const int tid = mk_tid(), wid = __builtin_amdgcn_readfirstlane(tid >> 6), lane = tid & 63, wr = wid >> 2, wc = wid & 3, fr = lane & 15, fq = lane >> 4;
    const int K = g.K, nt = K / BK;
    unsigned voffA[2], voffB[2];
#pragma unroll
    for (int i = 0; i < 2; ++i) { int R, C; stage_rc(tid * 16 + i * 8192, R, C); const int Rb = Epi::PERM ? ((R & ~31) + perm32(R & 31)) : R;
        voffA[i] = (unsigned)(R * K + C) * 2u; voffB[i] = (unsigned)(Rb * K + C) * 2u; }
    const size_t kstep = (size_t)(BK * 2);
    const size_t hstep = (size_t)HALF * K * 2;
    const size_t tstep = 2 * hstep;
    const unsigned ldsw = (unsigned)wid * 1024u;
    const int aoff = lds_byte(wr * 64 + fr, fq * 8), boff = lds_byte(wc * 32 + fr, fq * 8);
#define PG8_SA(b, h) (((b) * 2 + (h)) * HTB)
#define PG8_SB(b, h) ((4 + (b) * 2 + (h)) * HTB)
#define PG8_STAGE(bufoff, gbase, voff) do { _Pragma("unroll") for (int _i = 0; _i < 2; ++_i) \
        __builtin_amdgcn_global_load_lds((const unsigned*)((const char*)(gbase) + (voff)[_i]), (PG8_LAS unsigned*)(lds + (bufoff) + ldsw + _i * 8192), 16, 0, 0); } while (0)
#define PG8_LDA(dst, b, h) do { _Pragma("unroll") for (int m = 0; m < 4; ++m) _Pragma("unroll") for (int k = 0; k < 2; ++k) dst[m][k] = *(const PG8_LAS bf16x8*)(lds + PG8_SA(b, h) + aoff + m * 2048 + k * 1024); } while (0)
#define PG8_LDB(dst, b, h) do { _Pragma("unroll") for (int n = 0; n < 2; ++n) _Pragma("unroll") for (int k = 0; k < 2; ++k) dst[n][k] = *(const PG8_LAS bf16x8*)(lds + PG8_SB(b, h) + boff + n * 2048 + k * 1024); } while (0)
#define PG8_MMA(ai, bj, At, Bt) do { __builtin_amdgcn_s_setprio(1); _Pragma("unroll") for (int m = 0; m < 4; ++m) _Pragma("unroll") for (int n = 0; n < 2; ++n) _Pragma("unroll") for (int k = 0; k < 2; ++k) \
        acc[ai][bj][m][n] = __builtin_amdgcn_mfma_f32_16x16x32_bf16(Bt[n][k], At[m][k], acc[ai][bj][m][n], 0, 0, 0); __builtin_amdgcn_s_setprio(0); } while (0)
#define PG8_WAIT_V(n) asm volatile("s_waitcnt vmcnt(" #n ")" ::: "memory")
#define PG8_WAIT_L(n) asm volatile("s_waitcnt lgkmcnt(" #n ")" ::: "memory")
#define PG8_BAR __builtin_amdgcn_s_barrier()
#define PG8_SCHED __builtin_amdgcn_sched_barrier(0)
    Unit cur, nxt; int ui = 0;
    if (!S.next(0, cur)) return;
    f32x4 acc[2][2][4][2];
#pragma unroll
    for (int a = 0; a < 2; ++a)
#pragma unroll
        for (int b = 0; b < 2; ++b)
#pragma unroll
            for (int m = 0; m < 4; ++m)
#pragma unroll
                for (int n = 0; n < 2; ++n) acc[a][b][m][n] = (f32x4){0.f, 0.f, 0.f, 0.f};
    bf16x8 At[4][2], B0[2][2], B1[2][2];
    const char* cA = (const char*)g.A + (size_t)cur.pm * tstep; const char* cB = (const char*)g.Bt + (size_t)cur.pn * tstep;
    S.a_ready(cur);
    if constexpr (SP2) {
        PG8_STAGE(PG8_SB(0, 0), cB, voffB); PG8_STAGE(PG8_SB(0, 1), cB + hstep, voffB); PG8_STAGE(PG8_SA(0, 0), cA, voffA); PG8_STAGE(PG8_SA(0, 1), cA + hstep, voffA);
        if (wr == 1) PG8_BAR;
        PG8_WAIT_V(2); PG8_BAR;
        PG8_STAGE(PG8_SB(1, 0), cB + kstep, voffB); PG8_STAGE(PG8_SA(1, 0), cA + kstep, voffA); PG8_STAGE(PG8_SB(1, 1), cB + hstep + kstep, voffB);
        PG8_WAIT_V(6); PG8_BAR;
    } else {
        PG8_STAGE(PG8_SB(0, 0), cB, voffB); PG8_STAGE(PG8_SA(0, 0), cA, voffA); PG8_STAGE(PG8_SB(0, 1), cB + hstep, voffB); PG8_STAGE(PG8_SA(0, 1), cA + hstep, voffA);
        if (wr == 1) PG8_BAR;
        PG8_WAIT_V(4); PG8_BAR;
        PG8_STAGE(PG8_SB(1, 0), cB + kstep, voffB); PG8_STAGE(PG8_SA(1, 0), cA + kstep, voffA); PG8_STAGE(PG8_SB(1, 1), cB + hstep + kstep, voffB);
        PG8_WAIT_V(6); PG8_BAR;
    }
    for (;;) {
        const bool has_next = S.next(ui + 1, nxt);
        const char* nA = has_next ? (const char*)g.A + (size_t)nxt.pm * tstep : cA; const char* nB = has_next ? (const char*)g.Bt + (size_t)nxt.pn * tstep : cB;
        for (int t = 0; t < nt; t += 2) {
            const bool last = (t == nt - 2);
            const char* a1 = cA + (size_t)(t + 1) * kstep;
            const char* a2 = last ? nA : cA + (size_t)(t + 2) * kstep; const char* b2 = last ? nB : cB + (size_t)(t + 2) * kstep;
            const char* a3 = a2 + kstep; const char* b3 = b2 + kstep;
            if (last && has_next) S.a_ready(nxt);
            if constexpr (SP2) {
            PG8_LDB(B0, 0, 0); PG8_LDB(B1, 0, 1); PG8_SCHED; PG8_LDA(At, 0, 0); PG8_STAGE(PG8_SA(1, 1), a1 + hstep, voffA);
            PG8_WAIT_V(8); PG8_WAIT_L(0); PG8_BAR; PG8_MMA(0, 0, At, B0); PG8_MMA(0, 1, At, B1); PG8_BAR; PG8_SCHED;
            PG8_LDA(At, 0, 1); PG8_STAGE(PG8_SB(0, 0), b2, voffB); PG8_STAGE(PG8_SB(0, 1), b2 + hstep, voffB); PG8_STAGE(PG8_SA(0, 0), a2, voffA);
            PG8_WAIT_V(8); PG8_WAIT_L(0); PG8_BAR; PG8_MMA(1, 0, At, B0); PG8_MMA(1, 1, At, B1); PG8_BAR; PG8_SCHED;
            PG8_LDB(B0, 1, 0); PG8_LDB(B1, 1, 1); PG8_SCHED; PG8_LDA(At, 1, 0); PG8_STAGE(PG8_SA(0, 1), a2 + hstep, voffA);
            PG8_WAIT_V(8); PG8_WAIT_L(0); PG8_BAR; PG8_MMA(0, 0, At, B0); PG8_MMA(0, 1, At, B1); PG8_BAR; PG8_SCHED;
            PG8_LDA(At, 1, 1); PG8_STAGE(PG8_SB(1, 0), b3, voffB); PG8_STAGE(PG8_SB(1, 1), b3 + hstep, voffB); PG8_STAGE(PG8_SA(1, 0), a3, voffA);
            PG8_WAIT_V(8); PG8_WAIT_L(0); PG8_BAR; PG8_MMA(1, 0, At, B0); PG8_MMA(1, 1, At, B1); PG8_BAR; PG8_SCHED;
            } else {
            PG8_LDB(B0, 0, 0); PG8_SCHED; PG8_LDA(At, 0, 0); PG8_STAGE(PG8_SA(1, 1), a1 + hstep, voffA);
            PG8_WAIT_L(8); PG8_BAR; PG8_WAIT_L(0); PG8_MMA(0, 0, At, B0); PG8_BAR; PG8_SCHED;
            PG8_LDB(B1, 0, 1); PG8_STAGE(PG8_SB(0, 0), b2, voffB);
            PG8_BAR; PG8_WAIT_L(0); PG8_MMA(0, 1, At, B1); PG8_BAR;
            PG8_LDA(At, 0, 1); PG8_STAGE(PG8_SA(0, 0), a2, voffA);
            PG8_BAR; PG8_WAIT_L(0); PG8_MMA(1, 0, At, B0); PG8_BAR; PG8_SCHED;
            PG8_STAGE(PG8_SB(0, 1), b2 + hstep, voffB);
            PG8_WAIT_V(6); PG8_BAR; PG8_MMA(1, 1, At, B1); PG8_BAR;
            PG8_LDB(B0, 1, 0); PG8_SCHED; PG8_LDA(At, 1, 0); PG8_STAGE(PG8_SA(0, 1), a2 + hstep, voffA);
            PG8_WAIT_L(8); PG8_BAR; PG8_WAIT_L(0); PG8_MMA(0, 0, At, B0); PG8_BAR; PG8_SCHED;
            PG8_LDB(B1, 1, 1); PG8_STAGE(PG8_SB(1, 0), b3, voffB);
            PG8_BAR; PG8_WAIT_L(0); PG8_MMA(0, 1, At, B1); PG8_BAR;
            PG8_LDA(At, 1, 1); PG8_STAGE(PG8_SA(1, 0), a3, voffA);
            PG8_BAR; PG8_WAIT_L(0); PG8_MMA(1, 0, At, B0); PG8_BAR; PG8_SCHED;
            PG8_STAGE(PG8_SB(1, 1), b3 + hstep, voffB);
            PG8_WAIT_V(6); PG8_BAR; PG8_MMA(1, 1, At, B1); PG8_BAR;
            }
        }
        if constexpr (ALIGN_EPI) { if (wr == 0) PG8_BAR; }
        if constexpr (!Epi::AFTER_DRAIN) { E(acc, cur, wr, wc, fr, fq); S.done(cur); }
        if (!has_next) break;
#pragma unroll
        for (int a = 0; a < 2; ++a)
#pragma unroll
            for (int b = 0; b < 2; ++b)
#pragma unroll
                for (int m = 0; m < 4; ++m)
#pragma unroll
                    for (int n = 0; n < 2; ++n) acc[a][b][m][n] = (f32x4){0.f, 0.f, 0.f, 0.f};
        cur = nxt; cA = nA; cB = nB; ++ui;
        if constexpr (ALIGN_EPI) { if (wr == 1) PG8_BAR; }
    }
    PG8_WAIT_V(0);
    if constexpr (!ALIGN_EPI) { if (wr == 0) PG8_BAR; }
    PG8_BAR;
    if constexpr (Epi::AFTER_DRAIN) { E.fused(acc, cur, wr, wc, fr, fq, lds, wid, lane); S.done(cur); }
#undef PG8_SA
#undef PG8_SB
#undef PG8_STAGE
#undef PG8_LDA
#undef PG8_LDB
#undef PG8_MMA
#undef PG8_WAIT_V
#undef PG8_WAIT_L
#undef PG8_BAR
#undef PG8_SCHED
}
}

#ifndef PG8_SP2
#define PG8_SP2 true
#endif
namespace attn_body {
using bf16=__hip_bfloat16;
using bf16x8=__attribute__((ext_vector_type(8)))short;
using s16x4=__attribute__((ext_vector_type(4)))short;
using f32x16=__attribute__((ext_vector_type(16)))float;
using u32x4=__attribute__((ext_vector_type(4)))unsigned;
constexpr int BATCH=16,NHEAD=8,SEQ=4096,D=64,DM=3072,OPITCH=1024;
constexpr int NW=8,QBLK=32,QB=QBLK*NW,KVBLK=64,NQB=SEQ/QB;
constexpr int ATTN_PITCH=DM, ATTN_UNIT_ROWS=QB;
__device__ __forceinline__ int crow(int r,int hi){return (r&3)+8*(r>>2)+4*hi;}
#define SBAR() __builtin_amdgcn_sched_barrier(0)
__device__ __forceinline__ void cmask(f32x16&p0,f32x16&p1,int jb,int qrel,int hi){
  const float NEG=-INFINITY; int kb=64*jb+4*hi;
  #pragma unroll
  for(int r=0;r<16;++r){int kv=kb+(r&3)+8*(r>>2); if(kv>qrel)p0[r]=NEG; if(kv+32>qrel)p1[r]=NEG;}
}

constexpr int NSLOT=3, SLOTB=8192;
constexpr int LDS_K=0, LDS_V=NSLOT*SLOTB, LDS_WS=2*NSLOT*SLOTB, LDS_OST=LDS_WS+NW*64*4, LDS_BYTES=LDS_OST+NW*4096, LDS_F=86016;
constexpr float C2=0.125f*1.4426950408889634f;
__device__ __forceinline__ void glds16(const void*gsrc,unsigned lds_dst){unsigned keep;
  asm volatile("s_mov_b32 %0, m0\n\ts_mov_b32 m0, %2\n\ts_nop 0\n\tglobal_load_lds_dwordx4 %1, off\n\ts_mov_b32 m0, %0":"=&s"(keep):"v"(gsrc),"s"(lds_dst):"memory");}
__device__ __forceinline__ float max3f(float a,float b,float c){float r;asm("v_max3_f32 %0, %1, %2, %3":"=v"(r):"v"(a),"v"(b),"v"(c));return r;}
__device__ __forceinline__ float max2f(float a,float b){float r;asm("v_max_f32_e32 %0, %1, %2":"=v"(r):"v"(a),"v"(b));return r;}
__device__ __forceinline__ float fadd_s(float a,float b){float r;asm("v_add_f32_e32 %0, %1, %2":"=v"(r):"v"(a),"v"(b));return r;}
__device__ __forceinline__ float fsub_s(float a,float b){float r;asm("v_sub_f32_e32 %0, %1, %2":"=v"(r):"v"(a),"v"(b));return r;}
typedef float f32x2_t __attribute__((ext_vector_type(2))); typedef __bf16 bf16x2_t __attribute__((ext_vector_type(2)));
__device__ __forceinline__ unsigned cvtpk_s(float lo,float hi){f32x2_t v={lo,hi};bf16x2_t b=__builtin_convertvector(v,bf16x2_t);return __builtin_bit_cast(unsigned,b);}
#define WAIT_BAR(N) asm volatile("s_waitcnt vmcnt(" #N ") lgkmcnt(0)\n\ts_barrier":::"memory")

__device__ __forceinline__ void qkt(f32x16&p0,f32x16&p1,const char*Kslot,const bf16x8*qr,int r32,int hi){
  const char*kb=Kslot+hi*1024+r32*16;
  #pragma unroll
  for(int d0=0;d0<4;++d0){
    const bf16x8 b0=*reinterpret_cast<const bf16x8*>(kb+d0*2048);
    const bf16x8 b1=*reinterpret_cast<const bf16x8*>(kb+d0*2048+512);
    p0=__builtin_amdgcn_mfma_f32_32x32x16_bf16(b0,qr[d0],p0,0,0,0);p1=__builtin_amdgcn_mfma_f32_32x32x16_bf16(b1,qr[d0],p1,0,0,0);}
}
typedef __attribute__((address_space(3))) const char* lds_cptr;
typedef short v4i16_t __attribute__((ext_vector_type(4)));
__device__ __forceinline__ void kload8(bf16x8*kf,lds_cptr kp){
  kf[0]=*(const __attribute__((address_space(3))) bf16x8*)(kp);      kf[1]=*(const __attribute__((address_space(3))) bf16x8*)(kp+512);
  kf[2]=*(const __attribute__((address_space(3))) bf16x8*)(kp+2048); kf[3]=*(const __attribute__((address_space(3))) bf16x8*)(kp+2560);
  kf[4]=*(const __attribute__((address_space(3))) bf16x8*)(kp+4096); kf[5]=*(const __attribute__((address_space(3))) bf16x8*)(kp+4608);
  kf[6]=*(const __attribute__((address_space(3))) bf16x8*)(kp+6144); kf[7]=*(const __attribute__((address_space(3))) bf16x8*)(kp+6656);
}
__device__ __forceinline__ void kload2(bf16x8*kf,lds_cptr kp,int j){ kf[2*j]=*(const __attribute__((address_space(3))) bf16x8*)(kp+j*2048); kf[2*j+1]=*(const __attribute__((address_space(3))) bf16x8*)(kp+j*2048+512); }
__device__ __forceinline__ s16x4 vtr(lds_cptr p){ return __builtin_bit_cast(s16x4,__builtin_amdgcn_ds_read_tr16_b64_v4i16((__attribute__((address_space(3))) v4i16_t*)p)); }
__device__ __forceinline__ float rowmax(const f32x16&p0,const f32x16&p1){
  float a=max3f(p0[0],p0[1],p1[0]),b=max3f(p0[2],p0[3],p1[1]);a=max3f(a,p1[2],p1[3]);
  #pragma unroll
  for(int r=4;r<16;r+=4){a=max3f(a,p0[r],p0[r+1]);b=max3f(b,p0[r+2],p0[r+3]);a=max3f(a,p1[r],p1[r+1]);b=max3f(b,p1[r+2],p1[r+3]);}
  const float m=max2f(a,b);
  auto rr=__builtin_amdgcn_permlane32_swap(__float_as_uint(m),__float_as_uint(m),false,false);
  return max2f(__uint_as_float(rr[0]),__uint_as_float(rr[1]));
}
__device__ __forceinline__ void pv(f32x16*o,int vb,bf16x8 pa0,bf16x8 pa1,bf16x8 pa2,bf16x8 pa3){
  #pragma unroll
  for(int d0=0;d0<2;++d0){s16x4 lo[4],hi[4];
    #pragma unroll
    for(int ks=0;ks<4;++ks){
      asm volatile("ds_read_b64_tr_b16 %0,%1 offset:%c2":"=&v"(lo[ks]):"v"(vb),"i"(d0*4096+ks*1024):"memory");
      asm volatile("ds_read_b64_tr_b16 %0,%1 offset:%c2":"=&v"(hi[ks]):"v"(vb),"i"(d0*4096+ks*1024+512):"memory");}
    asm volatile("s_waitcnt lgkmcnt(0)":::"memory");SBAR();
    #define PK(k) (bf16x8){lo[k][0],lo[k][1],lo[k][2],lo[k][3],hi[k][0],hi[k][1],hi[k][2],hi[k][3]}
    o[d0]=__builtin_amdgcn_mfma_f32_32x32x16_bf16(pa0,PK(0),o[d0],0,0,0);
    o[d0]=__builtin_amdgcn_mfma_f32_32x32x16_bf16(pa1,PK(1),o[d0],0,0,0);
    o[d0]=__builtin_amdgcn_mfma_f32_32x32x16_bf16(pa2,PK(2),o[d0],0,0,0);
    o[d0]=__builtin_amdgcn_mfma_f32_32x32x16_bf16(pa3,PK(3),o[d0],0,0,0);
    #undef PK
  }
}

#ifndef ATTN_STORE16
#define ATTN_STORE16(p,v) (*(u32x4*)(p)=(v))
#endif
template<int THRL> __device__ __forceinline__ void attn_unit(int b,int h,int qb,const bf16*Q,const bf16*__restrict__ K,const bf16*__restrict__ V,bf16*O,const float*Fg,char*shm){
  const int tid=mk_tid(),lane=tid&63,r32=lane&31,hi=lane>>5; const int wid=__builtin_amdgcn_readfirstlane(tid>>6);
  const long rowbase=(long)b*SEQ; const int q0=qb*QB;
  const bf16*Qw=Q+(rowbase+q0+wid*QBLK)*DM+h*D;
  const bf16*Kh=K+rowbase*DM+h*D,*Vh=V+rowbase*DM+h*D;
  const unsigned lds0=(unsigned)(uintptr_t)shm;
  float*wsf=(float*)(shm+LDS_WS)+wid*64;
  const bf16*ksrc=Kh+(long)lane*DM+wid*8;
  const bf16*vsrc=Vh+(long)(16*(wid&3)+(lane>>2))*DM+(wid>>2)*32+(lane&3)*8;
  const unsigned kdst=lds0+LDS_K+wid*1024, vdst=lds0+LDS_V+wid*1024;
  #define DMA_K(t,slot) glds16(ksrc+(long)(t)*KVBLK*DM,(unsigned)__builtin_amdgcn_readfirstlane(kdst+(slot)))
  #define DMA_V(t,slot) glds16(vsrc+(long)(t)*KVBLK*DM,(unsigned)__builtin_amdgcn_readfirstlane(vdst+(slot)))
  const int vb0=(int)(lds0+LDS_V)+((lane>>4)&1)*32+(lane&3)*8+(4*hi+((lane&15)>>2))*64;
  const char*Kbase=shm+LDS_K; bf16x8 kf[8];
  const lds_cptr shm3=(lds_cptr)shm; const lds_cptr kp0=shm3+LDS_K+hi*1024+r32*16; const lds_cptr vp0=shm3+LDS_V+((lane>>4)&1)*32+(lane&3)*8+(4*hi+((lane&15)>>2))*64;
  const int NT=(q0+QB)/KVBLK;
  typedef float f4v_t __attribute__((ext_vector_type(4))); typedef __attribute__((address_space(3))) f4v_t lf4_t; lf4_t*Fl4=(lf4_t*)((__attribute__((address_space(3))) char*)shm+LDS_F);
  { const int nf4=(q0+QB)/4; const f4v_t*src=(const f4v_t*)Fg; for(int i=tid;i<nf4;i+=NW*64) Fl4[i]=-src[i]; }
  const float fq_l=Fg[q0+wid*QBLK+r32];
  #define BINIT(C0,C1,t) do{ const lf4_t*fp_=Fl4+(t)*16+hi; _Pragma("unroll") for(int a_=0;a_<4;++a_){ const f4v_t f0_=fp_[2*a_], f1_=fp_[8+2*a_]; \
      C0[4*a_]=nb+f0_.x; C0[4*a_+1]=nb+f0_.y; C0[4*a_+2]=nb+f0_.z; C0[4*a_+3]=nb+f0_.w; C1[4*a_]=nb+f1_.x; C1[4*a_+1]=nb+f1_.y; C1[4*a_+2]=nb+f1_.z; C1[4*a_+3]=nb+f1_.w; } }while(0)
  DMA_K(0,0);DMA_V(0,0);DMA_K(1,SLOTB);
  bf16x8 qr[4];
  #pragma unroll
  for(int d0=0;d0<4;++d0)qr[d0]=*reinterpret_cast<const bf16x8*>(&Qw[(long)r32*DM+d0*16+hi*8]);
  float mhat=0.f,l_reg=0.f;f32x16 o[2];o[0]=f32x16{};o[1]=f32x16{};float nb=fq_l;
  const int qrel=wid*QBLK+r32;
  #define CMASK(P0,P1,t) do{int jb_=(t)-(NT-4); if(jb_>=0)cmask(P0,P1,jb_,qrel,hi);}while(0)
  bool resc=false;
  #define START(P0,P1) do{ const float rm=rowmax(P0,P1); resc=false; \
    { const float dl=rm; mhat=fadd_s(mhat,dl); \
      _Pragma("unroll") for(int r=0;r<16;++r){P0[r]=fsub_s(P0[r],dl);P1[r]=fsub_s(P1[r],dl);} \
      nb=fq_l-mhat; } \
    _Pragma("unroll") for(int r=0;r<16;++r)P0[r]=__builtin_amdgcn_exp2f(P0[r]); }while(0)
  #define RESC() do{ if(resc){ asm volatile("s_waitcnt lgkmcnt(0)":::"memory"); \
      _Pragma("unroll") for(int d_=0;d_<2;++d_) _Pragma("unroll") for(int r=0;r<16;++r)o[d_][r]*=wsf[crow(r,hi)]; } }while(0)
  f32x16 pA0,pA1,pB0,pB1;
  int sl_prev=0,sl_cur=0,sl_next=SLOTB;
  #define ROT() do{sl_prev=sl_cur;sl_cur=sl_next;sl_next=(sl_next==(NSLOT-1)*SLOTB)?0:sl_next+SLOTB;}while(0)
  DMA_K(2,2*SLOTB);
  WAIT_BAR(3);
  BINIT(pA0,pA1,0); qkt(pA0,pA1,Kbase,qr,r32,hi);asm volatile("s_nop 15\n\ts_nop 7":"+v"(pA0),"+v"(pA1));CMASK(pA0,pA1,0);
  START(pA0,pA1); BINIT(pB0,pB1,1);
  _Pragma("unroll") for(int r=0;r<16;++r)pA1[r]=__builtin_amdgcn_exp2f(pA1[r]);
  WAIT_BAR(0);
  DMA_K(3,0);DMA_V(1,SLOTB);
  ROT();
  kload8(kf,kp0+sl_cur);
  WAIT_BAR(2);
  s16x4 vlo[8],vhi[8]; u32x4 pw0,pw1,pw2,pw3;
  #define PKW(P,B) cvtpk_s(P[B],P[B+1])
  #define PAF(k) __builtin_bit_cast(bf16x8,pw##k)
  #define VFR(i) (bf16x8){vlo[i][0],vlo[i][1],vlo[i][2],vlo[i][3],vhi[i][0],vhi[i][1],vhi[i][2],vhi[i][3]}
  #define PIN(x) asm volatile("":"+v"(x))
  #define MX3(a,b,c) __builtin_fmaxf(__builtin_fmaxf((a),(b)),(c))
  #define GAPA(MF,A0,A1,A2,A3,W0,W1,PW) do{ MF; sacc+=A0; sacc+=A1; sacc+=A2; sacc+=A3; PIN(sacc); W0; W1; PIN(PW); SBAR(); }while(0)
  #define EX(v) __builtin_amdgcn_exp2f(v)
  #define GAPB(MF,X,B,Y) do{ MF; X[B]=EX(X[B]); X[B+1]=EX(X[B+1]); X[B+2]=EX(X[B+2]); X[B+3]=EX(X[B+3]); PIN(X); Y[B]+=nb; Y[B+1]+=nb; Y[B+2]+=nb; Y[B+3]+=nb; PIN(Y); SBAR(); }while(0)
  #define BLOAD(P0,P1,t1) do{ const lf4_t*fp_=Fl4+(t1)*16+hi; _Pragma("unroll") for(int a_=0;a_<4;++a_){ const f4v_t f0_=fp_[2*a_], f1_=fp_[8+2*a_]; \
      P0[4*a_]=f0_.x; P0[4*a_+1]=f0_.y; P0[4*a_+2]=f0_.z; P0[4*a_+3]=f0_.w; P1[4*a_]=f1_.x; P1[4*a_+1]=f1_.y; P1[4*a_+2]=f1_.z; P1[4*a_+3]=f1_.w; } }while(0)
  #define VRD(i) do{ vlo[i]=vtr(vp_+(((i)>>2)*4096+((i)&3)*1024)); vhi[i]=vtr(vp_+(((i)>>2)*4096+((i)&3)*1024+512)); }while(0)
  #define KRD(G,j) do{ if(G){ kload2(kf,kp0+sl_next,j); SBAR(); } }while(0)
  #define STEP(C0,C1,P0,P1,t,GK,GV,GL) do{ SBAR(); \
    const lds_cptr vp_=vp0+sl_prev; \
    VRD(0); SBAR(); float sacc=(P0[0]+P0[1]); \
    GAPA(C0=__builtin_amdgcn_mfma_f32_32x32x16_bf16(kf[0],qr[0],C0,0,0,0), P0[2],P0[3],P0[4],P0[5],     pw0[0]=PKW(P0,0), pw0[1]=PKW(P0,2), pw0); \
    VRD(4); SBAR(); GAPA(C1=__builtin_amdgcn_mfma_f32_32x32x16_bf16(kf[1],qr[0],C1,0,0,0), P0[6],P0[7],P0[8],P0[9],     pw0[2]=PKW(P0,4), pw0[3]=PKW(P0,6), pw0); \
    VRD(1); SBAR(); GAPA(C0=__builtin_amdgcn_mfma_f32_32x32x16_bf16(kf[2],qr[1],C0,0,0,0),   P0[10],P0[11],P0[12],P0[13], pw1[0]=PKW(P0,8), pw1[1]=PKW(P0,10), pw1); \
    VRD(5); SBAR(); GAPA(C1=__builtin_amdgcn_mfma_f32_32x32x16_bf16(kf[3],qr[1],C1,0,0,0),   P0[14],P0[15],P1[0],P1[1],   pw1[2]=PKW(P0,12),pw1[3]=PKW(P0,14), pw1); \
    VRD(2); SBAR(); GAPA(C0=__builtin_amdgcn_mfma_f32_32x32x16_bf16(kf[4],qr[2],C0,0,0,0),   P1[2],P1[3],P1[4],P1[5],     pw2[0]=PKW(P1,0), pw2[1]=PKW(P1,2), pw2); \
    VRD(6); SBAR(); GAPA(C1=__builtin_amdgcn_mfma_f32_32x32x16_bf16(kf[5],qr[2],C1,0,0,0),   P1[6],P1[7],P1[8],P1[9],     pw2[2]=PKW(P1,4), pw2[3]=PKW(P1,6), pw2); \
    VRD(3); SBAR(); GAPA(C0=__builtin_amdgcn_mfma_f32_32x32x16_bf16(kf[6],qr[3],C0,0,0,0),   P1[10],P1[11],P1[12],P1[13], pw3[0]=PKW(P1,8), pw3[1]=PKW(P1,10), pw3); \
    VRD(7); SBAR(); GAPA(C1=__builtin_amdgcn_mfma_f32_32x32x16_bf16(kf[7],qr[3],C1,0,0,0),   P1[14],P1[15],0.f,0.f,       pw3[2]=PKW(P1,12),pw3[3]=PKW(P1,14), pw3); \
    l_reg+=sacc; \
    if(GK){DMA_K((t)+3,sl_cur);} if(GV){DMA_V((t)+1,sl_next);} \
    CMASK(C0,C1,t); \
    { float a=MX3(C0[0],C0[1],C1[0]),b=MX3(C0[2],C0[3],C1[1]); a=MX3(a,C1[2],C1[3]); \
      _Pragma("unroll") for(int r=4;r<16;r+=4){a=MX3(a,C0[r],C0[r+1]);b=MX3(b,C0[r+2],C0[r+3]);a=MX3(a,C1[r],C1[r+1]);b=MX3(b,C1[r+2],C1[r+3]);} \
      float rm=__builtin_fmaxf(a,b); { auto rr=__builtin_amdgcn_permlane32_swap(__float_as_uint(rm),__float_as_uint(rm),false,false); rm=__builtin_fmaxf(__uint_as_float(rr[0]),__uint_as_float(rr[1])); } \
      resc=false; \
      if(__builtin_expect(__any(rm>(float)THRL),0)){ const float dl=__builtin_fmaxf(rm,0.f); mhat+=dl; \
        _Pragma("unroll") for(int r=0;r<16;++r){C0[r]-=dl;C1[r]-=dl;} \
        nb-=dl; \
        const float f=__builtin_amdgcn_exp2f(-dl); l_reg*=f; if(hi==0)wsf[r32]=f; resc=true; } } \
    SBAR(); BLOAD(P0,P1,(t)+1); SBAR(); \
    GAPB(o[0]=__builtin_amdgcn_mfma_f32_32x32x16_bf16(PAF(0),VFR(0),o[0],0,0,0), C0,0,P0); \
    GAPB(o[1]=__builtin_amdgcn_mfma_f32_32x32x16_bf16(PAF(0),VFR(4),o[1],0,0,0), C0,4,P0); \
    KRD(GL,0); GAPB(o[0]=__builtin_amdgcn_mfma_f32_32x32x16_bf16(PAF(1),VFR(1),o[0],0,0,0), C0,8,P0); \
    KRD(GL,1); GAPB(o[1]=__builtin_amdgcn_mfma_f32_32x32x16_bf16(PAF(1),VFR(5),o[1],0,0,0), C0,12,P0); \
    KRD(GL,2); GAPB(o[0]=__builtin_amdgcn_mfma_f32_32x32x16_bf16(PAF(2),VFR(2),o[0],0,0,0), C1,0,P1); \
    KRD(GL,3); GAPB(o[1]=__builtin_amdgcn_mfma_f32_32x32x16_bf16(PAF(2),VFR(6),o[1],0,0,0), C1,4,P1); \
    GAPB(o[0]=__builtin_amdgcn_mfma_f32_32x32x16_bf16(PAF(3),VFR(3),o[0],0,0,0), C1,8,P1); \
    GAPB(o[1]=__builtin_amdgcn_mfma_f32_32x32x16_bf16(PAF(3),VFR(7),o[1],0,0,0), C1,12,P1); \
    }while(0)
  int t=1;
  #undef CMASK
  #define CMASK(P0,P1,t) do{}while(0)
  for(;t+5<NT;t+=2){
    STEP(pB0,pB1,pA0,pA1,t,true,true,true);     WAIT_BAR(2); RESC(); ROT();
    STEP(pA0,pA1,pB0,pB1,t+1,true,true,true);   WAIT_BAR(2); RESC(); ROT();
  }
  #undef CMASK
  #define CMASK(P0,P1,t) do{int jb_=(t)-(NT-4); if(jb_>=0)cmask(P0,P1,jb_,qrel,hi);}while(0)
  #define ENDW(tt) do{ if((tt)+3<NT){WAIT_BAR(2);} else if((tt)+2<NT){WAIT_BAR(1);} else {WAIT_BAR(0);} }while(0)
  for(;t+1<NT;t+=2){
    STEP(pB0,pB1,pA0,pA1,t,(t+3<NT),(t+1<NT),(t+1<NT));       ENDW(t);   RESC(); ROT();
    STEP(pA0,pA1,pB0,pB1,t+1,(t+4<NT),(t+2<NT),(t+2<NT));     ENDW(t+1); RESC(); ROT();
  }
  STEP(pB0,pB1,pA0,pA1,NT-1,false,false,false); RESC();
  { float sacc=pB0[0]+pB0[1]; _Pragma("unroll") for(int r=2;r<16;++r)sacc+=pB0[r]; _Pragma("unroll") for(int r=0;r<16;++r)sacc+=pB1[r]; l_reg+=sacc;
    pw0=(u32x4){PKW(pB0,0),PKW(pB0,2),PKW(pB0,4),PKW(pB0,6)};pw1=(u32x4){PKW(pB0,8),PKW(pB0,10),PKW(pB0,12),PKW(pB0,14)};pw2=(u32x4){PKW(pB1,0),PKW(pB1,2),PKW(pB1,4),PKW(pB1,6)};pw3=(u32x4){PKW(pB1,8),PKW(pB1,10),PKW(pB1,12),PKW(pB1,14)};
    SBAR(); pv(o,vb0+sl_cur,PAF(0),PAF(1),PAF(2),PAF(3)); }
  #undef PKW
  #undef PAF
  #undef VFR
  #undef PIN
  #undef MX3
  #undef GAPA
  #undef GAPB
  #undef BLOAD
  #undef EX
  #undef VRD
  #undef KRD
  #undef STEP
  #undef ENDW
  {auto rr=__builtin_amdgcn_permlane32_swap(__float_as_uint(l_reg),__float_as_uint(l_reg),false,false);l_reg=__uint_as_float(rr[0])+__uint_as_float(rr[1]);}
  if(hi==0)wsf[32+r32]=l_reg;asm volatile("s_waitcnt lgkmcnt(0)":::"memory");
  float rli[16];
  #pragma unroll
  for(int r=0;r<16;++r)rli[r]=__builtin_amdgcn_rcpf(wsf[32+crow(r,hi)]);
  bf16*Ow=O+(rowbase+q0+wid*QBLK)*OPITCH+h*D;
  { bf16*stg=(bf16*)(shm+LDS_OST)+wid*2048;
    #pragma unroll
    for(int r=0;r<16;++r){const int orow=crow(r,hi);
      #pragma unroll
      for(int d0=0;d0<2;++d0)stg[orow*64+d0*32+r32]=__float2bfloat16(o[d0][r]*rli[r]);}
    asm volatile("s_waitcnt lgkmcnt(0)":::"memory");
    #pragma unroll
    for(int i=0;i<4;++i){const int row=i*8+(lane>>3),ch=lane&7; const u32x4 v=*(const u32x4*)(stg+row*64+ch*8); ATTN_STORE16(Ow+(long)row*OPITCH+ch*8,v);} }
  asm volatile("s_waitcnt lgkmcnt(0)\n\ts_barrier":::"memory");
  #undef DMA_K
  #undef DMA_V
  #undef CMASK
  #undef START
  #undef RESC
  #undef ROT
  #undef BINIT
}
constexpr int ATTN_LDS_BYTES=LDS_BYTES;
struct AttnTensors { const bf16* Q; const bf16* K; const bf16* V; bf16* O; const float* F; };
struct AttnUnit { int bh; int qb; };
struct StaticOrder {
  int vcu;
  __device__ __forceinline__ explicit StaticOrder(int v):vcu(v){}
  __device__ __forceinline__ bool next(int i,AttnUnit&u)const{ if(i>=8)return false; const int s=4*(vcu&1)+(i>>1); u.bh=vcu>>1; u.qb=(i&1)?15-s:s; return true; }
};
template<class Sched,int THRL=48> __device__ __forceinline__ void attn_phase(char*lds,const AttnTensors&T,const Sched&S){
  AttnUnit u;
  for(int i=0;S.next(i,u);++i){ attn_unit<THRL>(u.bh/NHEAD,u.bh%NHEAD,u.qb,T.Q,T.K,T.V,T.O,T.F+(size_t)u.bh*SEQ,lds); }
}
#undef SBAR
#undef WAIT_BAR
}
namespace mk {
typedef unsigned short bf16_t;
typedef short bf16x8 __attribute__((ext_vector_type(8)));
typedef float f32x4 __attribute__((ext_vector_type(4)));
typedef float f32x16 __attribute__((ext_vector_type(16)));
typedef unsigned u32x4 __attribute__((ext_vector_type(4)));
typedef unsigned u32x2 __attribute__((ext_vector_type(2)));

constexpr int DM = 1024, NPT = 65536, NST = 512, MT = NPT + NST, SEQ = 4096, DFF = 2816, PW = 3072, NINP = 3328;
constexpr float LOG2E = 1.4426950408889634f;
constexpr float C2 = 0.125f * LOG2E;
constexpr float ALPHA = 1.4142135623730951f;
constexpr size_t O_YP = 0, O_YS = O_YP + 67108864, O_PFK = O_YS + 524288, O_PFV = O_PFK + 67108864, O_PFL = O_PFV + 67108864,
    O_PMC = O_PFL + 1048576, O_PMN = O_PMC + 524288, O_PMM = O_PMN + 8192, O_SFK = O_PMM + 128, O_SFV = O_SFK + 524288,
    O_SFL = O_SFV + 524288, O_SMC = O_SFL + 8192, O_SMN = O_SMC + 524288, O_SMM = O_SMN + 8192, O_SGV = O_SMM + 128, O_END = O_SGV + 262144;
constexpr size_t MiB = 1u << 20;
constexpr size_t WS_MOD = 1 * MiB, WS_STATS = 3 * MiB, WS_GATES = 6 * MiB, WS_FQ = 11 * MiB, WS_AB = 13 * MiB, WS_MS = 13 * MiB + 65536, WS_NS = 14 * MiB,
    WS_WIN = 16 * MiB, WS_WO = 29 * MiB, WS_WGU = 33 * MiB, WS_WD = 55 * MiB, WS_GW = 66 * MiB, WS_HA = 67 * MiB, WS_PROJ = 196 * MiB,
    WS_R1 = 583 * MiB, WS_R2 = 712 * MiB, WS_UT = 841 * MiB, WS_CS = 906 * MiB, WS_END = 938 * MiB;
constexpr int LDS_BYTES = 155648;

struct Ctx {
    unsigned char* ws; float* out; const PG8_LAS unsigned long long* tab;
    __device__ __forceinline__ const float* in(int i) const { const unsigned long long v = tab[i]; const unsigned lo = __builtin_amdgcn_readfirstlane((unsigned)v), hi = __builtin_amdgcn_readfirstlane((unsigned)(v >> 32)); return (const float*)(const __attribute__((address_space(1))) float*)(((unsigned long long)hi << 32) | lo); }
    __device__ __forceinline__ const float* x_prompt() const { return in(0); }
    __device__ __forceinline__ const float* x_sample() const { return in(1); }
    __device__ __forceinline__ const float* cache_k() const { return in(2); }
    __device__ __forceinline__ const float* cache_v() const { return in(3); }
    __device__ __forceinline__ const float* cache_logf() const { return in(4); }
    __device__ __forceinline__ const float* st_C() const { return in(5); }
    __device__ __forceinline__ const float* st_n() const { return in(6); }
    __device__ __forceinline__ const float* st_m() const { return in(7); }
    __device__ __forceinline__ const float* c_prompt() const { return in(8); }
    __device__ __forceinline__ const float* c_sample() const { return in(9); }
    __device__ __forceinline__ const float* w_ada() const { return in(10); }
    __device__ __forceinline__ const float* b_ada() const { return in(11); }
    __device__ __forceinline__ const float* w_in() const { return in(12); }
    __device__ __forceinline__ const float* b_mi() const { return in(13); }
    __device__ __forceinline__ const float* b_mf() const { return in(14); }
    __device__ __forceinline__ const float* norm_g() const { return in(15); }
    __device__ __forceinline__ const float* b_ff() const { return in(16); }
    __device__ __forceinline__ const float* gln_g() const { return in(17); }
    __device__ __forceinline__ const float* gln_b() const { return in(18); }
    __device__ __forceinline__ const float* gws() const { return in(19); }
    __device__ __forceinline__ const float* gbs() const { return in(20); }
    __device__ __forceinline__ const float* w_o() const { return in(21); }
    __device__ __forceinline__ const float* ln1_g() const { return in(22); }
    __device__ __forceinline__ const float* ln1_b() const { return in(23); }
    __device__ __forceinline__ const float* w_gate() const { return in(24); }
    __device__ __forceinline__ const float* w_up() const { return in(25); }
    __device__ __forceinline__ const float* w_down() const { return in(26); }
    __device__ __forceinline__ const float* ln2_g() const { return in(27); }
    __device__ __forceinline__ const float* ln2_b() const { return in(28); }
    __device__ __forceinline__ float* MOD() const { return (float*)(ws + WS_MOD); }
    __device__ __forceinline__ float* STATS() const { return (float*)(ws + WS_STATS); }
    __device__ __forceinline__ float* GATES() const { return (float*)(ws + WS_GATES); }
    __device__ __forceinline__ float* FQ() const { return (float*)(ws + WS_FQ); }
    __device__ __forceinline__ float* AB() const { return (float*)(ws + WS_AB); }
    __device__ __forceinline__ float* MS() const { return (float*)(ws + WS_MS); }
    __device__ __forceinline__ float* NS() const { return (float*)(ws + WS_NS); }
    __device__ __forceinline__ float* UT() const { return (float*)(ws + WS_UT); }
    __device__ __forceinline__ bf16_t* WIN() const { return (bf16_t*)(ws + WS_WIN); }
    __device__ __forceinline__ bf16_t* WO() const { return (bf16_t*)(ws + WS_WO); }
    __device__ __forceinline__ bf16_t* WGU() const { return (bf16_t*)(ws + WS_WGU); }
    __device__ __forceinline__ bf16_t* WD() const { return (bf16_t*)(ws + WS_WD); }
    __device__ __forceinline__ bf16_t* GW() const { return (bf16_t*)(ws + WS_GW); }
    __device__ __forceinline__ bf16_t* HA() const { return (bf16_t*)(ws + WS_HA); }
    __device__ __forceinline__ bf16_t* PROJ() const { return (bf16_t*)(ws + WS_PROJ); }
    __device__ __forceinline__ bf16_t* R1() const { return (bf16_t*)(ws + WS_R1); }
    __device__ __forceinline__ bf16_t* R2() const { return (bf16_t*)(ws + WS_R2); }
    __device__ __forceinline__ bf16_t* CS() const { return (bf16_t*)(ws + WS_CS); }
};

__device__ __forceinline__ float bf2f(unsigned u16) { return __uint_as_float(u16 << 16); }
__device__ __forceinline__ unsigned pkbf(float lo, float hi) { unsigned r; asm("v_cvt_pk_bf16_f32 %0, %1, %2" : "=v"(r) : "v"(lo), "v"(hi)); return r; }
__device__ __forceinline__ float logsig(float x) { return fminf(x, 0.f) - __logf(1.f + __expf(-fabsf(x))); }
__device__ __forceinline__ float sigm(float x) { return 1.f / (1.f + __expf(-x)); }
__device__ __forceinline__ float wsum(float v) {
#pragma unroll
    for (int o = 32; o > 0; o >>= 1) v += __shfl_xor(v, o);
    return v;
}
__device__ __forceinline__ float wmax(float v) {
#pragma unroll
    for (int o = 32; o > 0; o >>= 1) v = fmaxf(v, __shfl_xor(v, o));
    return v;
}
__device__ __forceinline__ int row_cb(int row) { return row < NPT ? (row >> 12) : 16 + ((row - NPT) >> 5); }
__device__ __forceinline__ int crow(int r, int hi) { return (r & 3) + 8 * (r >> 2) + 4 * hi; }
__device__ __forceinline__ bf16x8 gather8(const bf16_t* p, int stride, int o4) {
    unsigned v[8];
#pragma unroll
    for (int j = 0; j < 4; ++j) { v[j] = p[j * stride]; v[4 + j] = p[(o4 + j) * stride]; }
    u32x4 w; w.x = v[0] | (v[1] << 16); w.y = v[2] | (v[3] << 16); w.z = v[4] | (v[5] << 16); w.w = v[6] | (v[7] << 16);
    return __builtin_bit_cast(bf16x8, w);
}
__device__ __forceinline__ void unpack8(const u32x4 w, float* f) {
    f[0] = bf2f(w.x & 0xffffu); f[1] = bf2f(w.x >> 16); f[2] = bf2f(w.y & 0xffffu); f[3] = bf2f(w.y >> 16);
    f[4] = bf2f(w.z & 0xffffu); f[5] = bf2f(w.z >> 16); f[6] = bf2f(w.w & 0xffffu); f[7] = bf2f(w.w >> 16);
}

__device__ __forceinline__ void tr_item(const float* W, int ldw, int srccol, bf16_t* WT, int K, int dst_row0, int k0, float* scr, int lane) {
    float tv[32];
#pragma unroll
    for (int i = 0; i < 32; ++i) { const int kk = 2 * i + (lane >> 5); tv[i] = srccol >= 0 ? W[(size_t)(k0 + kk) * ldw + srccol] : 0.f; }
#pragma unroll
    for (int i = 0; i < 32; ++i) { const int kk = 2 * i + (lane >> 5); scr[kk * 33 + (lane & 31)] = tv[i]; }
    asm volatile("s_waitcnt lgkmcnt(0)" ::: "memory");
    const int c = lane & 7;
#pragma unroll
    for (int j = 0; j < 4; ++j) { const int n = (lane >> 3) + 8 * j; const float* s = scr + (8 * c) * 33 + n;
        u32x4 o; o.x = pkbf(s[0 * 33], s[1 * 33]); o.y = pkbf(s[2 * 33], s[3 * 33]); o.z = pkbf(s[4 * 33], s[5 * 33]); o.w = pkbf(s[6 * 33], s[7 * 33]);
        *(u32x4*)(WT + (size_t)(dst_row0 + n) * K + k0 + 8 * c) = o; }
    asm volatile("s_waitcnt lgkmcnt(0)" ::: "memory");
}

__device__ __forceinline__ void p0a(const Ctx& C, unsigned char* smem) {
    const int tid = mk_tid(), lane = tid & 63, wid = tid >> 6;
    const int gtid = blockIdx.x * 512 + tid, GT = gridDim.x * 512;
    for (int i = gtid; i < 4 * MT * 2; i += GT) C.STATS()[i] = 0.f;
    for (int i = gtid; i < 2 * 4 * 128 * 128; i += GT) { const int t = (i >> 7) & 127, s = i & 127; C.GW()[i] = (bf16_t)(pkbf(s <= t ? C.gws()[i] : 0.f, 0.f) & 0xffffu); }
    float* sil = (float*)smem;
    for (int u = blockIdx.x; u < 192; u += gridDim.x) {
        __syncthreads();
        for (int i = tid; i < 32 * 1024; i += 512) { const int cb = i >> 10, k = i & 1023; const float c = cb < 16 ? C.c_prompt()[cb * 1024 + k] : C.c_sample()[(cb - 16) * 1024 + k]; sil[i] = c / (1.f + __expf(-c)); }
        __syncthreads();
        const int l = u / 96, n0 = (u % 96) * 64;
        float acc[32];
#pragma unroll
        for (int cb = 0; cb < 32; ++cb) acc[cb] = 0.f;
        const float* W = C.w_ada() + (size_t)l * 1024 * 6144 + n0 + lane;
        for (int k = wid * 128; k < wid * 128 + 128; k += 16) {
            float wv[16];
#pragma unroll
            for (int j = 0; j < 16; ++j) wv[j] = W[(size_t)(k + j) * 6144];
#pragma unroll
            for (int q4 = 0; q4 < 4; ++q4)
#pragma unroll
                for (int cb = 0; cb < 32; ++cb) { const float4 s = *(const float4*)(sil + cb * 1024 + k + 4 * q4); acc[cb] += s.x * wv[4 * q4] + s.y * wv[4 * q4 + 1] + s.z * wv[4 * q4 + 2] + s.w * wv[4 * q4 + 3]; }
        }
        __syncthreads();
#pragma unroll
        for (int cb = 0; cb < 32; ++cb) sil[(wid * 32 + cb) * 64 + lane] = acc[cb];
        __syncthreads();
#pragma unroll
        for (int j = 0; j < 4; ++j) { const int o = tid + 512 * j, cb = o >> 6, ln = o & 63; float s = C.b_ada()[l * 6144 + n0 + ln];
#pragma unroll
            for (int w = 0; w < 8; ++w) s += sil[(w * 32 + cb) * 64 + ln];
            C.MOD()[(size_t)(l * 32 + cb) * 6144 + n0 + ln] = s; }
    }
    __syncthreads();
    float* scr = (float*)smem + wid * 2112;
    const int gw = blockIdx.x * 8 + wid, NGW = gridDim.x * 8;
    for (int it = gw; it < 12800; it += NGW) {
        const int l = it / 6400; int r = it % 6400;
        if (r < 1664) { const int kb = r / 104, nb = r % 104, p = nb * 32 + (lane & 31);
            const int sc = p < 1024 ? p : p < 2560 ? p + 8 : p < 3072 ? p + 16 : (p < 3080 ? p - 3072 + 1024 : (p < 3088 ? p - 3080 + 2568 : -1));
            tr_item(C.w_in() + (size_t)l * 1024 * 3088, 3088, sc, C.WIN() + (size_t)l * NINP * 1024, 1024, nb * 32, kb * 64, scr, lane); continue; }
        r -= 1664;
        if (r < 512) { const int kb = r / 32, nb = r % 32;
            tr_item(C.w_o() + (size_t)l * 1024 * 1024, 1024, nb * 32 + (lane & 31), C.WO() + (size_t)l * 1024 * 1024, 1024, nb * 32, kb * 64, scr, lane); continue; }
        r -= 512;
        if (r < 2816) { const int kb = r / 176, nb = r % 176, pn = nb >> 3, wi = nb & 7;
            const float* src = (wi < 4 ? C.w_gate() : C.w_up()) + (size_t)l * 1024 * DFF;
            tr_item(src, DFF, 128 * pn + 32 * (wi & 3) + (lane & 31), C.WGU() + (size_t)l * 5632 * 1024, 1024, nb * 32, kb * 64, scr, lane); continue; }
        r -= 2816;
        { const int kb = r / 32, nb = r % 32;
            tr_item(C.w_down() + (size_t)l * DFF * 1024, 1024, nb * 32 + (lane & 31), C.WD() + (size_t)l * 1024 * DFF, DFF, nb * 32, kb * 64, scr, lane); }
    }
}

__device__ __forceinline__ void p0b(const Ctx& C) {
    const int lane = mk_tid() & 63, wid = mk_tid() >> 6;
    const int gw = blockIdx.x * 8 + wid, NGW = gridDim.x * 8;
    const float* xp = C.x_prompt(); const float* xs = C.x_sample(); const float* MODp = C.MOD(); bf16_t* HAp = C.HA();
    for (int row0 = gw; row0 < MT; row0 += 2 * NGW) {
        float4 xv[2][4];
#pragma unroll
        for (int q = 0; q < 2; ++q) { const int row = row0 + q * NGW < MT ? row0 + q * NGW : row0;
            const float* xr = row < NPT ? xp + (size_t)row * DM : xs + (size_t)(row - NPT) * DM;
#pragma unroll
            for (int j = 0; j < 4; ++j) xv[q][j] = *(const float4*)(xr + 256 * j + 4 * lane); }
#pragma unroll
        for (int q = 0; q < 2; ++q) { const int row = row0 + q * NGW; if (row >= MT) break;
            const float* md = MODp + (size_t)row_cb(row) * 6144;
#pragma unroll
            for (int j = 0; j < 4; ++j) { const int c = 256 * j + 4 * lane; const float4 x = xv[q][j];
                const float4 sh = *(const float4*)(md + c), sc = *(const float4*)(md + 1024 + c);
                u32x2 o; o.x = pkbf(x.x * (1.f + sc.x) + sh.x, x.y * (1.f + sc.y) + sh.y); o.y = pkbf(x.z * (1.f + sc.z) + sh.z, x.w * (1.f + sc.w) + sh.w);
                *(u32x2*)(HAp + (size_t)row * DM + c) = o; } }
    }
}

__device__ __forceinline__ void ln_apply(const bf16_t* __restrict__ R, const float* __restrict__ stats, const float* __restrict__ g, const float* __restrict__ b, const float* __restrict__ mod_sh, const float* __restrict__ mod_sc,
                                         bf16_t* __restrict__ obf, float* __restrict__ of_p, float* __restrict__ of_s, int row_lo, int row_hi, int gw, int NGW) {
    const int lane = mk_tid() & 63;
    for (int row0 = row_lo + gw; row0 < row_hi; row0 += 4 * NGW) {
        u32x2 rr[4][4]; float mean[4], rstd[4];
#pragma unroll
        for (int q = 0; q < 4; ++q) { const int row = row0 + q * NGW < row_hi ? row0 + q * NGW : row0;
#pragma unroll
            for (int j = 0; j < 4; ++j) rr[q][j] = *(const u32x2*)(R + (size_t)row * DM + 256 * j + 4 * lane);
            const float s = __hip_atomic_load(stats + row * 2, __ATOMIC_RELAXED, __HIP_MEMORY_SCOPE_AGENT), ss = __hip_atomic_load(stats + row * 2 + 1, __ATOMIC_RELAXED, __HIP_MEMORY_SCOPE_AGENT);
            mean[q] = s * (1.f / 1024.f); rstd[q] = rsqrtf(fmaxf(ss * (1.f / 1024.f) - mean[q] * mean[q], 0.f) + 1e-5f); }
#pragma unroll
        for (int q = 0; q < 4; ++q) { const int row = row0 + q * NGW; if (row >= row_hi) break;
            const int cb = row_cb(row);
#pragma unroll
            for (int j = 0; j < 4; ++j) { const int c = 256 * j + 4 * lane;
                const float4 gg = *(const float4*)(g + c), bb = *(const float4*)(b + c);
                float4 x;
                x.x = (bf2f(rr[q][j].x & 0xffffu) - mean[q]) * rstd[q] * gg.x + bb.x; x.y = (bf2f(rr[q][j].x >> 16) - mean[q]) * rstd[q] * gg.y + bb.y;
                x.z = (bf2f(rr[q][j].y & 0xffffu) - mean[q]) * rstd[q] * gg.z + bb.z; x.w = (bf2f(rr[q][j].y >> 16) - mean[q]) * rstd[q] * gg.w + bb.w;
                if (of_p) { float* o = row < NPT ? of_p + (size_t)row * DM : of_s + (size_t)(row - NPT) * DM; f32x4 xv_; xv_[0] = x.x; xv_[1] = x.y; xv_[2] = x.z; xv_[3] = x.w; *(f32x4*)(o + c) = xv_; }
                if (obf) { const float4 sh = *(const float4*)(mod_sh + (size_t)cb * 6144 + c), sc = *(const float4*)(mod_sc + (size_t)cb * 6144 + c);
                    u32x2 o; o.x = pkbf(x.x * (1.f + sc.x) + sh.x, x.y * (1.f + sc.y) + sh.y); o.y = pkbf(x.z * (1.f + sc.z) + sh.z, x.w * (1.f + sc.w) + sh.w);
                    *(u32x2*)(obf + (size_t)row * DM + c) = o; }
            } }
    }
}

using pg8::Unit;
struct PanelOrder {
    int c, G, np;
    __device__ __forceinline__ void init(int G_, int c_) { G = G_; c = c_; np = c_ < 256 ? (256 - c_ + G_ - 1) / G_ : 0; }
    __device__ __forceinline__ bool next(int i, Unit& u) const {
        if (i < 4 * np) { u.pm = c + (i >> 2) * G; u.pn = i & 3; return true; }
        const int s = c + (i - 4 * np) * G; if (s < 8) { u.pm = 256 + (s >> 2); u.pn = s & 3; return true; }
        return false; }
    __device__ __forceinline__ void a_ready(const Unit&) const {}
    __device__ __forceinline__ void done(const Unit&) const {}
};
struct EpiInProj {
    static constexpr bool PERM = true, AFTER_DRAIN = false;
    bf16_t* proj; float* gates; float* out; int layer; const float *bi, *bf, *bff;
    __device__ __forceinline__ void operator()(const f32x4 (&acc)[2][2][4][2], const Unit& u, int wr, int wc, int fr, int fq) const {
        const int row0 = u.pm * 256 + wr * 64 + fr, pn = u.pn;
        if (pn < 12) {
            const float sc = (pn == 4 || pn == 5) ? C2 : (pn == 1 ? 0.125f : 1.f);
            const bool f32o = pn >= 6 && pn < 10;
            const int colf0 = ((pn - 6) & 1) * 256 + wc * 32 + 8 * fq;
#pragma unroll
            for (int ai = 0; ai < 2; ++ai)
#pragma unroll
                for (int m = 0; m < 4; ++m) { const int row = row0 + ai * 128 + m * 16;
                    bf16_t* rowp = proj + (size_t)row * PW + pn * 256 + wc * 32 + 8 * fq;
                    float* fo = nullptr;
                    if (f32o) { fo = row < NPT ? out + (pn < 8 ? O_PFK : O_PFV) + ((size_t)layer * NPT + row) * 512 : out + (pn < 8 ? O_SFK : O_SFV) + ((size_t)layer * NST + (row - NPT)) * 512; fo += colf0; }
#pragma unroll
                    for (int bj = 0; bj < 2; ++bj) { const f32x4 v0 = acc[ai][bj][m][0], v1 = acc[ai][bj][m][1];
                        u32x4 w; w.x = pkbf(v0[0] * sc, v0[1] * sc); w.y = pkbf(v0[2] * sc, v0[3] * sc); w.z = pkbf(v1[0] * sc, v1[1] * sc); w.w = pkbf(v1[2] * sc, v1[3] * sc);
                        *(u32x4*)(rowp + bj * 128) = w;
                        if (f32o) { *(f32x4*)(fo + bj * 128) = v0; *(f32x4*)(fo + bj * 128 + 4) = v1; } } }
        } else if (wc == 0 && fq < 2) {
#pragma unroll
            for (int ai = 0; ai < 2; ++ai)
#pragma unroll
                for (int m = 0; m < 4; ++m) { const int row = row0 + ai * 128 + m * 16;
                    const f32x4 v0 = acc[ai][0][m][0], v1 = acc[ai][0][m][1];
                    float* gp = gates + (size_t)row * 16;
                    if (fq == 0) {
                        f32x4 li, lf;
#pragma unroll
                        for (int j = 0; j < 4; ++j) { li[j] = v0[j] + bi[j]; lf[j] = logsig(v1[j] + bf[j]); }
                        *(f32x4*)gp = li; *(f32x4*)(gp + 4) = lf;
                    } else {
                        f32x4 a, b;
#pragma unroll
                        for (int j = 0; j < 4; ++j) { a[j] = logsig(v0[j] + bff[j]); b[j] = logsig(v1[j] + bff[4 + j]); }
                        *(f32x4*)(gp + 8) = a; *(f32x4*)(gp + 12) = b;
                        float* lo = row < NPT ? out + O_PFL + ((size_t)layer * NPT + row) * 8 : out + O_SFL + ((size_t)layer * NST + (row - NPT)) * 8;
                        *(f32x4*)lo = a; *(f32x4*)(lo + 4) = b;
                    } }
        }
    }
};
struct EpiSwiGLU {
    static constexpr bool PERM = true, AFTER_DRAIN = false;
    bf16_t* hid;
    __device__ __forceinline__ void operator()(const f32x4 (&acc)[2][2][4][2], const Unit& u, int wr, int wc, int fr, int fq) const {
        const int row0 = u.pm * 256 + wr * 64 + fr;
#pragma unroll
        for (int ai = 0; ai < 2; ++ai)
#pragma unroll
            for (int m = 0; m < 4; ++m) { const int row = row0 + ai * 128 + m * 16;
                float h[8];
#pragma unroll
                for (int n = 0; n < 2; ++n)
#pragma unroll
                    for (int j = 0; j < 4; ++j) { const float g = acc[ai][0][m][n][j], up = acc[ai][1][m][n][j]; h[4 * n + j] = g * up / (1.f + __expf(-g)); }
                u32x4 w; w.x = pkbf(h[0], h[1]); w.y = pkbf(h[2], h[3]); w.z = pkbf(h[4], h[5]); w.w = pkbf(h[6], h[7]);
                *(u32x4*)(hid + (size_t)row * DFF + u.pn * 128 + wc * 32 + 8 * fq) = w; }
    }
};
template <bool XN> struct EpiRes {
    static constexpr bool PERM = false, AFTER_DRAIN = false;
    const float *xp, *xs;
    const bf16_t* Rp; const float *Sp, *gp, *bp;
    const float* gate;
    bf16_t* R; float* stats;
    __device__ __forceinline__ void operator()(const f32x4 (&acc)[2][2][4][2], const Unit& u, int wr, int wc, int fr, int fq) const {
        const int col0 = u.pn * 256 + wc * 32 + 4 * fq;
#pragma unroll
        for (int ai = 0; ai < 2; ++ai)
#pragma unroll
            for (int m = 0; m < 4; ++m) { const int row = u.pm * 256 + ai * 128 + wr * 64 + m * 16 + fr; const int cb = row_cb(row);
                float mean = 0.f, rstd = 0.f;
                if (XN) { const float s = Sp[row * 2], ss = Sp[row * 2 + 1]; mean = s * (1.f / 1024.f); rstd = rsqrtf(fmaxf(ss * (1.f / 1024.f) - mean * mean, 0.f) + 1e-5f); }
                const float* xr = XN ? nullptr : (row < NPT ? xp + (size_t)row * DM : xs + (size_t)(row - NPT) * DM);
                float ps = 0.f, pss = 0.f;
#pragma unroll
                for (int bj = 0; bj < 2; ++bj)
#pragma unroll
                    for (int n = 0; n < 2; ++n) { const int c = col0 + bj * 128 + n * 16;
                        f32x4 x;
                        if (XN) { const u32x2 rr = *(const u32x2*)(Rp + (size_t)row * DM + c); const f32x4 gg = *(const f32x4*)(gp + c), bb = *(const f32x4*)(bp + c);
                            x[0] = (bf2f(rr.x & 0xffffu) - mean) * rstd * gg[0] + bb[0]; x[1] = (bf2f(rr.x >> 16) - mean) * rstd * gg[1] + bb[1];
                            x[2] = (bf2f(rr.y & 0xffffu) - mean) * rstd * gg[2] + bb[2]; x[3] = (bf2f(rr.y >> 16) - mean) * rstd * gg[3] + bb[3];
                        } else x = *(const f32x4*)(xr + c);
                        const f32x4 gt = *(const f32x4*)(gate + (size_t)cb * 6144 + c);
                        const f32x4 a = acc[ai][bj][m][n];
                        f32x4 r;
#pragma unroll
                        for (int j = 0; j < 4; ++j) { r[j] = ALPHA * x[j] + (1.f + gt[j]) * a[j]; ps += r[j]; pss += r[j] * r[j]; }
                        u32x2 w; w.x = pkbf(r[0], r[1]); w.y = pkbf(r[2], r[3]);
                        *(u32x2*)(R + (size_t)row * DM + c) = w; }
                ps += __shfl_xor(ps, 16); ps += __shfl_xor(ps, 32); pss += __shfl_xor(pss, 16); pss += __shfl_xor(pss, 32);
                if (fq == 0) { atomicAdd(stats + row * 2, ps); atomicAdd(stats + row * 2 + 1, pss); } }
    }
};
__device__ __forceinline__ void fcum_unit(const Ctx& C, int b, unsigned char* smem) {
    const int tid = mk_tid();
    float* tot = (float*)smem;
    float pre[8][8];
    const float* gp = C.GATES() + ((size_t)b * SEQ + tid * 8) * 16 + 8;
    float run[8];
#pragma unroll
    for (int h = 0; h < 8; ++h) run[h] = 0.f;
#pragma unroll
    for (int j = 0; j < 8; ++j) { const float4 a = *(const float4*)(gp + j * 16), c = *(const float4*)(gp + j * 16 + 4);
        run[0] += a.x; run[1] += a.y; run[2] += a.z; run[3] += a.w; run[4] += c.x; run[5] += c.y; run[6] += c.z; run[7] += c.w;
#pragma unroll
        for (int h = 0; h < 8; ++h) pre[j][h] = run[h]; }
    __syncthreads();
#pragma unroll
    for (int h = 0; h < 8; ++h) tot[tid * 8 + h] = run[h];
    __syncthreads();
    int cur = 0;
    for (int d = 1; d < 512; d <<= 1) {
        float v[8];
#pragma unroll
        for (int h = 0; h < 8; ++h) { v[h] = tot[cur * 4096 + tid * 8 + h]; if (tid >= d) v[h] += tot[cur * 4096 + (tid - d) * 8 + h]; }
#pragma unroll
        for (int h = 0; h < 8; ++h) tot[(cur ^ 1) * 4096 + tid * 8 + h] = v[h];
        cur ^= 1;
        __syncthreads();
    }
#pragma unroll
    for (int h = 0; h < 8; ++h) { const float off = tid > 0 ? tot[cur * 4096 + (tid - 1) * 8 + h] : 0.f;
        float* o = C.FQ() + ((size_t)(b * 8 + h)) * SEQ + tid * 8;
        float4 a, c; a.x = (off + pre[0][h]) * LOG2E; a.y = (off + pre[1][h]) * LOG2E; a.z = (off + pre[2][h]) * LOG2E; a.w = (off + pre[3][h]) * LOG2E;
        c.x = (off + pre[4][h]) * LOG2E; c.y = (off + pre[5][h]) * LOG2E; c.z = (off + pre[6][h]) * LOG2E; c.w = (off + pre[7][h]) * LOG2E;
        *(float4*)o = a; *(float4*)(o + 4) = c; }
    __syncthreads();
}

constexpr int M1_PAIRB = 18944, TP = 72;
__device__ __forceinline__ void m1_quad(const Ctx& C, int quad, unsigned char* smem) {
    const int tid = mk_tid(), lane = tid & 63, wid = __builtin_amdgcn_readfirstlane(tid >> 6), p = wid >> 1, sub = wid & 1, r32 = lane & 31, hi = lane >> 5;
    const int gc = quad * 4 + p, bh = gc >> 6, c = gc & 63, b = bh >> 2, h = bh & 3;
    const int row0 = b * SEQ + c * 64;
    unsigned char* base = smem + p * M1_PAIRB;
    bf16_t* Kt = (bf16_t*)base; bf16_t* Vt = (bf16_t*)(base + 9216); float* wt = (float*)(base + 18432);
    const int tp = tid & 127;
    u32x4 kpre[4], vpre[4];
#pragma unroll
    for (int j = 0; j < 4; ++j) { const int id = tp + 128 * j, s = id & 63, d8 = (id >> 6) * 8;
        kpre[j] = *(const u32x4*)(C.PROJ() + (size_t)(row0 + s) * PW + 256 + h * 64 + d8);
        vpre[j] = *(const u32x4*)(C.PROJ() + (size_t)(row0 + s) * PW + 512 + h * 64 + d8); }
    if (sub == 0) {
        const float lf = C.GATES()[(size_t)(row0 + lane) * 16 + 4 + h], li = C.GATES()[(size_t)(row0 + lane) * 16 + h];
        float B = lf;
#pragma unroll
        for (int o = 1; o < 64; o <<= 1) { const float t = __shfl_up(B, o); if (lane >= o) B += t; }
        const float g = li - B, G = wmax(g), a = __shfl(B, 63);
        wt[lane] = __expf(g - G);
        if (lane == 0) { C.AB()[gc * 2] = a; C.AB()[gc * 2 + 1] = a + G; }
    }
    __syncthreads();
#pragma unroll
    for (int j = 0; j < 4; ++j) { const int id = tp + 128 * j, s = id & 63, d8 = (id >> 6) * 8;
        const u32x4 kk = kpre[j], vv = vpre[j];
        float f[8]; unpack8(kk, f); const float w = wt[s];
        u32x4 kw; kw.x = pkbf(f[0] * w, f[1] * w); kw.y = pkbf(f[2] * w, f[3] * w); kw.z = pkbf(f[4] * w, f[5] * w); kw.w = pkbf(f[6] * w, f[7] * w);
        *(u32x4*)(Kt + s * TP + d8) = kw; *(u32x4*)(Vt + s * TP + d8) = vv; }
    __syncthreads();
    f32x16 acc[2]; acc[0] = f32x16{}; acc[1] = f32x16{};
#pragma unroll
    for (int ks = 0; ks < 4; ++ks) {
        const bf16x8 a = gather8(Kt + (16 * ks + 8 * hi) * TP + 32 * sub + r32, TP, 4);
#pragma unroll
        for (int bj = 0; bj < 2; ++bj) { const bf16x8 bb = gather8(Vt + (16 * ks + 8 * hi) * TP + 32 * bj + r32, TP, 4);
            acc[bj] = __builtin_amdgcn_mfma_f32_32x32x16_bf16(a, bb, acc[bj], 0, 0, 0); }
    }
    float* U = C.UT() + (size_t)gc * 4160;
#pragma unroll
    for (int bj = 0; bj < 2; ++bj)
#pragma unroll
        for (int a4 = 0; a4 < 4; ++a4) { f32x4 v; v[0] = acc[bj][4 * a4]; v[1] = acc[bj][4 * a4 + 1]; v[2] = acc[bj][4 * a4 + 2]; v[3] = acc[bj][4 * a4 + 3];
            *(f32x4*)(U + (32 * bj + r32) * 64 + 32 * sub + 8 * a4 + 4 * hi) = v; }
    { float su = 0.f;
#pragma unroll 8
        for (int s = 0; s < 32; ++s) su += bf2f(Kt[(32 * hi + s) * TP + 32 * sub + r32]);
        su += __shfl_xor(su, 32);
        if (hi == 0) U[4096 + 32 * sub + r32] = su; }
    __syncthreads();
}

__device__ __forceinline__ void scan_phase(const Ctx& C, int l) {
    const int gtid = blockIdx.x * 512 + mk_tid(), GT = gridDim.x * 512;
    for (int idx = gtid; idx < 64 * 2080; idx += GT) {
        const int bh = idx / 2080, e = (idx % 2080) * 2;
        float s0 = 0.f, s1 = 0.f, m = -INFINITY;
        const float* U = C.UT() + (size_t)bh * 64 * 4160 + e; const float* ab = C.AB() + bh * 128;
#pragma unroll 8
        for (int c = 0; c < 64; ++c) { const int gc = bh * 64 + c;
            if (e < 4096) *(unsigned*)(C.CS() + (size_t)gc * 4096 + e) = pkbf(s0, s1); else { float2 o; o.x = s0; o.y = s1; *(float2*)(C.NS() + gc * 64 + e - 4096) = o; }
            if (e == 0) C.MS()[gc] = m;
            const float2 abv = *(const float2*)(ab + 2 * c); const float2 u = *(const float2*)(U + (size_t)c * 4160);
            const float mn = fmaxf(m + abv.x, abv.y);
            const float f0 = __expf(m + abv.x - mn), f1 = __expf(abv.y - mn);
            s0 = f0 * s0 + f1 * u.x; s1 = f0 * s1 + f1 * u.y; m = mn; }
        const int b_ = bh >> 2, h = bh & 3;
        if (e < 4096) { const int dv = e >> 6, dk = e & 63; float* o = C.out + O_PMC + ((size_t)((l * 16 + b_) * 4 + h)) * 4096 + dk * 64 + dv; o[0] = s0; o[64] = s1; }
        else { float* o = C.out + O_PMN + ((l * 16 + b_) * 4 + h) * 64 + e - 4096; o[0] = s0; o[1] = s1; }
        if (e == 0) C.out[O_PMM + (l * 16 + b_) * 4 + h] = m;
    }
}

constexpr int M3_PAIRB = 27136;
__device__ __forceinline__ void m3_quad(const Ctx& C, int l, int quad, unsigned char* smem) {
    const int tid = mk_tid(), lane = tid & 63, wid = __builtin_amdgcn_readfirstlane(tid >> 6), p = wid >> 1, tb = wid & 1, r32 = lane & 31, hi = lane >> 5;
    const int gc = quad * 4 + p, bh = gc >> 6, c = gc & 63, b = bh >> 2, h = bh & 3;
    const int row0 = b * SEQ + c * 64;
    unsigned char* base = smem + p * M3_PAIRB;
    bf16_t* Vt = (bf16_t*)base; float* tg = (float*)(base + 9216); float* tmu = tg + 64; float* te = tg + 128; float* tmt = tg + 192; float* tn0 = tg + 256;
    float* Hs = (float*)(base + 9216 + 1280) + tb * 2080;
    const int t = 32 * tb + r32;
    bf16x8 qf[4], kfr[2][4], cbf[2][4]; u32x4 mof[4];
#pragma unroll
    for (int ds = 0; ds < 4; ++ds) qf[ds] = *(const bf16x8*)(C.PROJ() + (size_t)(row0 + t) * PW + h * 64 + 16 * ds + 8 * hi);
#pragma unroll
    for (int sb = 0; sb < 2; ++sb) if (sb <= tb) {
#pragma unroll
        for (int ds = 0; ds < 4; ++ds) kfr[sb][ds] = *(const bf16x8*)(C.PROJ() + (size_t)(row0 + 32 * sb + r32) * PW + 256 + h * 64 + 16 * ds + 8 * hi); }
#pragma unroll
    for (int bj = 0; bj < 2; ++bj)
#pragma unroll
        for (int ds = 0; ds < 4; ++ds) cbf[bj][ds] = *(const bf16x8*)(C.CS() + (size_t)gc * 4096 + (32 * bj + r32) * 64 + 16 * ds + 8 * hi);
#pragma unroll
    for (int j8 = 0; j8 < 4; ++j8) mof[j8] = *(const u32x4*)(C.PROJ() + (size_t)(row0 + t) * PW + 768 + h * 64 + 32 * hi + 8 * j8);
    if (tb == 0) {
        const float lf = C.GATES()[(size_t)(row0 + lane) * 16 + 4 + h], li = C.GATES()[(size_t)(row0 + lane) * 16 + h];
        float B = lf;
#pragma unroll
        for (int o = 1; o < 64; o <<= 1) { const float t = __shfl_up(B, o); if (lane >= o) B += t; }
        const float g = li - B; float G = g;
#pragma unroll
        for (int o = 1; o < 64; o <<= 1) { const float t = __shfl_up(G, o); if (lane >= o) G = fmaxf(G, t); }
        const float m0 = C.MS()[gc], mu = fmaxf(m0, G);
        tg[lane] = g; tmu[lane] = mu; te[lane] = __expf(m0 - mu); tmt[lane] = B + mu; tn0[lane] = C.NS()[gc * 64 + lane];
    }
    { const int tp = tid & 127;
#pragma unroll
        for (int j = 0; j < 4; ++j) { const int id = tp + 128 * j, s = id & 63, d8 = (id >> 6) * 8;
            *(u32x4*)(Vt + s * TP + d8) = *(const u32x4*)(C.PROJ() + (size_t)(row0 + s) * PW + 512 + h * 64 + d8); } }
    __syncthreads();
    f32x16 st[2]; st[0] = f32x16{}; st[1] = f32x16{};
#pragma unroll
    for (int sb = 0; sb < 2; ++sb) if (sb <= tb) {
#pragma unroll
        for (int ds = 0; ds < 4; ++ds) st[sb] = __builtin_amdgcn_mfma_f32_32x32x16_bf16(kfr[sb][ds], qf[ds], st[sb], 0, 0, 0); }
    const float mu_t = tmu[t], e_t = te[t];
    float den = 0.f;
#pragma unroll
    for (int sb = 0; sb < 2; ++sb) if (sb <= tb) {
#pragma unroll
        for (int r = 0; r < 16; ++r) { const int s = 32 * sb + crow(r, hi); const float w = (s <= t) ? __expf(tg[s] - mu_t) : 0.f; st[sb][r] *= w; den += st[sb][r]; } }
    den += __shfl_xor(den, 32);
    f32x16 acc[2]; acc[0] = f32x16{}; acc[1] = f32x16{};
#pragma unroll
    for (int sb = 0; sb < 2; ++sb) if (sb <= tb) {
#pragma unroll
        for (int kk = 0; kk < 2; ++kk) { u32x4 pw; pw.x = pkbf(st[sb][8 * kk], st[sb][8 * kk + 1]); pw.y = pkbf(st[sb][8 * kk + 2], st[sb][8 * kk + 3]);
            pw.z = pkbf(st[sb][8 * kk + 4], st[sb][8 * kk + 5]); pw.w = pkbf(st[sb][8 * kk + 6], st[sb][8 * kk + 7]);
            const bf16x8 pa = __builtin_bit_cast(bf16x8, pw);
#pragma unroll
            for (int bj = 0; bj < 2; ++bj) { const bf16x8 vb = gather8(Vt + (32 * sb + 16 * kk + 4 * hi) * TP + 32 * bj + r32, TP, 8);
                acc[bj] = __builtin_amdgcn_mfma_f32_32x32x16_bf16(pa, vb, acc[bj], 0, 0, 0); } } }
    float qn = 0.f;
#pragma unroll
    for (int ds = 0; ds < 4; ++ds) { float f[8]; unpack8(__builtin_bit_cast(u32x4, qf[ds]), f);
#pragma unroll
        for (int j = 0; j < 8; ++j) qn += f[j] * tn0[16 * ds + 8 * hi + j];
        u32x4 qs; qs.x = pkbf(f[0] * e_t, f[1] * e_t); qs.y = pkbf(f[2] * e_t, f[3] * e_t); qs.z = pkbf(f[4] * e_t, f[5] * e_t); qs.w = pkbf(f[6] * e_t, f[7] * e_t);
        const bf16x8 qa = __builtin_bit_cast(bf16x8, qs);
#pragma unroll
        for (int bj = 0; bj < 2; ++bj) acc[bj] = __builtin_amdgcn_mfma_f32_32x32x16_bf16(qa, cbf[bj][ds], acc[bj], 0, 0, 0); }
    qn += __shfl_xor(qn, 32);
    den += e_t * qn;
    const float rden = 1.f / fmaxf(fabsf(den), __expf(-tmt[t]));
#pragma unroll
    for (int bj = 0; bj < 2; ++bj)
#pragma unroll
        for (int r = 0; r < 16; ++r) Hs[crow(r, hi) * 65 + 32 * bj + r32] = acc[bj][r];
    asm volatile("s_waitcnt lgkmcnt(0)" ::: "memory");
    float hv[32]; float s1 = 0.f;
#pragma unroll
    for (int j = 0; j < 32; ++j) { hv[j] = Hs[r32 * 65 + 32 * hi + j] * rden; s1 += hv[j]; }
    s1 += __shfl_xor(s1, 32);
    const float mean = s1 * (1.f / 64.f); float s2 = 0.f;
#pragma unroll
    for (int j = 0; j < 32; ++j) { hv[j] -= mean; s2 += hv[j] * hv[j]; }
    s2 += __shfl_xor(s2, 32);
    const float rstd = rsqrtf(s2 * (1.f / 64.f) + 1e-6f);
    const size_t row = (size_t)row0 + t;
    const float* ng = C.norm_g() + l * 256 + h * 64 + 32 * hi;
#pragma unroll
    for (int j8 = 0; j8 < 4; ++j8) { float mo[8]; unpack8(mof[j8], mo);
        float o[8];
#pragma unroll
        for (int j = 0; j < 8; ++j) o[j] = hv[8 * j8 + j] * rstd * ng[8 * j8 + j] * sigm(mo[j]);
        u32x4 w; w.x = pkbf(o[0], o[1]); w.y = pkbf(o[2], o[3]); w.z = pkbf(o[4], o[5]); w.w = pkbf(o[6], o[7]);
        *(u32x4*)(C.HA() + row * DM + h * 64 + 32 * hi + 8 * j8) = w; }
    __syncthreads();
}

constexpr int GP = 264;
__device__ __forceinline__ void gmlp_unit(const Ctx& C, int l, int unit, unsigned char* smem) {
    const int tid = mk_tid(), lane = tid & 63, wid = __builtin_amdgcn_readfirstlane(tid >> 6), r32 = lane & 31, hi = lane >> 5;
    const int row0 = unit * 128;
    bf16_t* vn = (bf16_t*)smem;
    const float4 lg = *(const float4*)(C.gln_g() + l * 256 + 4 * lane), lb = *(const float4*)(C.gln_b() + l * 256 + 4 * lane);
    u32x2 rpre[16];
#pragma unroll
    for (int i = 0; i < 16; ++i) rpre[i] = *(const u32x2*)(C.PROJ() + (size_t)(row0 + wid * 16 + i) * PW + 2816 + 4 * lane);
#pragma unroll
    for (int i = 0; i < 16; ++i) { const int s = wid * 16 + i;
        const u32x2 rr = rpre[i];
        float v0 = bf2f(rr.x & 0xffffu), v1 = bf2f(rr.x >> 16), v2 = bf2f(rr.y & 0xffffu), v3 = bf2f(rr.y >> 16);
        const float mean = wsum((v0 + v1) + (v2 + v3)) * (1.f / 256.f);
        v0 -= mean; v1 -= mean; v2 -= mean; v3 -= mean;
        const float rstd = rsqrtf(wsum((v0 * v0 + v1 * v1) + (v2 * v2 + v3 * v3)) * (1.f / 256.f) + 1e-5f);
        u32x2 o; o.x = pkbf(v0 * rstd * lg.x + lb.x, v1 * rstd * lg.y + lb.y); o.y = pkbf(v2 * rstd * lg.z + lb.z, v3 * rstd * lg.w + lb.w);
        *(u32x2*)(vn + s * GP + 4 * lane) = o; }
    __syncthreads();
    const int g = wid >> 1, th = wid & 1;
    const bf16_t* W = C.GW() + (size_t)(l * 4 + g) * 128 * 128;
    f32x16 acc[2][2];
#pragma unroll
    for (int i = 0; i < 2; ++i) { acc[i][0] = f32x16{}; acc[i][1] = f32x16{}; }
#pragma unroll
    for (int ks = 0; ks < 8; ++ks) {
        bf16x8 bfr[2];
        if (ks < 4 * th + 4) {
#pragma unroll
            for (int cbk = 0; cbk < 2; ++cbk) bfr[cbk] = gather8(vn + (16 * ks + 8 * hi) * GP + g * 64 + 32 * cbk + r32, GP, 4);
#pragma unroll
            for (int i = 0; i < 2; ++i) { const int tbk = 2 * th + i;
                if (ks < 2 * tbk + 2) { const bf16x8 a = *(const bf16x8*)(W + (32 * tbk + r32) * 128 + 16 * ks + 8 * hi);
                    acc[i][0] = __builtin_amdgcn_mfma_f32_32x32x16_bf16(a, bfr[0], acc[i][0], 0, 0, 0);
                    acc[i][1] = __builtin_amdgcn_mfma_f32_32x32x16_bf16(a, bfr[1], acc[i][1], 0, 0, 0); } }
        }
    }
    __syncthreads();
    float* Z = (float*)smem;
#pragma unroll
    for (int i = 0; i < 2; ++i)
#pragma unroll
        for (int cbk = 0; cbk < 2; ++cbk)
#pragma unroll
            for (int r = 0; r < 16; ++r) Z[(32 * (2 * th + i) + crow(r, hi)) * 257 + g * 64 + 32 * cbk + r32] = acc[i][cbk][r];
    __syncthreads();
#pragma unroll
    for (int j = 0; j < 8; ++j) { const int id = tid + 512 * j, t = id >> 5, c8 = (id & 31) * 8;
        float gu[8]; unpack8(*(const u32x4*)(C.PROJ() + (size_t)(row0 + t) * PW + 2560 + c8), gu);
        const float bsv = C.gbs()[(size_t)(l * 4 + (c8 >> 6)) * 128 + t];
        const float* z = Z + t * 257 + c8;
        u32x4 w; w.x = pkbf(gu[0] * (z[0] + bsv), gu[1] * (z[1] + bsv)); w.y = pkbf(gu[2] * (z[2] + bsv), gu[3] * (z[3] + bsv));
        w.z = pkbf(gu[4] * (z[4] + bsv), gu[5] * (z[5] + bsv)); w.w = pkbf(gu[6] * (z[6] + bsv), gu[7] * (z[7] + bsv));
        *(u32x4*)(C.HA() + (size_t)(row0 + t) * DM + 768 + c8) = w; }
    __syncthreads();
}

__device__ __forceinline__ void gmlp_sample_unit(const Ctx& C, int l, int bs_, unsigned char* smem) {
    const int tid = mk_tid(), lane = tid & 63, wid = __builtin_amdgcn_readfirstlane(tid >> 6);
    float* vn = (float*)smem;
    float* wl = vn + 32 * 257;
    const int row0 = NPT + bs_ * 32;
    for (int i = tid; i < 4096; i += 512) { const int g = i >> 10, t = (i >> 5) & 31, s2 = i & 31; wl[(g * 32 + t) * 33 + s2] = C.gws()[((size_t)(l * 4 + g) * 128 + t) * 128 + s2]; }
    const float4 lg = *(const float4*)(C.gln_g() + l * 256 + 4 * lane), lb = *(const float4*)(C.gln_b() + l * 256 + 4 * lane);
    for (int i = 0; i < 4; ++i) { const int s = wid * 4 + i;
        const u32x2 rr = *(const u32x2*)(C.PROJ() + (size_t)(row0 + s) * PW + 2816 + 4 * lane);
        float v0 = bf2f(rr.x & 0xffffu), v1 = bf2f(rr.x >> 16), v2 = bf2f(rr.y & 0xffffu), v3 = bf2f(rr.y >> 16);
        const float mean = wsum((v0 + v1) + (v2 + v3)) * (1.f / 256.f);
        v0 -= mean; v1 -= mean; v2 -= mean; v3 -= mean;
        const float rstd = rsqrtf(wsum((v0 * v0 + v1 * v1) + (v2 * v2 + v3 * v3)) * (1.f / 256.f) + 1e-5f);
        float4 o; o.x = v0 * rstd * lg.x + lb.x; o.y = v1 * rstd * lg.y + lb.y; o.z = v2 * rstd * lg.z + lb.z; o.w = v3 * rstd * lg.w + lb.w;
        vn[s * 257 + 4 * lane] = o.x; vn[s * 257 + 4 * lane + 1] = o.y; vn[s * 257 + 4 * lane + 2] = o.z; vn[s * 257 + 4 * lane + 3] = o.w;
        *(float4*)(C.out + O_SGV + ((size_t)(l * 16 + bs_) * 32 + s) * 256 + 4 * lane) = o; }
    __syncthreads();
    for (int j = 0; j < 16; ++j) { const int o = tid + 512 * j, t = o >> 8, cc = o & 255, g = cc >> 6;
        const float* w = wl + (g * 32 + t) * 33;
        float z = C.gbs()[(l * 4 + g) * 128 + t];
        for (int s = 0; s <= t; ++s) z += w[s] * vn[s * 257 + cc];
        const float gu = bf2f(C.PROJ()[(size_t)(row0 + t) * PW + 2560 + cc]);
        C.HA()[(size_t)(row0 + t) * DM + 768 + cc] = (bf16_t)(pkbf(gu * z, 0.f) & 0xffffu); }
    __syncthreads();
}

__device__ __forceinline__ void mlstm_sample_unit(const Ctx& C, int l, int unit, unsigned char* smem) {
    const int tid = mk_tid(), bs_ = unit >> 2, h = unit & 3;
    const int row0 = NPT + bs_ * 32;
    float* q = (float*)smem; float* k = q + 32 * 65; float* v = k + 32 * 65; float* P = v + 32 * 65;
    float* Hh = P + 32 * 33;
    float* tB = Hh + 32 * 65; float* tg = tB + 32; float* tmu = tg + 32; float* te = tmu + 32; float* tmt = te + 32; float* trd = tmt + 32; float* tmean = trd + 32; float* trs = tmean + 32; float* tw = trs + 32; float* C0s = tw + 64; float* n0s = C0s + 4096; float* tlf = n0s + 64; float* tli = tlf + 32;
    const size_t sidx = (size_t)(l * 16 + bs_) * 4 + h;
    int zo = 0; asm volatile("" : "+v"(zo));
    const float* C0g = C.st_C() + sidx * 4096; const float* n0g = C.st_n() + sidx * 64; const float m0 = C.st_m()[sidx];
    for (int i = tid; i < 1024; i += 512) *(float4*)(C0s + 4 * i) = *(const float4*)(C0g + 4 * i);
    if (tid < 64) n0s[tid] = n0g[tid];
    if (tid >= 64 && tid < 96) { const int t = tid - 64; tlf[t] = C.GATES()[(size_t)(row0 + t) * 16 + 4 + h]; tli[t] = C.GATES()[(size_t)(row0 + t) * 16 + h]; }
    const float* C0 = C0s; const float* n0 = n0s;
    for (int i = tid; i < 32 * 64; i += 512) { const int t = i >> 6, d = i & 63; const bf16_t* pr = C.PROJ() + (size_t)(row0 + t) * PW + h * 64 + d;
        q[t * 65 + d] = bf2f(pr[0]); k[t * 65 + d] = bf2f(pr[256]); v[t * 65 + d] = bf2f(pr[512]); }
    __syncthreads();
    if (tid == 0) { float B = 0.f, G = -INFINITY;
        for (int t = 0; t < 32; ++t) { const float lf = tlf[t], li = tli[t];
            B += lf; const float g = li - B; G = fmaxf(G, g); const float mu = fmaxf(m0, G);
            tB[t] = B; tg[t] = g; tmu[t] = mu; te[t] = __expf(m0 - mu); tmt[t] = B + mu; }
        const float mend = B + fmaxf(m0, G);
        for (int s = 0; s < 32; ++s) tw[s] = __expf(B + tg[s] - mend);
        tw[32] = __expf(m0 + B - mend); tw[33] = mend; }
    __syncthreads();
    for (int j = 0; j < 2; ++j) { const int t = tid >> 4, s = (tid & 15) + 16 * j; float d = 0.f;
        if (s <= t) { for (int e = 0; e < 64; ++e) d += q[t * 65 + e] * k[s * 65 + e]; d *= __expf(tg[s] - tmu[t]); }
        P[t * 33 + s] = d; }
    __syncthreads();
    if (tid < 32) { const int t = tid; float den = 0.f, qn = 0.f;
        for (int s = 0; s < 32; ++s) den += P[t * 33 + s];
        for (int e = 0; e < 64; ++e) qn += q[t * 65 + e] * n0[e + zo];
        den += te[t] * qn; trd[t] = 1.f / fmaxf(fabsf(den), __expf(-tmt[t])); }
    __syncthreads();
    { const int t = tid >> 4, d4 = (tid & 15) * 4; float a0 = 0.f, a1 = 0.f, a2 = 0.f, a3 = 0.f, c0 = 0.f, c1 = 0.f, c2 = 0.f, c3 = 0.f;
        for (int s = 0; s < 32; ++s) { const float p = P[t * 33 + s]; a0 += p * v[s * 65 + d4]; a1 += p * v[s * 65 + d4 + 1]; a2 += p * v[s * 65 + d4 + 2]; a3 += p * v[s * 65 + d4 + 3]; }
        for (int e = 0; e < 64; ++e) { const float qq = q[t * 65 + e]; const float4 cc = *(const float4*)(C0 + e * 64 + d4); c0 += qq * cc.x; c1 += qq * cc.y; c2 += qq * cc.z; c3 += qq * cc.w; }
        const float et = te[t], rd = trd[t];
        Hh[t * 65 + d4] = (a0 + et * c0) * rd; Hh[t * 65 + d4 + 1] = (a1 + et * c1) * rd; Hh[t * 65 + d4 + 2] = (a2 + et * c2) * rd; Hh[t * 65 + d4 + 3] = (a3 + et * c3) * rd; }
    __syncthreads();
    if (tid < 32) { float s1 = 0.f; for (int e = 0; e < 64; ++e) s1 += Hh[tid * 65 + e]; const float mean = s1 * (1.f / 64.f); float s2 = 0.f;
        for (int e = 0; e < 64; ++e) { const float d = Hh[tid * 65 + e] - mean; s2 += d * d; }
        tmean[tid] = mean; trs[tid] = rsqrtf(s2 * (1.f / 64.f) + 1e-6f); }
    __syncthreads();
    { const int t = tid >> 4, d4 = (tid & 15) * 4; const size_t row = (size_t)row0 + t; float o[4];
#pragma unroll
        for (int j = 0; j < 4; ++j) { const float mo = bf2f(C.PROJ()[row * PW + 768 + h * 64 + d4 + j]);
            o[j] = (Hh[t * 65 + d4 + j] - tmean[t]) * trs[t] * C.norm_g()[l * 256 + h * 64 + d4 + j] * sigm(mo); }
        u32x2 w; w.x = pkbf(o[0], o[1]); w.y = pkbf(o[2], o[3]); *(u32x2*)(C.HA() + row * DM + h * 64 + d4) = w; }
    { const int dk = tid >> 3, dv8 = (tid & 7) * 8; const float d0 = tw[32]; float a[8];
#pragma unroll
        for (int j = 0; j < 8; ++j) a[j] = d0 * C0[dk * 64 + dv8 + j];
        for (int s = 0; s < 32; ++s) { const float wk = tw[s + zo] * k[s * 65 + dk];
#pragma unroll
            for (int j = 0; j < 8; ++j) a[j] += wk * v[s * 65 + dv8 + j]; }
        float* o = C.out + O_SMC + sidx * 4096 + dk * 64 + dv8;
#pragma unroll
        for (int j = 0; j < 8; ++j) o[j] = a[j]; }
    if (tid < 64) { float a = tw[32] * n0[tid]; for (int s = 0; s < 32; ++s) a += tw[s + zo] * k[s * 65 + tid]; C.out[O_SMN + sidx * 64 + tid] = a; }
    if (tid == 0) C.out[O_SMM + sidx] = tw[33];
    __syncthreads();
}

__device__ __forceinline__ bf16x8 cvt8(const float* p) {
    const float4 a = *(const float4*)p, b = *(const float4*)(p + 4);
    u32x4 w; w.x = pkbf(a.x, a.y); w.y = pkbf(a.z, a.w); w.z = pkbf(b.x, b.y); w.w = pkbf(b.z, b.w);
    return __builtin_bit_cast(bf16x8, w);
}
__device__ __forceinline__ void fox_sample_unit(const Ctx& C, int l, int unit, unsigned char* smem) {
    const int tid = mk_tid(), lane = tid & 63, wid = __builtin_amdgcn_readfirstlane(tid >> 6), r32 = lane & 31, hi = lane >> 5, bs_ = unit >> 3, h = unit & 7;
    constexpr int NS_ = 1056;
    float* F = (float*)smem;
    float* pm = F + 1088;
    float* pl = pm + 256;
    float* wsc = pl + 256;
    float* pO = wsc + 256;
    const int row0 = NPT + bs_ * 32;
    const size_t cbase = (size_t)(l * 16 + bs_);
    if (wid == 0) {
        float v[17]; float tot = 0.f;
#pragma unroll
        for (int j = 0; j < 17; ++j) { const int s = lane * 17 + j; float x = 0.f;
            if (s < 1024) x = C.cache_logf()[(cbase * 1024 + s) * 8 + h]; else if (s < NS_) x = C.GATES()[(size_t)(row0 + s - 1024) * 16 + 8 + h];
            tot += x; v[j] = tot; }
        float inc = tot;
#pragma unroll
        for (int o = 1; o < 64; o <<= 1) { const float t = __shfl_up(inc, o); if (lane >= o) inc += t; }
        const float off = inc - tot;
#pragma unroll
        for (int j = 0; j < 17; ++j) { const int s = lane * 17 + j; if (s < NS_) F[s] = (off + v[j]) * LOG2E; }
    }
    bf16x8 qf[4];
#pragma unroll
    for (int ds = 0; ds < 4; ++ds) qf[ds] = *(const bf16x8*)(C.PROJ() + (size_t)(row0 + r32) * PW + 1024 + h * 64 + 16 * ds + 8 * hi);
    __syncthreads();
    const float Fq = F[1024 + r32];
    float m_run = -INFINITY, l_run = 0.f;
    f32x16 o[2]; o[0] = f32x16{}; o[1] = f32x16{};
    float* mysc = wsc + wid * 32;
    for (int kb = wid; kb < 33; kb += 8) {
        const int key0 = 32 * kb;
        const float* kbase = kb < 32 ? C.cache_k() + ((cbase * 1024 + key0) * 8 + h) * 64 : C.out + O_SFK + ((cbase * 32) * 8 + h) * 64;
        const float* vbase = kb < 32 ? C.cache_v() + ((cbase * 1024 + key0) * 8 + h) * 64 : C.out + O_SFV + ((cbase * 32) * 8 + h) * 64;
        f32x16 st = f32x16{};
#pragma unroll
        for (int ds = 0; ds < 4; ++ds) { const bf16x8 a = cvt8(kbase + (size_t)r32 * 512 + 16 * ds + 8 * hi); st = __builtin_amdgcn_mfma_f32_32x32x16_bf16(a, qf[ds], st, 0, 0, 0); }
        float mx = -INFINITY;
#pragma unroll
        for (int r = 0; r < 16; ++r) { const int key = key0 + crow(r, hi); float v = st[r] + Fq - F[key]; if (key > 1024 + r32) v = -INFINITY; st[r] = v; mx = fmaxf(mx, v); }
        mx = fmaxf(mx, __shfl_xor(mx, 32));
        const float m_new = fmaxf(m_run, mx), sc = exp2f(m_run - m_new);
        m_run = m_new; l_run *= sc;
        if (hi == 0) mysc[r32] = sc;
        float ps = 0.f;
#pragma unroll
        for (int r = 0; r < 16; ++r) { st[r] = exp2f(st[r] - m_new); ps += st[r]; }
        l_run += ps;
        asm volatile("s_waitcnt lgkmcnt(0)" ::: "memory");
#pragma unroll
        for (int r = 0; r < 16; ++r) { const float f = mysc[crow(r, hi)]; o[0][r] *= f; o[1][r] *= f; }
#pragma unroll
        for (int kk = 0; kk < 2; ++kk) { u32x4 pw; pw.x = pkbf(st[8 * kk], st[8 * kk + 1]); pw.y = pkbf(st[8 * kk + 2], st[8 * kk + 3]); pw.z = pkbf(st[8 * kk + 4], st[8 * kk + 5]); pw.w = pkbf(st[8 * kk + 6], st[8 * kk + 7]);
            const bf16x8 pa = __builtin_bit_cast(bf16x8, pw);
#pragma unroll
            for (int bj = 0; bj < 2; ++bj) { const float* vp = vbase + (size_t)(16 * kk + 4 * hi) * 512 + 32 * bj + r32;
                u32x4 vw; vw.x = pkbf(vp[0], vp[512]); vw.y = pkbf(vp[1024], vp[1536]); vw.z = pkbf(vp[4096], vp[4608]); vw.w = pkbf(vp[5120], vp[5632]);
                o[bj] = __builtin_amdgcn_mfma_f32_32x32x16_bf16(pa, __builtin_bit_cast(bf16x8, vw), o[bj], 0, 0, 0); } }
    }
    l_run += __shfl_xor(l_run, 32);
    if (hi == 0) { pm[wid * 32 + r32] = m_run; pl[wid * 32 + r32] = l_run; }
#pragma unroll
    for (int bj = 0; bj < 2; ++bj)
#pragma unroll
        for (int r = 0; r < 16; ++r) pO[(wid * 32 + crow(r, hi)) * 65 + 32 * bj + r32] = o[bj][r];
    __syncthreads();
    { const int t = tid >> 4, c4 = (tid & 15) * 4; float M = -INFINITY;
#pragma unroll
        for (int w = 0; w < 8; ++w) M = fmaxf(M, pm[w * 32 + t]);
        float den = 0.f, n0 = 0.f, n1 = 0.f, n2 = 0.f, n3 = 0.f;
#pragma unroll
        for (int w = 0; w < 8; ++w) { const float f = exp2f(pm[w * 32 + t] - M); den += f * pl[w * 32 + t]; const float* po = pO + (w * 32 + t) * 65 + c4;
            n0 += f * po[0]; n1 += f * po[1]; n2 += f * po[2]; n3 += f * po[3]; }
        const float inv = 1.f / den;
        u32x2 w2; w2.x = pkbf(n0 * inv, n1 * inv); w2.y = pkbf(n2 * inv, n3 * inv);
        *(u32x2*)(C.HA() + (size_t)(row0 + t) * DM + 256 + h * 64 + c4) = w2; }
    __syncthreads();
}
#define LAS __attribute__((address_space(3)))
#define XB_TMO      128
#define XB_XCNT(j)  (256  + 64 * (j))
#define XB_XSUB(j)  (1280 + 64 * (j))
#define XB_XGEN(j)  (2304 + 64 * (j))
#define XB_TOP      3328
#define XB_TOPGEN   3392
#define XCD_BAR_WORDS 3456
#define XB_SPIN_CAP (1u << 18)

__device__ __forceinline__ unsigned xb_ld(unsigned* p)              { return __hip_atomic_load(p, __ATOMIC_RELAXED, __HIP_MEMORY_SCOPE_AGENT); }
__device__ __forceinline__ unsigned xb_add(unsigned* p, unsigned v) { return __hip_atomic_fetch_add(p, v, __ATOMIC_RELAXED, __HIP_MEMORY_SCOPE_AGENT); }
__device__ __forceinline__ unsigned xb_xcc_id() { return (unsigned)__builtin_amdgcn_s_getreg((3 << 11) | 20) & 0xFu; }
#define XB_SPIN(cond, bar) do { unsigned _sp = 0; while (cond) { __builtin_amdgcn_s_sleep(1); \
    if ((++_sp & 255u) == 0u) { if (xb_ld(&(bar)[XB_TMO])) break; if (_sp > XB_SPIN_CAP) { atomicAdd(&(bar)[XB_TMO], 1u); break; } } } } while (0)

struct XcdBarrier {
    unsigned* bar; unsigned x;
    volatile LAS unsigned* st;
};

__device__ __forceinline__ XcdBarrier xcd_barrier_post(unsigned* bar, volatile LAS unsigned* st) {
    XcdBarrier b; b.bar = bar; b.x = xb_xcc_id(); b.st = st;
    if (threadIdx.x == 0) (void)xb_add(&bar[XB_XCNT(b.x)], 1u);
    return b;
}
__device__ __forceinline__ void xcd_barrier_complete(unsigned* bar, unsigned x, unsigned& nloc, unsigned& nx) {
    const unsigned G = gridDim.x * gridDim.y * gridDim.z;
    unsigned sum, cnt, mine, sp = 0u;
    for (;;) {
        sum = 0u; cnt = 0u; mine = 0u;
#pragma unroll
        for (unsigned j = 0; j < 16; ++j) { const unsigned c = xb_ld(&bar[XB_XCNT(j)]); sum += c; cnt += (c > 0u) ? 1u : 0u; mine = (j == x) ? c : mine; }
        if (sum == G) break;
        __builtin_amdgcn_s_sleep(1);
        if ((++sp & 255u) == 0u) { if (xb_ld(&bar[XB_TMO])) break; if (sp > XB_SPIN_CAP) { atomicAdd(&bar[XB_TMO], 1u); break; } }
    }
    nloc = mine > 0u ? mine : 1u; nx = cnt > 0u ? cnt : 1u;
}

__device__ __forceinline__ void xcd_barrier(const XcdBarrier& b) {
    asm volatile("s_waitcnt vmcnt(0)" ::: "memory");
    __syncthreads();
    if (threadIdx.x == 0) {
        unsigned* bar = b.bar;
        __builtin_amdgcn_s_waitcnt(0);
        unsigned nloc = b.st[0], nx = b.st[1];
        if (nloc == 0u) { xcd_barrier_complete(bar, b.x, nloc, nx); b.st[0] = nloc; b.st[1] = nx; }
        const unsigned old = xb_add(&bar[XB_XSUB(b.x)], 1u);
        const unsigned gen = old / nloc;
        if (old + 1u == (gen + 1u) * nloc) {
            __builtin_amdgcn_fence(__ATOMIC_RELEASE, "agent");
            asm volatile("s_waitcnt vmcnt(0)" ::: "memory");
            const unsigned og = xb_add(&bar[XB_TOP], 1u);
            const unsigned tg = og / nx;
            if (og + 1u == (tg + 1u) * nx) xb_add(&bar[XB_TOPGEN], 1u);
            else XB_SPIN(xb_ld(&bar[XB_TOPGEN]) == tg, bar);
            __builtin_amdgcn_fence(__ATOMIC_ACQUIRE, "agent");
            xb_add(&bar[XB_XGEN(b.x)], 1u);
            asm volatile("s_waitcnt vmcnt(0)" ::: "memory");
        } else {
            XB_SPIN(xb_ld(&bar[XB_XGEN(b.x)]) == gen, bar);
            __builtin_amdgcn_fence(__ATOMIC_ACQUIRE, "agent");
            asm volatile("s_waitcnt vmcnt(0)" ::: "memory");
        }
    }
    __syncthreads();
}

struct Args { const float* in[29]; float* out; unsigned char* ws; int ph_lo, ph_hi; };
constexpr int N_PHASES = 20;
#ifndef MK_ONLY
#define MK_ONLY -1
#endif
#define PH(k) (MK_ONLY < 0 || MK_ONLY == (k))
#ifndef MK_SUB
#define MK_SUB -1
#endif
#define SUB(j) ((MK_SUB < 0 || MK_SUB == (j)) && (rep == 0 || MK_REP_SUB < 0 || MK_REP_SUB == (j)))
#ifndef MK_REP_K
#define MK_REP_K -1000
#endif
#ifndef MK_REP_MASK
#define MK_REP_MASK 0
#endif
#ifndef MK_REP_N
#define MK_REP_N 1
#endif
#ifndef MK_REP_SUB
#define MK_REP_SUB -1
#endif

template <class Epi> __device__ __forceinline__ void run_gemm(int G, int bx, unsigned char* smem, const bf16_t* A, const bf16_t* Bt, int N, int K, const Epi& E) {
    pg8::Gemm g{A, Bt, MT, N, K}; pg8::StaticOrder S; S.init(MT, N, G, bx);
    pg8::gemm_phase<Epi, pg8::StaticOrder, true, true>((PG8_LAS unsigned char*)smem, g, S, E);
}

template <class Epi> __device__ __forceinline__ void run_gemm_panel(int G, int bx, unsigned char* smem, const bf16_t* A, const bf16_t* Bt, int N, int K, const Epi& E) {
    pg8::Gemm g{A, Bt, MT, N, K}; PanelOrder S; S.init(G, bx);
    pg8::gemm_phase<Epi, PanelOrder, true, true>((PG8_LAS unsigned char*)smem, g, S, E);
}

__global__ void __launch_bounds__(512, 2) mk_fwd(Args args) {
    extern __shared__ __attribute__((aligned(16))) unsigned char smem[];
    cg::grid_group grid = cg::this_grid();
    Ctx C; C.tab = (const PG8_LAS unsigned long long*)(smem + LDS_BYTES - 256);
    if (mk_tid() == 0) { PG8_LAS unsigned long long* tw = (PG8_LAS unsigned long long*)(smem + LDS_BYTES - 256);
#pragma unroll
        for (int i = 0; i < 29; ++i) tw[i] = (unsigned long long)args.in[i]; }
    if (mk_tid() < 2) ((volatile LAS unsigned*)(smem + LDS_BYTES - 16))[mk_tid()] = 0u;
    __syncthreads();
    XcdBarrier xbar = xcd_barrier_post((unsigned*)(args.ws + 4096), (volatile LAS unsigned*)(smem + LDS_BYTES - 16));

#ifdef MK_EXTRA_SYNCS
    for (int i = 0; i < MK_EXTRA_SYNCS; ++i) xcd_barrier(xbar);
#endif
    for (int ph = args.ph_lo; ph < args.ph_hi; ++ph) {
        { unsigned long long w_ = (unsigned long long)args.ws, o_ = (unsigned long long)args.out; asm volatile("" : "+s"(w_), "+s"(o_)); C.ws = (unsigned char*)(__attribute__((address_space(1))) unsigned char*)w_; C.out = (float*)(__attribute__((address_space(1))) float*)o_; }
        int G = (int)gridDim.x, bx = (int)blockIdx.x; asm volatile("" : "+s"(G), "+s"(bx));
        const int ptype = ph < 2 ? 100 + ph : (ph - 2) % 9; const int pbit = ptype >= 100 ? ptype - 91 : ptype; const int nrep = (ptype == MK_REP_K || ((MK_REP_MASK >> pbit) & 1)) ? MK_REP_N : 1;
        for (int rep = 0; rep < nrep; ++rep) {
        if (rep > 0) { XcdBarrier xb_ = xbar; unsigned long long bp_ = (unsigned long long)xb_.bar; asm volatile("" : "+s"(bp_)); xb_.bar = (unsigned*)(__attribute__((address_space(1))) unsigned*)bp_; xcd_barrier(xb_); }
        if (ph == 0) { if constexpr (PH(100)) p0a(C, smem); }
        else if (ph == 1) { if constexpr (PH(101)) p0b(C); }
        else {
            const int l = (ph - 2) / 9, k = (ph - 2) % 9;
            const float* mod = C.MOD() + (size_t)l * 32 * 6144;
            float* st1 = C.STATS() + (size_t)(l * 2) * MT * 2; float* st2 = C.STATS() + (size_t)(l * 2 + 1) * MT * 2; float* stw1 = rep > 0 ? C.STATS() + (size_t)4 * MT * 2 : st1; float* stw2 = rep > 0 ? C.STATS() + (size_t)4 * MT * 2 : st2;
            if (k == 0) { if constexpr (PH(0)) {
                EpiInProj E{C.PROJ(), C.GATES(), C.out, l, C.b_mi() + l * 4, C.b_mf() + l * 4, C.b_ff() + l * 8};
                run_gemm(G, bx, smem, C.HA(), C.WIN() + (size_t)l * NINP * 1024, NINP, 1024, E);
            } } else if (k == 1) { if constexpr (PH(1)) {
                if (SUB(0)) for (int q = bx; q < 1024; q += G) m1_quad(C, q, smem);
                if (SUB(1)) for (int u = bx; u < 512; u += G) gmlp_unit(C, l, u, smem);
                if (SUB(2)) for (int u = bx; u < 16; u += G) fcum_unit(C, u, smem);
                if (SUB(3)) for (int u = (bx + G - (16 % G)) % G; u < 64; u += G) mlstm_sample_unit(C, l, u, smem);
                if (SUB(4)) for (int u = (bx + G - (80 % G)) % G; u < 16; u += G) gmlp_sample_unit(C, l, u, smem);
            } } else if (k == 2) { if constexpr (PH(2)) {
                scan_phase(C, l);
            } } else if (k == 3) { if constexpr (PH(3)) {
                const attn_body::AttnTensors AT{(const attn_body::bf16*)(C.PROJ() + 1024), (const attn_body::bf16*)(C.PROJ() + 1536), (const attn_body::bf16*)(C.PROJ() + 2048), (attn_body::bf16*)(C.HA() + 256), C.FQ()};
                const int vcu0 = (G % 8 == 0) ? (bx % 8) * (G / 8) + bx / 8 : bx;
                if (SUB(0)) for (int v = vcu0; v < 256; v += G) { const attn_body::StaticOrder S(v); attn_body::attn_phase<attn_body::StaticOrder>((char*)smem, AT, S); }
                __syncthreads();
                if (SUB(1)) for (int q = bx; q < 1024; q += G) m3_quad(C, l, q, smem);
                if (SUB(2)) for (int u = G - 1 - bx; u < 128; u += G) fox_sample_unit(C, l, u, smem);
            } } else if (k == 4) { if constexpr (PH(4)) {
                if (l == 0) { EpiRes<false> E{C.x_prompt(), C.x_sample(), nullptr, nullptr, nullptr, nullptr, mod + 2048, C.R1(), stw1};
                    run_gemm_panel(G, bx, smem, C.HA(), C.WO() + (size_t)l * 1024 * 1024, 1024, 1024, E); }
                else { EpiRes<true> E{nullptr, nullptr, C.R2(), C.STATS() + (size_t)((l - 1) * 2 + 1) * MT * 2, C.ln2_g() + (l - 1) * 1024, C.ln2_b() + (l - 1) * 1024, mod + 2048, C.R1(), stw1};
                    run_gemm_panel(G, bx, smem, C.HA(), C.WO() + (size_t)l * 1024 * 1024, 1024, 1024, E); }
                if (rep == 0) { __syncthreads(); const int wv_ = __builtin_amdgcn_readfirstlane((int)(mk_tid() >> 6));
                    for (int p = bx; p < 256; p += G) ln_apply(C.R1(), st1, C.ln1_g() + l * 1024, C.ln1_b() + l * 1024, mod + 3072, mod + 4096, C.HA(), nullptr, nullptr, 256 * p, 256 * p + 256, wv_, 8); }
            } } else if (k == 5) { if constexpr (PH(5)) {
                { const int wv_ = __builtin_amdgcn_readfirstlane((int)(mk_tid() >> 6));
                  ln_apply(C.R1(), st1, C.ln1_g() + l * 1024, C.ln1_b() + l * 1024, mod + 3072, mod + 4096, C.HA(), nullptr, nullptr, rep == 0 ? NPT : 0, MT, bx * 8 + wv_, G * 8); }
            } } else if (k == 6) { if constexpr (PH(6)) {
                EpiSwiGLU E{C.PROJ()};
                run_gemm(G, bx, smem, C.HA(), C.WGU() + (size_t)l * 5632 * 1024, 5632, 1024, E);
            } } else if (k == 7) { if constexpr (PH(7)) {
                EpiRes<true> E{nullptr, nullptr, C.R1(), st1, C.ln1_g() + l * 1024, C.ln1_b() + l * 1024, mod + 5120, C.R2(), stw2};
                run_gemm(G, bx, smem, C.PROJ(), C.WD() + (size_t)l * 1024 * DFF, 1024, DFF, E);
            } } else { if constexpr (PH(8)) {
                if (l == 0) ln_apply(C.R2(), st2, C.ln2_g(), C.ln2_b(), mod + 32 * 6144, mod + 32 * 6144 + 1024, C.HA(), nullptr, nullptr, 0, MT, bx * 8 + __builtin_amdgcn_readfirstlane((int)(mk_tid() >> 6)), G * 8);
                else ln_apply(C.R2(), st2, C.ln2_g() + 1024, C.ln2_b() + 1024, nullptr, nullptr, nullptr, C.out + O_YP, C.out + O_YS, 0, MT, bx * 8 + __builtin_amdgcn_readfirstlane((int)(mk_tid() >> 6)), G * 8);
            } }
        }
        }
        if (ph + 1 < args.ph_hi) { if (args.ph_hi < 0) grid.sync(); else { XcdBarrier xb_ = xbar; unsigned long long bp_ = (unsigned long long)xb_.bar; asm volatile("" : "+s"(bp_)); xb_.bar = (unsigned*)(__attribute__((address_space(1))) unsigned*)bp_; xcd_barrier(xb_); } }
    }
}
}

#ifndef MK_NLAUNCH
#define MK_NLAUNCH 1
#endif
extern "C" void kernel_launch(void* const* d_in, const int* in_sizes, int n_in, void* d_out, int out_size, void* d_ws, size_t ws_size, hipStream_t stream) {
    static int grid = 0;
    if (grid == 0) {
        if (n_in != 29 || (size_t)out_size != mk::O_END || ws_size < mk::WS_END) { fprintf(stderr, "kernel_launch: unexpected shapes: n_in %d out %d ws %zu (need %zu)\n", n_in, out_size, ws_size, (size_t)mk::WS_END); grid = -1; return; }
        int dev = 0, cus = 0, per_cu = 0;
        (void)hipGetDevice(&dev); (void)hipDeviceGetAttribute(&cus, hipDeviceAttributeMultiprocessorCount, dev);
        if (hipFuncSetAttribute((const void*)mk::mk_fwd, hipFuncAttributeMaxDynamicSharedMemorySize, mk::LDS_BYTES) != hipSuccess) { fprintf(stderr, "kernel_launch: hipFuncSetAttribute failed\n"); grid = -1; return; }
        if (hipOccupancyMaxActiveBlocksPerMultiprocessor(&per_cu, (const void*)mk::mk_fwd, 512, mk::LDS_BYTES) != hipSuccess || per_cu < 1) { fprintf(stderr, "kernel_launch: occupancy query failed (%d)\n", per_cu); per_cu = 1; (void)hipGetLastError(); }
        grid = cus * (per_cu > 1 ? 1 : per_cu);
        if (grid <= 0) grid = 256;
    }
    if (grid < 0) return;
    if (hipMemsetAsync(d_ws, 0, 65536, stream) != hipSuccess) { fprintf(stderr, "kernel_launch: memset failed\n"); return; }
    mk::Args a{};
    for (int i = 0; i < 29; ++i) a.in[i] = (const float*)d_in[i];
    a.out = (float*)d_out; a.ws = (unsigned char*)d_ws;
    for (int li = 0; li < MK_NLAUNCH; ++li) {
        a.ph_lo = (MK_NLAUNCH == 1) ? 0 : li * mk::N_PHASES / MK_NLAUNCH; a.ph_hi = (MK_NLAUNCH == 1) ? mk::N_PHASES : (li + 1) * mk::N_PHASES / MK_NLAUNCH;
        void* kargs[] = {&a};
        const hipError_t e = hipLaunchCooperativeKernel((const void*)mk::mk_fwd, dim3(grid), dim3(512), kargs, mk::LDS_BYTES, stream);
        if (e != hipSuccess) { fprintf(stderr, "kernel_launch: cooperative launch failed: %s (grid %d)\n", hipGetErrorString(e), grid); break; }
    }
}
```

```cpp
#include <hip/hip_runtime.h>
#include <hip/hip_bf16.h>
#include <hip/hip_cooperative_groups.h>
#include <cstdio>
#include <cstdint>
#include <cmath>
namespace cg = cooperative_groups;
__device__ __forceinline__ int mk_tid() { int t = threadIdx.x; asm volatile("" : "+v"(t)); return t; }
namespace pg8 {
#define PG8_LAS __attribute__((address_space(3)))
typedef unsigned short bf16_t;
typedef short bf16x8 __attribute__((ext_vector_type(8)));
typedef float f32x4 __attribute__((ext_vector_type(4)));
typedef unsigned u32x4 __attribute__((ext_vector_type(4)));
constexpr int BM = 256, BK = 64, HALF = 128, HTB = HALF * BK * 2  , STAGE_BYTES = 8 * HTB, NXCD = 8, WGM = 8;

__host__ __device__ __forceinline__ int lds_byte(int r, int c) { const int st = (r >> 4) * 2 + (c >> 5), rr = r & 15, cc = c & 31, ob = rr * 64 + cc * 2; return st * 1024 + (ob ^ (((ob >> 9) & 1) << 5)); }
__host__ __device__ __forceinline__ void stage_rc(int b, int& R, int& C) { const int st = b / 1024, sb = b % 1024, swz = sb ^ (((sb >> 9) & 1) << 5); R = (st >> 1) * 16 + swz / 64; C = (st & 1) * 32 + (swz % 64) / 2; }
__host__ __device__ __forceinline__ int perm32(int rho) { const int n = rho >> 4, i = rho & 15; return 8 * (i >> 2) + 4 * n + (i & 3); }

struct Unit { int pm, pn; };
struct Gemm { const bf16_t* A; const bf16_t* Bt; int M, N, K; };

struct StaticOrder {
    int nM, nN, nwg, G, c;
    __host__ __device__ void init(int M, int N, int G_, int c_) { nM = M / BM; nN = N / BM; nwg = nM * nN; G = G_; c = c_; }
    __host__ __device__ bool next(int i, Unit& u) const {
        const long L = (long)i * G + c; if (L >= nwg) return false;
        int wgid = (int)L; { const int q = nwg / NXCD, r = nwg % NXCD, xcd = wgid % NXCD, off = wgid / NXCD; wgid = (xcd < r ? xcd * (q + 1) : r * (q + 1) + (xcd - r) * q) + off; }
        const int nig = WGM * nN, gid = wgid / nig, fm = gid * WGM, gsz = (nM - fm) < WGM ? (nM - fm) : WGM;
        u.pm = fm + ((wgid % nig) % gsz); u.pn = (wgid % nig) / gsz; return true;
    }
    __device__ __forceinline__ void a_ready(const Unit&) const {}
    __device__ __forceinline__ void done(const Unit&) const {}
};

__device__ __forceinline__ unsigned cvt_pk_bf16(float lo, float hi) { unsigned r; asm volatile("v_cvt_pk_bf16_f32 %0, %1, %2" : "=v"(r) : "v"(lo), "v"(hi)); return r; }
typedef float f32x2 __attribute__((ext_vector_type(2)));
__device__ __forceinline__ f32x2 gelu_pk(f32x2 v) {
    const f32x2 av = __builtin_elementwise_abs(v), d = av * 0.2316418882f + 1.0f;
    f32x2 t; t.x = __builtin_amdgcn_rcpf(d.x); t.y = __builtin_amdgcn_rcpf(d.y);
    f32x2 q = t * 0.5307027145f + (-0.7265760135f); q = q * t + 0.7107068705f; q = q * t + (-0.142248368f); q = q * t + 0.127414796f; q = q * t;
    const f32x2 s = (v * v) * (-0.72134752044f);
    f32x2 e; e.x = __builtin_amdgcn_exp2f(s.x); e.y = __builtin_amdgcn_exp2f(s.y);
    const f32x2 m = v * (q * e), r = v - m;
    f32x2 o; o.x = v.x < 0.f ? m.x : r.x; o.y = v.y < 0.f ? m.y : r.y; return o;
}

template <int ACT  > struct EpiBf16 {
    static constexpr bool PERM = true, AFTER_DRAIN = false; static_assert(ACT == 0 || ACT == 1, "EpiBf16: ACT is 0 (none) or 1 (gelu_pk)");
    bf16_t* O; int ldc; const float* bias; int split_cols; size_t split_stride; float scale0;
    __device__ __forceinline__ void operator()(const f32x4 (&acc)[2][2][4][2], const Unit& u, int wr, int wc, int fr, int fq) const {
        const int row0 = u.pm * BM + wr * 64 + fr; int colt = u.pn * BM; bf16_t* base = O;
        float sc = 1.f; if (split_cols) { const int t = colt / split_cols; base += (size_t)t * split_stride; colt -= t * split_cols; if (t == 0) sc = scale0; }
        const int col0 = colt + wc * 32 + 8 * fq, bcol0 = u.pn * BM + wc * 32 + 8 * fq;
        f32x4 bv[2][2];
#pragma unroll
        for (int bj = 0; bj < 2; ++bj)
#pragma unroll
            for (int n = 0; n < 2; ++n) bv[bj][n] = bias ? *(const f32x4*)(bias + bcol0 + bj * HALF + 4 * n) : (f32x4){0.f, 0.f, 0.f, 0.f};
#pragma unroll
        for (int ai = 0; ai < 2; ++ai)
#pragma unroll
            for (int m = 0; m < 4; ++m) { bf16_t* rowp = base + (size_t)(row0 + ai * HALF + m * 16) * ldc + col0;
#pragma unroll
                for (int bj = 0; bj < 2; ++bj) { f32x4 v0 = acc[ai][bj][m][0] + bv[bj][0], v1 = acc[ai][bj][m][1] + bv[bj][1];
                    if (ACT == 1) { f32x2 a = gelu_pk((f32x2){v0[0], v0[1]}), b = gelu_pk((f32x2){v0[2], v0[3]}), c = gelu_pk((f32x2){v1[0], v1[1]}), d = gelu_pk((f32x2){v1[2], v1[3]});
                        v0 = (f32x4){a.x, a.y, b.x, b.y}; v1 = (f32x4){c.x, c.y, d.x, d.y}; }
                    v0 = v0 * sc; v1 = v1 * sc; u32x4 w; w.x = cvt_pk_bf16(v0[0], v0[1]); w.y = cvt_pk_bf16(v0[2], v0[3]); w.z = cvt_pk_bf16(v1[0], v1[1]); w.w = cvt_pk_bf16(v1[2], v1[3]);
                    *(u32x4*)(rowp + bj * HALF) = w; } }
    }
};

struct PanelStats {
    unsigned* xbuf;
    unsigned* cnt;
    unsigned* tmo;
    int ntn; float eps;
    unsigned code;
    __device__ __forceinline__ bool run(const f32x4 (&v)[2][2][4][2], const Unit& u, int wr, int wc, int fr, int fq, PG8_LAS unsigned char* lds, int wid, int lane) const {
        typedef float f32x2v __attribute__((ext_vector_type(2)));
        PG8_LAS f32x2v* P = (PG8_LAS f32x2v*)lds;
        PG8_LAS f32x2v* S = (PG8_LAS f32x2v*)(lds + 8192);
        PG8_LAS unsigned* flag = (PG8_LAS unsigned*)(lds + 8192 + 2048);
#pragma unroll
        for (int ai = 0; ai < 2; ++ai)
#pragma unroll
            for (int m = 0; m < 4; ++m) {
                float s = 0.f;
#pragma unroll
                for (int bj = 0; bj < 2; ++bj)
#pragma unroll
                    for (int n = 0; n < 2; ++n) { const f32x4 x = v[ai][bj][m][n]; s += (x[0] + x[1]) + (x[2] + x[3]); }
                s += __shfl_xor(s, 16); s += __shfl_xor(s, 32);
                const float mw = s * (1.0f / 64.0f); float q = 0.f;
#pragma unroll
                for (int bj = 0; bj < 2; ++bj)
#pragma unroll
                    for (int n = 0; n < 2; ++n) { const f32x4 d = v[ai][bj][m][n] - mw; q += (d[0] * d[0] + d[1] * d[1]) + (d[2] * d[2] + d[3] * d[3]); }
                q += __shfl_xor(q, 16); q += __shfl_xor(q, 32);
                if (fq == 0) P[(ai * HALF + wr * 64 + m * 16 + fr) * 4 + wc] = (f32x2v){mw, q};
            }
        asm volatile("s_waitcnt lgkmcnt(0)" ::: "memory"); __builtin_amdgcn_s_barrier(); asm volatile("" ::: "memory");
#if defined(BROKEN_EXCHANGE_NO_WAIT)
#warning BROKEN CONTROL BUILD: the row-statistics exchange does not wait; results are wrong by design
        if (blockIdx.x >= 64) { const long long t0_ = clock64(); while (clock64() - t0_ < 60000) __builtin_amdgcn_s_sleep(8); }
#endif
        const int row = wid * 32 + (lane & 31);
        if (lane < 32) {
            const f32x2v a = P[row * 4 + 0], b = P[row * 4 + 1], c = P[row * 4 + 2], d = P[row * 4 + 3];
            const float mt = (a.x + b.x + c.x + d.x) * 0.25f;
            const float da = a.x - mt, db = b.x - mt, dc = c.x - mt, dd = d.x - mt;
            const float m2 = (a.y + b.y) + (c.y + d.y) + 64.0f * ((da * da + db * db) + (dc * dc + dd * dd));
            unsigned long long* slot = (unsigned long long*)xbuf + ((size_t)(u.pm * BM + row) * 4 + u.pn);
            __hip_atomic_store(slot, ((unsigned long long)__float_as_uint(m2) << 32) | __float_as_uint(mt), __ATOMIC_RELAXED, __HIP_MEMORY_SCOPE_AGENT);
        }
        asm volatile("s_waitcnt vmcnt(0)" ::: "memory");
        if (lane == 0) __hip_atomic_fetch_add(cnt + 64 * u.pm, 1u, __ATOMIC_RELAXED, __HIP_MEMORY_SCOPE_AGENT);
        if (wid == 0) {
            bool dead = false; const unsigned long long t0 = __builtin_amdgcn_s_memrealtime(); const unsigned want = 8u * (unsigned)ntn;
            for (;;) {
#if defined(BROKEN_EXCHANGE_NO_WAIT)
                break;
#endif
                if ((unsigned)__builtin_amdgcn_readfirstlane(__hip_atomic_load(cnt + 64 * u.pm, __ATOMIC_RELAXED, __HIP_MEMORY_SCOPE_AGENT)) >= want) break;
                if (__builtin_amdgcn_s_memrealtime() - t0 > 2000000ull) {
                    if (lane == 0) { unsigned expect = 0u; __hip_atomic_compare_exchange_strong(tmo + 1, &expect, code | (unsigned)(u.pm & 0xff), __ATOMIC_RELAXED, __ATOMIC_RELAXED, __HIP_MEMORY_SCOPE_AGENT);
                                     __hip_atomic_store(tmo, 1u, __ATOMIC_RELAXED, __HIP_MEMORY_SCOPE_AGENT); }
                    dead = true; break; }
                __builtin_amdgcn_s_sleep(2);
            }
            __builtin_amdgcn_fence(__ATOMIC_ACQUIRE, "agent");
            if (lane == 0) flag[0] = dead ? 1u : 0u;
        }
        asm volatile("s_waitcnt vmcnt(0) lgkmcnt(0)" ::: "memory"); __builtin_amdgcn_s_barrier(); asm volatile("" ::: "memory");
        const bool bad = flag[0] != 0u;
        if (lane < 32) {
            const unsigned long long* slot = (const unsigned long long*)xbuf + (size_t)(u.pm * BM + row) * 4; float mt[4], m2[4]; float ms = 0.f;
#pragma unroll
            for (int t = 0; t < 4; ++t) { if (t < ntn) { const unsigned long long w = __hip_atomic_load(slot + t, __ATOMIC_RELAXED, __HIP_MEMORY_SCOPE_AGENT); mt[t] = __uint_as_float((unsigned)w); m2[t] = __uint_as_float((unsigned)(w >> 32)); } else { mt[t] = 0.f; m2[t] = 0.f; } ms += mt[t]; }
            const float mean = ms / (float)ntn; float q = 0.f;
#pragma unroll
            for (int t = 0; t < 4; ++t) if (t < ntn) { const float dm = mt[t] - mean; q += m2[t] + 256.0f * dm * dm; }
            S[row] = (f32x2v){mean, 1.0f / sqrtf(q / (256.0f * (float)ntn) + eps)};
        }
        asm volatile("s_waitcnt lgkmcnt(0)" ::: "memory"); __builtin_amdgcn_s_barrier(); asm volatile("" ::: "memory");
        return bad;
    }
};
struct EpiLnRes {
    static constexpr bool PERM = false, AFTER_DRAIN = true;
    const float* base; float* out; int ldc; const float* bias; PanelStats st; unsigned poison;
    __device__ __forceinline__ void fused(f32x4 (&acc)[2][2][4][2], const Unit& u, int wr, int wc, int fr, int fq, PG8_LAS unsigned char* lds, int wid, int lane) const {
        typedef float f32x2v __attribute__((ext_vector_type(2)));
        const PG8_LAS f32x2v* S = (const PG8_LAS f32x2v*)(lds + 8192);
        const int col0 = u.pn * BM + wc * 32 + 4 * fq;
#pragma unroll
        for (int bj = 0; bj < 2; ++bj)
#pragma unroll
            for (int n = 0; n < 2; ++n) { const f32x4 bv = bias ? *(const f32x4*)(bias + col0 + bj * HALF + n * 16) : (f32x4){0.f, 0.f, 0.f, 0.f};
#pragma unroll
                for (int ai = 0; ai < 2; ++ai)
#pragma unroll
                    for (int m = 0; m < 4; ++m) acc[ai][bj][m][n] += bv; }
        f32x4 pre[4][2][2];
#pragma unroll
        for (int m = 0; m < 4; ++m) { const size_t off = (size_t)(u.pm * BM + wr * 64 + m * 16 + fr) * ldc + col0;
#pragma unroll
            for (int bj = 0; bj < 2; ++bj)
#pragma unroll
                for (int n = 0; n < 2; ++n) pre[m][bj][n] = *(const f32x4*)(base + off + bj * HALF + n * 16); }
        const bool bad = st.run(acc, u, wr, wc, fr, fq, lds, wid, lane) || poison != 0u;
        const float qnan = __builtin_nanf("");
#pragma unroll
        for (int ai = 0; ai < 2; ++ai)
#pragma unroll
            for (int m = 0; m < 4; ++m) { const int r = ai * HALF + wr * 64 + m * 16 + fr; const f32x2v sr = S[r]; const size_t off = (size_t)(u.pm * BM + r) * ldc + col0;
#pragma unroll
                for (int bj = 0; bj < 2; ++bj)
#pragma unroll
                    for (int n = 0; n < 2; ++n) { const f32x4 bs = ai == 0 ? pre[m][bj][n] : *(const f32x4*)(base + off + bj * HALF + n * 16); f32x4 o = bs + (acc[ai][bj][m][n] - sr.x) * sr.y;
                        if (bad) o = (f32x4){qnan, qnan, qnan, qnan}; *(f32x4*)(out + off + bj * HALF + n * 16) = o; }
                if (m & 1) asm volatile("" ::: "memory"); }
    }
};
struct EpiLnResLn {
    static constexpr bool PERM = false, AFTER_DRAIN = true;
    const float* base; float* out; bf16_t* xn; int ldc; const float* bias; PanelStats st1, st2; unsigned poison;
    __device__ __forceinline__ void fused(f32x4 (&acc)[2][2][4][2], const Unit& u, int wr, int wc, int fr, int fq, PG8_LAS unsigned char* lds, int wid, int lane) const {
        typedef float f32x2v __attribute__((ext_vector_type(2))); typedef unsigned u32x2v __attribute__((ext_vector_type(2)));
        const PG8_LAS f32x2v* S = (const PG8_LAS f32x2v*)(lds + 8192);
        const int col0 = u.pn * BM + wc * 32 + 4 * fq;
#pragma unroll
        for (int bj = 0; bj < 2; ++bj)
#pragma unroll
            for (int n = 0; n < 2; ++n) { const f32x4 bv = bias ? *(const f32x4*)(bias + col0 + bj * HALF + n * 16) : (f32x4){0.f, 0.f, 0.f, 0.f};
#pragma unroll
                for (int ai = 0; ai < 2; ++ai)
#pragma unroll
                    for (int m = 0; m < 4; ++m) acc[ai][bj][m][n] += bv; }
        bool bad = st1.run(acc, u, wr, wc, fr, fq, lds, wid, lane) || poison != 0u;
        const float qnan = __builtin_nanf("");
#pragma unroll
        for (int ai = 0; ai < 2; ++ai)
#pragma unroll
            for (int m = 0; m < 4; ++m) { const int r = ai * HALF + wr * 64 + m * 16 + fr; const f32x2v sr = S[r]; const size_t off = (size_t)(u.pm * BM + r) * ldc + col0;
#pragma unroll
                for (int bj = 0; bj < 2; ++bj)
#pragma unroll
                    for (int n = 0; n < 2; ++n) { const f32x4 bs = *(const f32x4*)(base + off + bj * HALF + n * 16); acc[ai][bj][m][n] = bs + (acc[ai][bj][m][n] - sr.x) * sr.y; }
                asm volatile("" : "+v"(acc[ai][0][m][0]), "+v"(acc[ai][0][m][1]), "+v"(acc[ai][1][m][0]), "+v"(acc[ai][1][m][1]));
                if (m & 1) asm volatile("" ::: "memory"); }
        const bool bad1 = bad;
        bad = st2.run(acc, u, wr, wc, fr, fq, lds, wid, lane) || bad;
#pragma unroll
        for (int ai = 0; ai < 2; ++ai)
#pragma unroll
            for (int m = 0; m < 4; ++m) { const int r = ai * HALF + wr * 64 + m * 16 + fr; const f32x2v sr = S[r]; const size_t off = (size_t)(u.pm * BM + r) * ldc + col0;
#pragma unroll
                for (int bj = 0; bj < 2; ++bj)
#pragma unroll
                    for (int n = 0; n < 2; ++n) { const f32x4 x1 = acc[ai][bj][m][n]; *(f32x4*)(out + off + bj * HALF + n * 16) = bad1 ? (f32x4){qnan, qnan, qnan, qnan} : x1;
                        const f32x4 o = (x1 - sr.x) * sr.y; u32x2v w; w.x = cvt_pk_bf16(o[0], o[1]); w.y = cvt_pk_bf16(o[2], o[3]);
                        if (bad) { w.x = 0x7fc07fc0u; w.y = 0x7fc07fc0u; } *(u32x2v*)(xn + off + bj * HALF + n * 16) = w; }
                asm volatile("" ::: "memory"); }
    }
};

template <class Epi, class Sched, bool ALIGN_EPI = false, bool SP2 = false>
__device__ __forceinline__ void gemm_phase(PG8_LAS unsigned char* lds, const Gemm g, const Sched& S, const Epi& E) {
    const int tid = mk_tid(), wid = __builtin_amdgcn_readfirstlane(tid >> 6), lane = tid & 63, wr = wid >> 2, wc = wid & 3, fr = lane & 15, fq = lane >> 4;
    const int K = g.K, nt = K / BK;
    unsigned voffA[2], voffB[2];
#pragma unroll
    for (int i = 0; i < 2; ++i) { int R, C; stage_rc(tid * 16 + i * 8192, R, C); const int Rb = Epi::PERM ? ((R & ~31) + perm32(R & 31)) : R;
        voffA[i] = (unsigned)(R * K + C) * 2u; voffB[i] = (unsigned)(Rb * K + C) * 2u; }
    const size_t kstep = (size_t)(BK * 2);
    const size_t hstep = (size_t)HALF * K * 2;
    const size_t tstep = 2 * hstep;
    const unsigned ldsw = (unsigned)wid * 1024u;
    const int aoff = lds_byte(wr * 64 + fr, fq * 8), boff = lds_byte(wc * 32 + fr, fq * 8);
#define PG8_SA(b, h) (((b) * 2 + (h)) * HTB)
#define PG8_SB(b, h) ((4 + (b) * 2 + (h)) * HTB)
#define PG8_STAGE(bufoff, gbase, voff) do { _Pragma("unroll") for (int _i = 0; _i < 2; ++_i) \
        __builtin_amdgcn_global_load_lds((const unsigned*)((const char*)(gbase) + (voff)[_i]), (PG8_LAS unsigned*)(lds + (bufoff) + ldsw + _i * 8192), 16, 0, 0); } while (0)
#define PG8_LDA(dst, b, h) do { _Pragma("unroll") for (int m = 0; m < 4; ++m) _Pragma("unroll") for (int k = 0; k < 2; ++k) dst[m][k] = *(const PG8_LAS bf16x8*)(lds + PG8_SA(b, h) + aoff + m * 2048 + k * 1024); } while (0)
#define PG8_LDB(dst, b, h) do { _Pragma("unroll") for (int n = 0; n < 2; ++n) _Pragma("unroll") for (int k = 0; k < 2; ++k) dst[n][k] = *(const PG8_LAS bf16x8*)(lds + PG8_SB(b, h) + boff + n * 2048 + k * 1024); } while (0)
#define PG8_MMA(ai, bj, At, Bt) do { __builtin_amdgcn_s_setprio(1); _Pragma("unroll") for (int m = 0; m < 4; ++m) _Pragma("unroll") for (int n = 0; n < 2; ++n) _Pragma("unroll") for (int k = 0; k < 2; ++k) \
        acc[ai][bj][m][n] = __builtin_amdgcn_mfma_f32_16x16x32_bf16(Bt[n][k], At[m][k], acc[ai][bj][m][n], 0, 0, 0); __builtin_amdgcn_s_setprio(0); } while (0)
#define PG8_WAIT_V(n) asm volatile("s_waitcnt vmcnt(" #n ")" ::: "memory")
#define PG8_WAIT_L(n) asm volatile("s_waitcnt lgkmcnt(" #n ")" ::: "memory")
#define PG8_BAR __builtin_amdgcn_s_barrier()
#define PG8_SCHED __builtin_amdgcn_sched_barrier(0)
    Unit cur, nxt; int ui = 0;
    if (!S.next(0, cur)) return;
    f32x4 acc[2][2][4][2];
#pragma unroll
    for (int a = 0; a < 2; ++a)
#pragma unroll
        for (int b = 0; b < 2; ++b)
#pragma unroll
            for (int m = 0; m < 4; ++m)
#pragma unroll
                for (int n = 0; n < 2; ++n) acc[a][b][m][n] = (f32x4){0.f, 0.f, 0.f, 0.f};
    bf16x8 At[4][2], B0[2][2], B1[2][2];
    const char* cA = (const char*)g.A + (size_t)cur.pm * tstep; const char* cB = (const char*)g.Bt + (size_t)cur.pn * tstep;
    S.a_ready(cur);
    if constexpr (SP2) {
        PG8_STAGE(PG8_SB(0, 0), cB, voffB); PG8_STAGE(PG8_SB(0, 1), cB + hstep, voffB); PG8_STAGE(PG8_SA(0, 0), cA, voffA); PG8_STAGE(PG8_SA(0, 1), cA + hstep, voffA);
        if (wr == 1) PG8_BAR;
        PG8_WAIT_V(2); PG8_BAR;
        PG8_STAGE(PG8_SB(1, 0), cB + kstep, voffB); PG8_STAGE(PG8_SA(1, 0), cA + kstep, voffA); PG8_STAGE(PG8_SB(1, 1), cB + hstep + kstep, voffB);
        PG8_WAIT_V(6); PG8_BAR;
    } else {
        PG8_STAGE(PG8_SB(0, 0), cB, voffB); PG8_STAGE(PG8_SA(0, 0), cA, voffA); PG8_STAGE(PG8_SB(0, 1), cB + hstep, voffB); PG8_STAGE(PG8_SA(0, 1), cA + hstep, voffA);
        if (wr == 1) PG8_BAR;
        PG8_WAIT_V(4); PG8_BAR;
        PG8_STAGE(PG8_SB(1, 0), cB + kstep, voffB); PG8_STAGE(PG8_SA(1, 0), cA + kstep, voffA); PG8_STAGE(PG8_SB(1, 1), cB + hstep + kstep, voffB);
        PG8_WAIT_V(6); PG8_BAR;
    }
    for (;;) {
        const bool has_next = S.next(ui + 1, nxt);
        const char* nA = has_next ? (const char*)g.A + (size_t)nxt.pm * tstep : cA; const char* nB = has_next ? (const char*)g.Bt + (size_t)nxt.pn * tstep : cB;
        for (int t = 0; t < nt; t += 2) {
            const bool last = (t == nt - 2);
            const char* a1 = cA + (size_t)(t + 1) * kstep;
            const char* a2 = last ? nA : cA + (size_t)(t + 2) * kstep; const char* b2 = last ? nB : cB + (size_t)(t + 2) * kstep;
            const char* a3 = a2 + kstep; const char* b3 = b2 + kstep;
            if (last && has_next) S.a_ready(nxt);
            if constexpr (SP2) {
            PG8_LDB(B0, 0, 0); PG8_LDB(B1, 0, 1); PG8_SCHED; PG8_LDA(At, 0, 0); PG8_STAGE(PG8_SA(1, 1), a1 + hstep, voffA);
            PG8_WAIT_V(8); PG8_WAIT_L(0); PG8_BAR; PG8_MMA(0, 0, At, B0); PG8_MMA(0, 1, At, B1); PG8_BAR; PG8_SCHED;
            PG8_LDA(At, 0, 1); PG8_STAGE(PG8_SB(0, 0), b2, voffB); PG8_STAGE(PG8_SB(0, 1), b2 + hstep, voffB); PG8_STAGE(PG8_SA(0, 0), a2, voffA);
            PG8_WAIT_V(8); PG8_WAIT_L(0); PG8_BAR; PG8_MMA(1, 0, At, B0); PG8_MMA(1, 1, At, B1); PG8_BAR; PG8_SCHED;
            PG8_LDB(B0, 1, 0); PG8_LDB(B1, 1, 1); PG8_SCHED; PG8_LDA(At, 1, 0); PG8_STAGE(PG8_SA(0, 1), a2 + hstep, voffA);
            PG8_WAIT_V(8); PG8_WAIT_L(0); PG8_BAR; PG8_MMA(0, 0, At, B0); PG8_MMA(0, 1, At, B1); PG8_BAR; PG8_SCHED;
            PG8_LDA(At, 1, 1); PG8_STAGE(PG8_SB(1, 0), b3, voffB); PG8_STAGE(PG8_SB(1, 1), b3 + hstep, voffB); PG8_STAGE(PG8_SA(1, 0), a3, voffA);
            PG8_WAIT_V(8); PG8_WAIT_L(0); PG8_BAR; PG8_MMA(1, 0, At, B0); PG8_MMA(1, 1, At, B1); PG8_BAR; PG8_SCHED;
            } else {
            PG8_LDB(B0, 0, 0); PG8_SCHED; PG8_LDA(At, 0, 0); PG8_STAGE(PG8_SA(1, 1), a1 + hstep, voffA);
            PG8_WAIT_L(8); PG8_BAR; PG8_WAIT_L(0); PG8_MMA(0, 0, At, B0); PG8_BAR; PG8_SCHED;
            PG8_LDB(B1, 0, 1); PG8_STAGE(PG8_SB(0, 0), b2, voffB);
            PG8_BAR; PG8_WAIT_L(0); PG8_MMA(0, 1, At, B1); PG8_BAR;
            PG8_LDA(At, 0, 1); PG8_STAGE(PG8_SA(0, 0), a2, voffA);
            PG8_BAR; PG8_WAIT_L(0); PG8_MMA(1, 0, At, B0); PG8_BAR; PG8_SCHED;
            PG8_STAGE(PG8_SB(0, 1), b2 + hstep, voffB);
            PG8_WAIT_V(6); PG8_BAR; PG8_MMA(1, 1, At, B1); PG8_BAR;
            PG8_LDB(B0, 1, 0); PG8_SCHED; PG8_LDA(At, 1, 0); PG8_STAGE(PG8_SA(0, 1), a2 + hstep, voffA);
            PG8_WAIT_L(8); PG8_BAR; PG8_WAIT_L(0); PG8_MMA(0, 0, At, B0); PG8_BAR; PG8_SCHED;
            PG8_LDB(B1, 1, 1); PG8_STAGE(PG8_SB(1, 0), b3, voffB);
            PG8_BAR; PG8_WAIT_L(0); PG8_MMA(0, 1, At, B1); PG8_BAR;
            PG8_LDA(At, 1, 1); PG8_STAGE(PG8_SA(1, 0), a3, voffA);
            PG8_BAR; PG8_WAIT_L(0); PG8_MMA(1, 0, At, B0); PG8_BAR; PG8_SCHED;
            PG8_STAGE(PG8_SB(1, 1), b3 + hstep, voffB);
            PG8_WAIT_V(6); PG8_BAR; PG8_MMA(1, 1, At, B1); PG8_BAR;
            }
        }
        if constexpr (ALIGN_EPI) { if (wr == 0) PG8_BAR; }
        if constexpr (!Epi::AFTER_DRAIN) { E(acc, cur, wr, wc, fr, fq); S.done(cur); }
        if (!has_next) break;
#pragma unroll
        for (int a = 0; a < 2; ++a)
#pragma unroll
            for (int b = 0; b < 2; ++b)
#pragma unroll
                for (int m = 0; m < 4; ++m)
#pragma unroll
                    for (int n = 0; n < 2; ++n) acc[a][b][m][n] = (f32x4){0.f, 0.f, 0.f, 0.f};
        cur = nxt; cA = nA; cB = nB; ++ui;
        if constexpr (ALIGN_EPI) { if (wr == 1) PG8_BAR; }
    }
    PG8_WAIT_V(0);
    if constexpr (!ALIGN_EPI) { if (wr == 0) PG8_BAR; }
    PG8_BAR;
    if constexpr (Epi::AFTER_DRAIN) { E.fused(acc, cur, wr, wc, fr, fq, lds, wid, lane); S.done(cur); }
#undef PG8_SA
#undef PG8_SB
#undef PG8_STAGE
#undef PG8_LDA
#undef PG8_LDB
#undef PG8_MMA
#undef PG8_WAIT_V
#undef PG8_WAIT_L
#undef PG8_BAR
#undef PG8_SCHED
}
}

#ifndef PG8_SP2
#define PG8_SP2 true
#endif
namespace attn_body {
using bf16=__hip_bfloat16;
using bf16x8=__attribute__((ext_vector_type(8)))short;
using s16x4=__attribute__((ext_vector_type(4)))short;
using f32x16=__attribute__((ext_vector_type(16)))float;
using u32x4=__attribute__((ext_vector_type(4)))unsigned;
constexpr int BATCH=16,NHEAD=8,SEQ=4096,D=64,DM=3072,OPITCH=1024;
constexpr int NW=8,QBLK=32,QB=QBLK*NW,KVBLK=64,NQB=SEQ/QB;
constexpr int ATTN_PITCH=DM, ATTN_UNIT_ROWS=QB;
__device__ __forceinline__ int crow(int r,int hi){return (r&3)+8*(r>>2)+4*hi;}
#define SBAR() __builtin_amdgcn_sched_barrier(0)
__device__ __forceinline__ void cmask(f32x16&p0,f32x16&p1,int jb,int qrel,int hi){
  const float NEG=-INFINITY; int kb=64*jb+4*hi;
  #pragma unroll
  for(int r=0;r<16;++r){int kv=kb+(r&3)+8*(r>>2); if(kv>qrel)p0[r]=NEG; if(kv+32>qrel)p1[r]=NEG;}
}

constexpr int NSLOT=3, SLOTB=8192;
constexpr int LDS_K=0, LDS_V=NSLOT*SLOTB, LDS_WS=2*NSLOT*SLOTB, LDS_OST=LDS_WS+NW*64*4, LDS_BYTES=LDS_OST+NW*4096, LDS_F=86016;
constexpr float C2=0.125f*1.4426950408889634f;
__device__ __forceinline__ void glds16(const void*gsrc,unsigned lds_dst){unsigned keep;
  asm volatile("s_mov_b32 %0, m0\n\ts_mov_b32 m0, %2\n\ts_nop 0\n\tglobal_load_lds_dwordx4 %1, off\n\ts_mov_b32 m0, %0":"=&s"(keep):"v"(gsrc),"s"(lds_dst):"memory");}
__device__ __forceinline__ float max3f(float a,float b,float c){float r;asm("v_max3_f32 %0, %1, %2, %3":"=v"(r):"v"(a),"v"(b),"v"(c));return r;}
__device__ __forceinline__ float max2f(float a,float b){float r;asm("v_max_f32_e32 %0, %1, %2":"=v"(r):"v"(a),"v"(b));return r;}
__device__ __forceinline__ float fadd_s(float a,float b){float r;asm("v_add_f32_e32 %0, %1, %2":"=v"(r):"v"(a),"v"(b));return r;}
__device__ __forceinline__ float fsub_s(float a,float b){float r;asm("v_sub_f32_e32 %0, %1, %2":"=v"(r):"v"(a),"v"(b));return r;}
typedef float f32x2_t __attribute__((ext_vector_type(2))); typedef __bf16 bf16x2_t __attribute__((ext_vector_type(2)));
__device__ __forceinline__ unsigned cvtpk_s(float lo,float hi){f32x2_t v={lo,hi};bf16x2_t b=__builtin_convertvector(v,bf16x2_t);return __builtin_bit_cast(unsigned,b);}
#define WAIT_BAR(N) asm volatile("s_waitcnt vmcnt(" #N ") lgkmcnt(0)\n\ts_barrier":::"memory")

__device__ __forceinline__ void qkt(f32x16&p0,f32x16&p1,const char*Kslot,const bf16x8*qr,int r32,int hi){
  const char*kb=Kslot+hi*1024+r32*16;
  #pragma unroll
  for(int d0=0;d0<4;++d0){
    const bf16x8 b0=*reinterpret_cast<const bf16x8*>(kb+d0*2048);
    const bf16x8 b1=*reinterpret_cast<const bf16x8*>(kb+d0*2048+512);
    p0=__builtin_amdgcn_mfma_f32_32x32x16_bf16(b0,qr[d0],p0,0,0,0);p1=__builtin_amdgcn_mfma_f32_32x32x16_bf16(b1,qr[d0],p1,0,0,0);}
}
typedef __attribute__((address_space(3))) const char* lds_cptr;
typedef short v4i16_t __attribute__((ext_vector_type(4)));
__device__ __forceinline__ void kload8(bf16x8*kf,lds_cptr kp){
  kf[0]=*(const __attribute__((address_space(3))) bf16x8*)(kp);      kf[1]=*(const __attribute__((address_space(3))) bf16x8*)(kp+512);
  kf[2]=*(const __attribute__((address_space(3))) bf16x8*)(kp+2048); kf[3]=*(const __attribute__((address_space(3))) bf16x8*)(kp+2560);
  kf[4]=*(const __attribute__((address_space(3))) bf16x8*)(kp+4096); kf[5]=*(const __attribute__((address_space(3))) bf16x8*)(kp+4608);
  kf[6]=*(const __attribute__((address_space(3))) bf16x8*)(kp+6144); kf[7]=*(const __attribute__((address_space(3))) bf16x8*)(kp+6656);
}
__device__ __forceinline__ void kload2(bf16x8*kf,lds_cptr kp,int j){ kf[2*j]=*(const __attribute__((address_space(3))) bf16x8*)(kp+j*2048); kf[2*j+1]=*(const __attribute__((address_space(3))) bf16x8*)(kp+j*2048+512); }
__device__ __forceinline__ s16x4 vtr(lds_cptr p){ return __builtin_bit_cast(s16x4,__builtin_amdgcn_ds_read_tr16_b64_v4i16((__attribute__((address_space(3))) v4i16_t*)p)); }
__device__ __forceinline__ float rowmax(const f32x16&p0,const f32x16&p1){
  float a=max3f(p0[0],p0[1],p1[0]),b=max3f(p0[2],p0[3],p1[1]);a=max3f(a,p1[2],p1[3]);
  #pragma unroll
  for(int r=4;r<16;r+=4){a=max3f(a,p0[r],p0[r+1]);b=max3f(b,p0[r+2],p0[r+3]);a=max3f(a,p1[r],p1[r+1]);b=max3f(b,p1[r+2],p1[r+3]);}
  const float m=max2f(a,b);
  auto rr=__builtin_amdgcn_permlane32_swap(__float_as_uint(m),__float_as_uint(m),false,false);
  return max2f(__uint_as_float(rr[0]),__uint_as_float(rr[1]));
}
__device__ __forceinline__ void pv(f32x16*o,int vb,bf16x8 pa0,bf16x8 pa1,bf16x8 pa2,bf16x8 pa3){
  #pragma unroll
  for(int d0=0;d0<2;++d0){s16x4 lo[4],hi[4];
    #pragma unroll
    for(int ks=0;ks<4;++ks){
      asm volatile("ds_read_b64_tr_b16 %0,%1 offset:%c2":"=&v"(lo[ks]):"v"(vb),"i"(d0*4096+ks*1024):"memory");
      asm volatile("ds_read_b64_tr_b16 %0,%1 offset:%c2":"=&v"(hi[ks]):"v"(vb),"i"(d0*4096+ks*1024+512):"memory");}
    asm volatile("s_waitcnt lgkmcnt(0)":::"memory");SBAR();
    #define PK(k) (bf16x8){lo[k][0],lo[k][1],lo[k][2],lo[k][3],hi[k][0],hi[k][1],hi[k][2],hi[k][3]}
    o[d0]=__builtin_amdgcn_mfma_f32_32x32x16_bf16(pa0,PK(0),o[d0],0,0,0);
    o[d0]=__builtin_amdgcn_mfma_f32_32x32x16_bf16(pa1,PK(1),o[d0],0,0,0);
    o[d0]=__builtin_amdgcn_mfma_f32_32x32x16_bf16(pa2,PK(2),o[d0],0,0,0);
    o[d0]=__builtin_amdgcn_mfma_f32_32x32x16_bf16(pa3,PK(3),o[d0],0,0,0);
    #undef PK
  }
}

#ifndef ATTN_STORE16
#define ATTN_STORE16(p,v) (*(u32x4*)(p)=(v))
#endif
template<int THRL> __device__ __forceinline__ void attn_unit(int b,int h,int qb,const bf16*Q,const bf16*__restrict__ K,const bf16*__restrict__ V,bf16*O,const float*Fg,char*shm){
  const int tid=mk_tid(),lane=tid&63,r32=lane&31,hi=lane>>5; const int wid=__builtin_amdgcn_readfirstlane(tid>>6);
  const long rowbase=(long)b*SEQ; const int q0=qb*QB;
  const bf16*Qw=Q+(rowbase+q0+wid*QBLK)*DM+h*D;
  const bf16*Kh=K+rowbase*DM+h*D,*Vh=V+rowbase*DM+h*D;
  const unsigned lds0=(unsigned)(uintptr_t)shm;
  float*wsf=(float*)(shm+LDS_WS)+wid*64;
  const bf16*ksrc=Kh+(long)lane*DM+wid*8;
  const bf16*vsrc=Vh+(long)(16*(wid&3)+(lane>>2))*DM+(wid>>2)*32+(lane&3)*8;
  const unsigned kdst=lds0+LDS_K+wid*1024, vdst=lds0+LDS_V+wid*1024;
  #define DMA_K(t,slot) glds16(ksrc+(long)(t)*KVBLK*DM,(unsigned)__builtin_amdgcn_readfirstlane(kdst+(slot)))
  #define DMA_V(t,slot) glds16(vsrc+(long)(t)*KVBLK*DM,(unsigned)__builtin_amdgcn_readfirstlane(vdst+(slot)))
  const int vb0=(int)(lds0+LDS_V)+((lane>>4)&1)*32+(lane&3)*8+(4*hi+((lane&15)>>2))*64;
  const char*Kbase=shm+LDS_K; bf16x8 kf[8];
  const lds_cptr shm3=(lds_cptr)shm; const lds_cptr kp0=shm3+LDS_K+hi*1024+r32*16; const lds_cptr vp0=shm3+LDS_V+((lane>>4)&1)*32+(lane&3)*8+(4*hi+((lane&15)>>2))*64;
  const int NT=(q0+QB)/KVBLK;
  typedef float f4v_t __attribute__((ext_vector_type(4))); typedef __attribute__((address_space(3))) f4v_t lf4_t; lf4_t*Fl4=(lf4_t*)((__attribute__((address_space(3))) char*)shm+LDS_F);
  { const int nf4=(q0+QB)/4; const f4v_t*src=(const f4v_t*)Fg; for(int i=tid;i<nf4;i+=NW*64) Fl4[i]=-src[i]; }
  const float fq_l=Fg[q0+wid*QBLK+r32];
  #define BINIT(C0,C1,t) do{ const lf4_t*fp_=Fl4+(t)*16+hi; _Pragma("unroll") for(int a_=0;a_<4;++a_){ const f4v_t f0_=fp_[2*a_], f1_=fp_[8+2*a_]; \
      C0[4*a_]=nb+f0_.x; C0[4*a_+1]=nb+f0_.y; C0[4*a_+2]=nb+f0_.z; C0[4*a_+3]=nb+f0_.w; C1[4*a_]=nb+f1_.x; C1[4*a_+1]=nb+f1_.y; C1[4*a_+2]=nb+f1_.z; C1[4*a_+3]=nb+f1_.w; } }while(0)
  DMA_K(0,0);DMA_V(0,0);DMA_K(1,SLOTB);
  bf16x8 qr[4];
  #pragma unroll
  for(int d0=0;d0<4;++d0)qr[d0]=*reinterpret_cast<const bf16x8*>(&Qw[(long)r32*DM+d0*16+hi*8]);
  float mhat=0.f,l_reg=0.f;f32x16 o[2];o[0]=f32x16{};o[1]=f32x16{};float nb=fq_l;
  const int qrel=wid*QBLK+r32;
  #define CMASK(P0,P1,t) do{int jb_=(t)-(NT-4); if(jb_>=0)cmask(P0,P1,jb_,qrel,hi);}while(0)
  bool resc=false;
  #define START(P0,P1) do{ const float rm=rowmax(P0,P1); resc=false; \
    { const float dl=rm; mhat=fadd_s(mhat,dl); \
      _Pragma("unroll") for(int r=0;r<16;++r){P0[r]=fsub_s(P0[r],dl);P1[r]=fsub_s(P1[r],dl);} \
      nb=fq_l-mhat; } \
    _Pragma("unroll") for(int r=0;r<16;++r)P0[r]=__builtin_amdgcn_exp2f(P0[r]); }while(0)
  #define RESC() do{ if(resc){ asm volatile("s_waitcnt lgkmcnt(0)":::"memory"); \
      _Pragma("unroll") for(int d_=0;d_<2;++d_) _Pragma("unroll") for(int r=0;r<16;++r)o[d_][r]*=wsf[crow(r,hi)]; } }while(0)
  f32x16 pA0,pA1,pB0,pB1;
  int sl_prev=0,sl_cur=0,sl_next=SLOTB;
  #define ROT() do{sl_prev=sl_cur;sl_cur=sl_next;sl_next=(sl_next==(NSLOT-1)*SLOTB)?0:sl_next+SLOTB;}while(0)
  DMA_K(2,2*SLOTB);
  WAIT_BAR(3);
  BINIT(pA0,pA1,0); qkt(pA0,pA1,Kbase,qr,r32,hi);asm volatile("s_nop 15\n\ts_nop 7":"+v"(pA0),"+v"(pA1));CMASK(pA0,pA1,0);
  START(pA0,pA1); BINIT(pB0,pB1,1);
  _Pragma("unroll") for(int r=0;r<16;++r)pA1[r]=__builtin_amdgcn_exp2f(pA1[r]);
  WAIT_BAR(0);
  DMA_K(3,0);DMA_V(1,SLOTB);
  ROT();
  kload8(kf,kp0+sl_cur);
  WAIT_BAR(2);
  s16x4 vlo[8],vhi[8]; u32x4 pw0,pw1,pw2,pw3;
  #define PKW(P,B) cvtpk_s(P[B],P[B+1])
  #define PAF(k) __builtin_bit_cast(bf16x8,pw##k)
  #define VFR(i) (bf16x8){vlo[i][0],vlo[i][1],vlo[i][2],vlo[i][3],vhi[i][0],vhi[i][1],vhi[i][2],vhi[i][3]}
  #define PIN(x) asm volatile("":"+v"(x))
  #define MX3(a,b,c) __builtin_fmaxf(__builtin_fmaxf((a),(b)),(c))
  #define GAPA(MF,A0,A1,A2,A3,W0,W1,PW) do{ MF; sacc+=A0; sacc+=A1; sacc+=A2; sacc+=A3; PIN(sacc); W0; W1; PIN(PW); SBAR(); }while(0)
  #define EX(v) __builtin_amdgcn_exp2f(v)
  #define GAPB(MF,X,B,Y) do{ MF; X[B]=EX(X[B]); X[B+1]=EX(X[B+1]); X[B+2]=EX(X[B+2]); X[B+3]=EX(X[B+3]); PIN(X); Y[B]+=nb; Y[B+1]+=nb; Y[B+2]+=nb; Y[B+3]+=nb; PIN(Y); SBAR(); }while(0)
  #define BLOAD(P0,P1,t1) do{ const lf4_t*fp_=Fl4+(t1)*16+hi; _Pragma("unroll") for(int a_=0;a_<4;++a_){ const f4v_t f0_=fp_[2*a_], f1_=fp_[8+2*a_]; \
      P0[4*a_]=f0_.x; P0[4*a_+1]=f0_.y; P0[4*a_+2]=f0_.z; P0[4*a_+3]=f0_.w; P1[4*a_]=f1_.x; P1[4*a_+1]=f1_.y; P1[4*a_+2]=f1_.z; P1[4*a_+3]=f1_.w; } }while(0)
  #define VRD(i) do{ vlo[i]=vtr(vp_+(((i)>>2)*4096+((i)&3)*1024)); vhi[i]=vtr(vp_+(((i)>>2)*4096+((i)&3)*1024+512)); }while(0)
  #define KRD(G,j) do{ if(G){ kload2(kf,kp0+sl_next,j); SBAR(); } }while(0)
  #define STEP(C0,C1,P0,P1,t,GK,GV,GL) do{ SBAR(); \
    const lds_cptr vp_=vp0+sl_prev; \
    VRD(0); SBAR(); float sacc=(P0[0]+P0[1]); \
    GAPA(C0=__builtin_amdgcn_mfma_f32_32x32x16_bf16(kf[0],qr[0],C0,0,0,0), P0[2],P0[3],P0[4],P0[5],     pw0[0]=PKW(P0,0), pw0[1]=PKW(P0,2), pw0); \
    VRD(4); SBAR(); GAPA(C1=__builtin_amdgcn_mfma_f32_32x32x16_bf16(kf[1],qr[0],C1,0,0,0), P0[6],P0[7],P0[8],P0[9],     pw0[2]=PKW(P0,4), pw0[3]=PKW(P0,6), pw0); \
    VRD(1); SBAR(); GAPA(C0=__builtin_amdgcn_mfma_f32_32x32x16_bf16(kf[2],qr[1],C0,0,0,0),   P0[10],P0[11],P0[12],P0[13], pw1[0]=PKW(P0,8), pw1[1]=PKW(P0,10), pw1); \
    VRD(5); SBAR(); GAPA(C1=__builtin_amdgcn_mfma_f32_32x32x16_bf16(kf[3],qr[1],C1,0,0,0),   P0[14],P0[15],P1[0],P1[1],   pw1[2]=PKW(P0,12),pw1[3]=PKW(P0,14), pw1); \
    VRD(2); SBAR(); GAPA(C0=__builtin_amdgcn_mfma_f32_32x32x16_bf16(kf[4],qr[2],C0,0,0,0),   P1[2],P1[3],P1[4],P1[5],     pw2[0]=PKW(P1,0), pw2[1]=PKW(P1,2), pw2); \
    VRD(6); SBAR(); GAPA(C1=__builtin_amdgcn_mfma_f32_32x32x16_bf16(kf[5],qr[2],C1,0,0,0),   P1[6],P1[7],P1[8],P1[9],     pw2[2]=PKW(P1,4), pw2[3]=PKW(P1,6), pw2); \
    VRD(3); SBAR(); GAPA(C0=__builtin_amdgcn_mfma_f32_32x32x16_bf16(kf[6],qr[3],C0,0,0,0),   P1[10],P1[11],P1[12],P1[13], pw3[0]=PKW(P1,8), pw3[1]=PKW(P1,10), pw3); \
    VRD(7); SBAR(); GAPA(C1=__builtin_amdgcn_mfma_f32_32x32x16_bf16(kf[7],qr[3],C1,0,0,0),   P1[14],P1[15],0.f,0.f,       pw3[2]=PKW(P1,12),pw3[3]=PKW(P1,14), pw3); \
    l_reg+=sacc; \
    if(GK){DMA_K((t)+3,sl_cur);} if(GV){DMA_V((t)+1,sl_next);} \
    CMASK(C0,C1,t); \
    { float a=MX3(C0[0],C0[1],C1[0]),b=MX3(C0[2],C0[3],C1[1]); a=MX3(a,C1[2],C1[3]); \
      _Pragma("unroll") for(int r=4;r<16;r+=4){a=MX3(a,C0[r],C0[r+1]);b=MX3(b,C0[r+2],C0[r+3]);a=MX3(a,C1[r],C1[r+1]);b=MX3(b,C1[r+2],C1[r+3]);} \
      float rm=__builtin_fmaxf(a,b); { auto rr=__builtin_amdgcn_permlane32_swap(__float_as_uint(rm),__float_as_uint(rm),false,false); rm=__builtin_fmaxf(__uint_as_float(rr[0]),__uint_as_float(rr[1])); } \
      resc=false; \
      if(__builtin_expect(__any(rm>(float)THRL),0)){ const float dl=__builtin_fmaxf(rm,0.f); mhat+=dl; \
        _Pragma("unroll") for(int r=0;r<16;++r){C0[r]-=dl;C1[r]-=dl;} \
        nb-=dl; \
        const float f=__builtin_amdgcn_exp2f(-dl); l_reg*=f; if(hi==0)wsf[r32]=f; resc=true; } } \
    SBAR(); BLOAD(P0,P1,(t)+1); SBAR(); \
    GAPB(o[0]=__builtin_amdgcn_mfma_f32_32x32x16_bf16(PAF(0),VFR(0),o[0],0,0,0), C0,0,P0); \
    GAPB(o[1]=__builtin_amdgcn_mfma_f32_32x32x16_bf16(PAF(0),VFR(4),o[1],0,0,0), C0,4,P0); \
    KRD(GL,0); GAPB(o[0]=__builtin_amdgcn_mfma_f32_32x32x16_bf16(PAF(1),VFR(1),o[0],0,0,0), C0,8,P0); \
    KRD(GL,1); GAPB(o[1]=__builtin_amdgcn_mfma_f32_32x32x16_bf16(PAF(1),VFR(5),o[1],0,0,0), C0,12,P0); \
    KRD(GL,2); GAPB(o[0]=__builtin_amdgcn_mfma_f32_32x32x16_bf16(PAF(2),VFR(2),o[0],0,0,0), C1,0,P1); \
    KRD(GL,3); GAPB(o[1]=__builtin_amdgcn_mfma_f32_32x32x16_bf16(PAF(2),VFR(6),o[1],0,0,0), C1,4,P1); \
    GAPB(o[0]=__builtin_amdgcn_mfma_f32_32x32x16_bf16(PAF(3),VFR(3),o[0],0,0,0), C1,8,P1); \
    GAPB(o[1]=__builtin_amdgcn_mfma_f32_32x32x16_bf16(PAF(3),VFR(7),o[1],0,0,0), C1,12,P1); \
    }while(0)
  int t=1;
  #undef CMASK
  #define CMASK(P0,P1,t) do{}while(0)
  for(;t+5<NT;t+=2){
    STEP(pB0,pB1,pA0,pA1,t,true,true,true);     WAIT_BAR(2); RESC(); ROT();
    STEP(pA0,pA1,pB0,pB1,t+1,true,true,true);   WAIT_BAR(2); RESC(); ROT();
  }
  #undef CMASK
  #define CMASK(P0,P1,t) do{int jb_=(t)-(NT-4); if(jb_>=0)cmask(P0,P1,jb_,qrel,hi);}while(0)
  #define ENDW(tt) do{ if((tt)+3<NT){WAIT_BAR(2);} else if((tt)+2<NT){WAIT_BAR(1);} else {WAIT_BAR(0);} }while(0)
  for(;t+1<NT;t+=2){
    STEP(pB0,pB1,pA0,pA1,t,(t+3<NT),(t+1<NT),(t+1<NT));       ENDW(t);   RESC(); ROT();
    STEP(pA0,pA1,pB0,pB1,t+1,(t+4<NT),(t+2<NT),(t+2<NT));     ENDW(t+1); RESC(); ROT();
  }
  STEP(pB0,pB1,pA0,pA1,NT-1,false,false,false); RESC();
  { float sacc=pB0[0]+pB0[1]; _Pragma("unroll") for(int r=2;r<16;++r)sacc+=pB0[r]; _Pragma("unroll") for(int r=0;r<16;++r)sacc+=pB1[r]; l_reg+=sacc;
    pw0=(u32x4){PKW(pB0,0),PKW(pB0,2),PKW(pB0,4),PKW(pB0,6)};pw1=(u32x4){PKW(pB0,8),PKW(pB0,10),PKW(pB0,12),PKW(pB0,14)};pw2=(u32x4){PKW(pB1,0),PKW(pB1,2),PKW(pB1,4),PKW(pB1,6)};pw3=(u32x4){PKW(pB1,8),PKW(pB1,10),PKW(pB1,12),PKW(pB1,14)};
    SBAR(); pv(o,vb0+sl_cur,PAF(0),PAF(1),PAF(2),PAF(3)); }
  #undef PKW
  #undef PAF
  #undef VFR
  #undef PIN
  #undef MX3
  #undef GAPA
  #undef GAPB
  #undef BLOAD
  #undef EX
  #undef VRD
  #undef KRD
  #undef STEP
  #undef ENDW
  {auto rr=__builtin_amdgcn_permlane32_swap(__float_as_uint(l_reg),__float_as_uint(l_reg),false,false);l_reg=__uint_as_float(rr[0])+__uint_as_float(rr[1]);}
  if(hi==0)wsf[32+r32]=l_reg;asm volatile("s_waitcnt lgkmcnt(0)":::"memory");
  float rli[16];
  #pragma unroll
  for(int r=0;r<16;++r)rli[r]=__builtin_amdgcn_rcpf(wsf[32+crow(r,hi)]);
  bf16*Ow=O+(rowbase+q0+wid*QBLK)*OPITCH+h*D;
  { bf16*stg=(bf16*)(shm+LDS_OST)+wid*2048;
    #pragma unroll
    for(int r=0;r<16;++r){const int orow=crow(r,hi);
      #pragma unroll
      for(int d0=0;d0<2;++d0)stg[orow*64+d0*32+r32]=__float2bfloat16(o[d0][r]*rli[r]);}
    asm volatile("s_waitcnt lgkmcnt(0)":::"memory");
    #pragma unroll
    for(int i=0;i<4;++i){const int row=i*8+(lane>>3),ch=lane&7; const u32x4 v=*(const u32x4*)(stg+row*64+ch*8); ATTN_STORE16(Ow+(long)row*OPITCH+ch*8,v);} }
  asm volatile("s_waitcnt lgkmcnt(0)\n\ts_barrier":::"memory");
  #undef DMA_K
  #undef DMA_V
  #undef CMASK
  #undef START
  #undef RESC
  #undef ROT
  #undef BINIT
}
constexpr int ATTN_LDS_BYTES=LDS_BYTES;
struct AttnTensors { const bf16* Q; const bf16* K; const bf16* V; bf16* O; const float* F; };
struct AttnUnit { int bh; int qb; };
struct StaticOrder {
  int vcu;
  __device__ __forceinline__ explicit StaticOrder(int v):vcu(v){}
  __device__ __forceinline__ bool next(int i,AttnUnit&u)const{ if(i>=8)return false; const int s=4*(vcu&1)+(i>>1); u.bh=vcu>>1; u.qb=(i&1)?15-s:s; return true; }
};
template<class Sched,int THRL=48> __device__ __forceinline__ void attn_phase(char*lds,const AttnTensors&T,const Sched&S){
  AttnUnit u;
  for(int i=0;S.next(i,u);++i){ attn_unit<THRL>(u.bh/NHEAD,u.bh%NHEAD,u.qb,T.Q,T.K,T.V,T.O,T.F+(size_t)u.bh*SEQ,lds); }
}
#undef SBAR
#undef WAIT_BAR
}
namespace mk {
typedef unsigned short bf16_t;
typedef short bf16x8 __attribute__((ext_vector_type(8)));
typedef float f32x4 __attribute__((ext_vector_type(4)));
typedef float f32x16 __attribute__((ext_vector_type(16)));
typedef unsigned u32x4 __attribute__((ext_vector_type(4)));
typedef unsigned u32x2 __attribute__((ext_vector_type(2)));

constexpr int DM = 1024, NPT = 65536, NST = 512, MT = NPT + NST, SEQ = 4096, DFF = 2816, PW = 3072, NINP = 3328;
constexpr float LOG2E = 1.4426950408889634f;
constexpr float C2 = 0.125f * LOG2E;
constexpr float ALPHA = 1.4142135623730951f;
constexpr size_t O_YP = 0, O_YS = O_YP + 67108864, O_PFK = O_YS + 524288, O_PFV = O_PFK + 67108864, O_PFL = O_PFV + 67108864,
    O_PMC = O_PFL + 1048576, O_PMN = O_PMC + 524288, O_PMM = O_PMN + 8192, O_SFK = O_PMM + 128, O_SFV = O_SFK + 524288,
    O_SFL = O_SFV + 524288, O_SMC = O_SFL + 8192, O_SMN = O_SMC + 524288, O_SMM = O_SMN + 8192, O_SGV = O_SMM + 128, O_END = O_SGV + 262144;
constexpr size_t MiB = 1u << 20;
constexpr size_t WS_MOD = 1 * MiB, WS_STATS = 3 * MiB, WS_GATES = 6 * MiB, WS_FQ = 11 * MiB, WS_AB = 13 * MiB, WS_MS = 13 * MiB + 65536, WS_NS = 14 * MiB,
    WS_WIN = 16 * MiB, WS_WO = 29 * MiB, WS_WGU = 33 * MiB, WS_WD = 55 * MiB, WS_GW = 66 * MiB, WS_HA = 67 * MiB, WS_PROJ = 196 * MiB,
    WS_R1 = 583 * MiB, WS_R2 = 712 * MiB, WS_UT = 841 * MiB, WS_CS = 906 * MiB, WS_END = 938 * MiB;
constexpr int LDS_BYTES = 155648;

struct Ctx {
    unsigned char* ws; float* out; const PG8_LAS unsigned long long* tab;
    __device__ __forceinline__ const float* in(int i) const { const unsigned long long v = tab[i]; const unsigned lo = __builtin_amdgcn_readfirstlane((unsigned)v), hi = __builtin_amdgcn_readfirstlane((unsigned)(v >> 32)); return (const float*)(const __attribute__((address_space(1))) float*)(((unsigned long long)hi << 32) | lo); }
    __device__ __forceinline__ const float* x_prompt() const { return in(0); }
    __device__ __forceinline__ const float* x_sample() const { return in(1); }
    __device__ __forceinline__ const float* cache_k() const { return in(2); }
    __device__ __forceinline__ const float* cache_v() const { return in(3); }
    __device__ __forceinline__ const float* cache_logf() const { return in(4); }
    __device__ __forceinline__ const float* st_C() const { return in(5); }
    __device__ __forceinline__ const float* st_n() const { return in(6); }
    __device__ __forceinline__ const float* st_m() const { return in(7); }
    __device__ __forceinline__ const float* c_prompt() const { return in(8); }
    __device__ __forceinline__ const float* c_sample() const { return in(9); }
    __device__ __forceinline__ const float* w_ada() const { return in(10); }
    __device__ __forceinline__ const float* b_ada() const { return in(11); }
    __device__ __forceinline__ const float* w_in() const { return in(12); }
    __device__ __forceinline__ const float* b_mi() const { return in(13); }
    __device__ __forceinline__ const float* b_mf() const { return in(14); }
    __device__ __forceinline__ const float* norm_g() const { return in(15); }
    __device__ __forceinline__ const float* b_ff() const { return in(16); }
    __device__ __forceinline__ const float* gln_g() const { return in(17); }
    __device__ __forceinline__ const float* gln_b() const { return in(18); }
    __device__ __forceinline__ const float* gws() const { return in(19); }
    __device__ __forceinline__ const float* gbs() const { return in(20); }
    __device__ __forceinline__ const float* w_o() const { return in(21); }
    __device__ __forceinline__ const float* ln1_g() const { return in(22); }
    __device__ __forceinline__ const float* ln1_b() const { return in(23); }
    __device__ __forceinline__ const float* w_gate() const { return in(24); }
    __device__ __forceinline__ const float* w_up() const { return in(25); }
    __device__ __forceinline__ const float* w_down() const { return in(26); }
    __device__ __forceinline__ const float* ln2_g() const { return in(27); }
    __device__ __forceinline__ const float* ln2_b() const { return in(28); }
    __device__ __forceinline__ float* MOD() const { return (float*)(ws + WS_MOD); }
    __device__ __forceinline__ float* STATS() const { return (float*)(ws + WS_STATS); }
    __device__ __forceinline__ float* GATES() const { return (float*)(ws + WS_GATES); }
    __device__ __forceinline__ float* FQ() const { return (float*)(ws + WS_FQ); }
    __device__ __forceinline__ float* AB() const { return (float*)(ws + WS_AB); }
    __device__ __forceinline__ float* MS() const { return (float*)(ws + WS_MS); }
    __device__ __forceinline__ float* NS() const { return (float*)(ws + WS_NS); }
    __device__ __forceinline__ float* UT() const { return (float*)(ws + WS_UT); }
    __device__ __forceinline__ bf16_t* WIN() const { return (bf16_t*)(ws + WS_WIN); }
    __device__ __forceinline__ bf16_t* WO() const { return (bf16_t*)(ws + WS_WO); }
    __device__ __forceinline__ bf16_t* WGU() const { return (bf16_t*)(ws + WS_WGU); }
    __device__ __forceinline__ bf16_t* WD() const { return (bf16_t*)(ws + WS_WD); }
    __device__ __forceinline__ bf16_t* GW() const { return (bf16_t*)(ws + WS_GW); }
    __device__ __forceinline__ bf16_t* HA() const { return (bf16_t*)(ws + WS_HA); }
    __device__ __forceinline__ bf16_t* PROJ() const { return (bf16_t*)(ws + WS_PROJ); }
    __device__ __forceinline__ bf16_t* R1() const { return (bf16_t*)(ws + WS_R1); }
    __device__ __forceinline__ bf16_t* R2() const { return (bf16_t*)(ws + WS_R2); }
    __device__ __forceinline__ bf16_t* CS() const { return (bf16_t*)(ws + WS_CS); }
};

__device__ __forceinline__ float bf2f(unsigned u16) { return __uint_as_float(u16 << 16); }
__device__ __forceinline__ unsigned pkbf(float lo, float hi) { unsigned r; asm("v_cvt_pk_bf16_f32 %0, %1, %2" : "=v"(r) : "v"(lo), "v"(hi)); return r; }
__device__ __forceinline__ float logsig(float x) { return fminf(x, 0.f) - __logf(1.f + __expf(-fabsf(x))); }
__device__ __forceinline__ float sigm(float x) { return 1.f / (1.f + __expf(-x)); }
__device__ __forceinline__ float wsum(float v) {
#pragma unroll
    for (int o = 32; o > 0; o >>= 1) v += __shfl_xor(v, o);
    return v;
}
__device__ __forceinline__ float wmax(float v) {
#pragma unroll
    for (int o = 32; o > 0; o >>= 1) v = fmaxf(v, __shfl_xor(v, o));
    return v;
}
__device__ __forceinline__ int row_cb(int row) { return row < NPT ? (row >> 12) : 16 + ((row - NPT) >> 5); }
__device__ __forceinline__ int crow(int r, int hi) { return (r & 3) + 8 * (r >> 2) + 4 * hi; }
__device__ __forceinline__ bf16x8 gather8(const bf16_t* p, int stride, int o4) {
    unsigned v[8];
#pragma unroll
    for (int j = 0; j < 4; ++j) { v[j] = p[j * stride]; v[4 + j] = p[(o4 + j) * stride]; }
    u32x4 w; w.x = v[0] | (v[1] << 16); w.y = v[2] | (v[3] << 16); w.z = v[4] | (v[5] << 16); w.w = v[6] | (v[7] << 16);
    return __builtin_bit_cast(bf16x8, w);
}
__device__ __forceinline__ void unpack8(const u32x4 w, float* f) {
    f[0] = bf2f(w.x & 0xffffu); f[1] = bf2f(w.x >> 16); f[2] = bf2f(w.y & 0xffffu); f[3] = bf2f(w.y >> 16);
    f[4] = bf2f(w.z & 0xffffu); f[5] = bf2f(w.z >> 16); f[6] = bf2f(w.w & 0xffffu); f[7] = bf2f(w.w >> 16);
}

__device__ __forceinline__ void tr_item(const float* W, int ldw, int srccol, bf16_t* WT, int K, int dst_row0, int k0, float* scr, int lane) {
    float tv[32];
#pragma unroll
    for (int i = 0; i < 32; ++i) { const int kk = 2 * i + (lane >> 5); tv[i] = srccol >= 0 ? W[(size_t)(k0 + kk) * ldw + srccol] : 0.f; }
#pragma unroll
    for (int i = 0; i < 32; ++i) { const int kk = 2 * i + (lane >> 5); scr[kk * 33 + (lane & 31)] = tv[i]; }
    asm volatile("s_waitcnt lgkmcnt(0)" ::: "memory");
    const int c = lane & 7;
#pragma unroll
    for (int j = 0; j < 4; ++j) { const int n = (lane >> 3) + 8 * j; const float* s = scr + (8 * c) * 33 + n;
        u32x4 o; o.x = pkbf(s[0 * 33], s[1 * 33]); o.y = pkbf(s[2 * 33], s[3 * 33]); o.z = pkbf(s[4 * 33], s[5 * 33]); o.w = pkbf(s[6 * 33], s[7 * 33]);
        *(u32x4*)(WT + (size_t)(dst_row0 + n) * K + k0 + 8 * c) = o; }
    asm volatile("s_waitcnt lgkmcnt(0)" ::: "memory");
}

__device__ __forceinline__ void p0a(const Ctx& C, unsigned char* smem) {
    const int tid = mk_tid(), lane = tid & 63, wid = tid >> 6;
    const int gtid = blockIdx.x * 512 + tid, GT = gridDim.x * 512;
    for (int i = gtid; i < 4 * MT * 2; i += GT) C.STATS()[i] = 0.f;
    for (int i = gtid; i < 2 * 4 * 128 * 128; i += GT) { const int t = (i >> 7) & 127, s = i & 127; C.GW()[i] = (bf16_t)(pkbf(s <= t ? C.gws()[i] : 0.f, 0.f) & 0xffffu); }
    float* sil = (float*)smem;
    for (int u = blockIdx.x; u < 192; u += gridDim.x) {
        __syncthreads();
        for (int i = tid; i < 32 * 1024; i += 512) { const int cb = i >> 10, k = i & 1023; const float c = cb < 16 ? C.c_prompt()[cb * 1024 + k] : C.c_sample()[(cb - 16) * 1024 + k]; sil[i] = c / (1.f + __expf(-c)); }
        __syncthreads();
        const int l = u / 96, n0 = (u % 96) * 64;
        float acc[32];
#pragma unroll
        for (int cb = 0; cb < 32; ++cb) acc[cb] = 0.f;
        const float* W = C.w_ada() + (size_t)l * 1024 * 6144 + n0 + lane;
        for (int k = wid * 128; k < wid * 128 + 128; k += 16) {
            float wv[16];
#pragma unroll
            for (int j = 0; j < 16; ++j) wv[j] = W[(size_t)(k + j) * 6144];
#pragma unroll
            for (int q4 = 0; q4 < 4; ++q4)
#pragma unroll
                for (int cb = 0; cb < 32; ++cb) { const float4 s = *(const float4*)(sil + cb * 1024 + k + 4 * q4); acc[cb] += s.x * wv[4 * q4] + s.y * wv[4 * q4 + 1] + s.z * wv[4 * q4 + 2] + s.w * wv[4 * q4 + 3]; }
        }
        __syncthreads();
#pragma unroll
        for (int cb = 0; cb < 32; ++cb) sil[(wid * 32 + cb) * 64 + lane] = acc[cb];
        __syncthreads();
#pragma unroll
        for (int j = 0; j < 4; ++j) { const int o = tid + 512 * j, cb = o >> 6, ln = o & 63; float s = C.b_ada()[l * 6144 + n0 + ln];
#pragma unroll
            for (int w = 0; w < 8; ++w) s += sil[(w * 32 + cb) * 64 + ln];
            C.MOD()[(size_t)(l * 32 + cb) * 6144 + n0 + ln] = s; }
    }
    __syncthreads();
    float* scr = (float*)smem + wid * 2112;
    const int gw = blockIdx.x * 8 + wid, NGW = gridDim.x * 8;
    for (int it = gw; it < 12800; it += NGW) {
        const int l = it / 6400; int r = it % 6400;
        if (r < 1664) { const int kb = r / 104, nb = r % 104, p = nb * 32 + (lane & 31);
            const int sc = p < 1024 ? p : p < 2560 ? p + 8 : p < 3072 ? p + 16 : (p < 3080 ? p - 3072 + 1024 : (p < 3088 ? p - 3080 + 2568 : -1));
            tr_item(C.w_in() + (size_t)l * 1024 * 3088, 3088, sc, C.WIN() + (size_t)l * NINP * 1024, 1024, nb * 32, kb * 64, scr, lane); continue; }
        r -= 1664;
        if (r < 512) { const int kb = r / 32, nb = r % 32;
            tr_item(C.w_o() + (size_t)l * 1024 * 1024, 1024, nb * 32 + (lane & 31), C.WO() + (size_t)l * 1024 * 1024, 1024, nb * 32, kb * 64, scr, lane); continue; }
        r -= 512;
        if (r < 2816) { const int kb = r / 176, nb = r % 176, pn = nb >> 3, wi = nb & 7;
            const float* src = (wi < 4 ? C.w_gate() : C.w_up()) + (size_t)l * 1024 * DFF;
            tr_item(src, DFF, 128 * pn + 32 * (wi & 3) + (lane & 31), C.WGU() + (size_t)l * 5632 * 1024, 1024, nb * 32, kb * 64, scr, lane); continue; }
        r -= 2816;
        { const int kb = r / 32, nb = r % 32;
            tr_item(C.w_down() + (size_t)l * DFF * 1024, 1024, nb * 32 + (lane & 31), C.WD() + (size_t)l * 1024 * DFF, DFF, nb * 32, kb * 64, scr, lane); }
    }
}

__device__ __forceinline__ void p0b(const Ctx& C) {
    const int lane = mk_tid() & 63, wid = mk_tid() >> 6;
    const int gw = blockIdx.x * 8 + wid, NGW = gridDim.x * 8;
    const float* xp = C.x_prompt(); const float* xs = C.x_sample(); const float* MODp = C.MOD(); bf16_t* HAp = C.HA();
    for (int row0 = gw; row0 < MT; row0 += 2 * NGW) {
        float4 xv[2][4];
#pragma unroll
        for (int q = 0; q < 2; ++q) { const int row = row0 + q * NGW < MT ? row0 + q * NGW : row0;
            const float* xr = row < NPT ? xp + (size_t)row * DM : xs + (size_t)(row - NPT) * DM;
#pragma unroll
            for (int j = 0; j < 4; ++j) xv[q][j] = *(const float4*)(xr + 256 * j + 4 * lane); }
#pragma unroll
        for (int q = 0; q < 2; ++q) { const int row = row0 + q * NGW; if (row >= MT) break;
            const float* md = MODp + (size_t)row_cb(row) * 6144;
#pragma unroll
            for (int j = 0; j < 4; ++j) { const int c = 256 * j + 4 * lane; const float4 x = xv[q][j];
                const float4 sh = *(const float4*)(md + c), sc = *(const float4*)(md + 1024 + c);
                u32x2 o; o.x = pkbf(x.x * (1.f + sc.x) + sh.x, x.y * (1.f + sc.y) + sh.y); o.y = pkbf(x.z * (1.f + sc.z) + sh.z, x.w * (1.f + sc.w) + sh.w);
                *(u32x2*)(HAp + (size_t)row * DM + c) = o; } }
    }
}

__device__ __forceinline__ void ln_apply(const bf16_t* __restrict__ R, const float* __restrict__ stats, const float* __restrict__ g, const float* __restrict__ b, const float* __restrict__ mod_sh, const float* __restrict__ mod_sc,
                                         bf16_t* __restrict__ obf, float* __restrict__ of_p, float* __restrict__ of_s, int row_lo, int row_hi, int gw, int NGW) {
    const int lane = mk_tid() & 63;
    for (int row0 = row_lo + gw; row0 < row_hi; row0 += 8 * NGW) {
        u32x2 rr[8][4]; float mean[8], rstd[8];
#pragma unroll
        for (int q = 0; q < 8; ++q) { const int row = row0 + q * NGW < row_hi ? row0 + q * NGW : row0;
#pragma unroll
            for (int j = 0; j < 4; ++j) rr[q][j] = *(const u32x2*)(R + (size_t)row * DM + 256 * j + 4 * lane);
            const float s = __hip_atomic_load(stats + row * 2, __ATOMIC_RELAXED, __HIP_MEMORY_SCOPE_AGENT), ss = __hip_atomic_load(stats + row * 2 + 1, __ATOMIC_RELAXED, __HIP_MEMORY_SCOPE_AGENT);
            mean[q] = s * (1.f / 1024.f); rstd[q] = rsqrtf(fmaxf(ss * (1.f / 1024.f) - mean[q] * mean[q], 0.f) + 1e-5f); }
#pragma unroll
        for (int q = 0; q < 8; ++q) { const int row = row0 + q * NGW; if (row >= row_hi) break;
            const int cb = row_cb(row);
#pragma unroll
            for (int j = 0; j < 4; ++j) { const int c = 256 * j + 4 * lane;
                const float4 gg = *(const float4*)(g + c), bb = *(const float4*)(b + c);
                float4 x;
                x.x = (bf2f(rr[q][j].x & 0xffffu) - mean[q]) * rstd[q] * gg.x + bb.x; x.y = (bf2f(rr[q][j].x >> 16) - mean[q]) * rstd[q] * gg.y + bb.y;
                x.z = (bf2f(rr[q][j].y & 0xffffu) - mean[q]) * rstd[q] * gg.z + bb.z; x.w = (bf2f(rr[q][j].y >> 16) - mean[q]) * rstd[q] * gg.w + bb.w;
                if (of_p) { float* o = row < NPT ? of_p + (size_t)row * DM : of_s + (size_t)(row - NPT) * DM; f32x4 xv_; xv_[0] = x.x; xv_[1] = x.y; xv_[2] = x.z; xv_[3] = x.w; *(f32x4*)(o + c) = xv_; }
                if (obf) { const float4 sh = *(const float4*)(mod_sh + (size_t)cb * 6144 + c), sc = *(const float4*)(mod_sc + (size_t)cb * 6144 + c);
                    u32x2 o; o.x = pkbf(x.x * (1.f + sc.x) + sh.x, x.y * (1.f + sc.y) + sh.y); o.y = pkbf(x.z * (1.f + sc.z) + sh.z, x.w * (1.f + sc.w) + sh.w);
                    *(u32x2*)(obf + (size_t)row * DM + c) = o; }
            } }
    }
}

using pg8::Unit;
struct PanelOrder {
    int c, G, np;
    __device__ __forceinline__ void init(int G_, int c_) { G = G_; c = c_; np = c_ < 256 ? (256 - c_ + G_ - 1) / G_ : 0; }
    __device__ __forceinline__ bool next(int i, Unit& u) const {
        if (i < 4 * np) { u.pm = c + (i >> 2) * G; u.pn = i & 3; return true; }
        const int s = c + (i - 4 * np) * G; if (s < 8) { u.pm = 256 + (s >> 2); u.pn = s & 3; return true; }
        return false; }
    __device__ __forceinline__ void a_ready(const Unit&) const {}
    __device__ __forceinline__ void done(const Unit&) const {}
};
struct EpiInProj {
    static constexpr bool PERM = true, AFTER_DRAIN = false;
    bf16_t* proj; float* gates; float* out; int layer; const float *bi, *bf, *bff;
    __device__ __forceinline__ void operator()(const f32x4 (&acc)[2][2][4][2], const Unit& u, int wr, int wc, int fr, int fq) const {
        const int row0 = u.pm * 256 + wr * 64 + fr, pn = u.pn;
        if (pn < 12) {
            const float sc = (pn == 4 || pn == 5) ? C2 : (pn == 1 ? 0.125f : 1.f);
            const bool f32o = pn >= 6 && pn < 10;
            const int colf0 = ((pn - 6) & 1) * 256 + wc * 32 + 8 * fq;
#pragma unroll
            for (int ai = 0; ai < 2; ++ai)
#pragma unroll
                for (int m = 0; m < 4; ++m) { const int row = row0 + ai * 128 + m * 16;
                    bf16_t* rowp = proj + (size_t)row * PW + pn * 256 + wc * 32 + 8 * fq;
                    float* fo = nullptr;
                    if (f32o) { fo = row < NPT ? out + (pn < 8 ? O_PFK : O_PFV) + ((size_t)layer * NPT + row) * 512 : out + (pn < 8 ? O_SFK : O_SFV) + ((size_t)layer * NST + (row - NPT)) * 512; fo += colf0; }
#pragma unroll
                    for (int bj = 0; bj < 2; ++bj) { const f32x4 v0 = acc[ai][bj][m][0], v1 = acc[ai][bj][m][1];
                        u32x4 w; w.x = pkbf(v0[0] * sc, v0[1] * sc); w.y = pkbf(v0[2] * sc, v0[3] * sc); w.z = pkbf(v1[0] * sc, v1[1] * sc); w.w = pkbf(v1[2] * sc, v1[3] * sc);
                        *(u32x4*)(rowp + bj * 128) = w;
                        if (f32o) { *(f32x4*)(fo + bj * 128) = v0; *(f32x4*)(fo + bj * 128 + 4) = v1; } } }
        } else if (wc == 0 && fq < 2) {
#pragma unroll
            for (int ai = 0; ai < 2; ++ai)
#pragma unroll
                for (int m = 0; m < 4; ++m) { const int row = row0 + ai * 128 + m * 16;
                    const f32x4 v0 = acc[ai][0][m][0], v1 = acc[ai][0][m][1];
                    float* gp = gates + (size_t)row * 16;
                    if (fq == 0) {
                        f32x4 li, lf;
#pragma unroll
                        for (int j = 0; j < 4; ++j) { li[j] = v0[j] + bi[j]; lf[j] = logsig(v1[j] + bf[j]); }
                        *(f32x4*)gp = li; *(f32x4*)(gp + 4) = lf;
                    } else {
                        f32x4 a, b;
#pragma unroll
                        for (int j = 0; j < 4; ++j) { a[j] = logsig(v0[j] + bff[j]); b[j] = logsig(v1[j] + bff[4 + j]); }
                        *(f32x4*)(gp + 8) = a; *(f32x4*)(gp + 12) = b;
                        float* lo = row < NPT ? out + O_PFL + ((size_t)layer * NPT + row) * 8 : out + O_SFL + ((size_t)layer * NST + (row - NPT)) * 8;
                        *(f32x4*)lo = a; *(f32x4*)(lo + 4) = b;
                    } }
        }
    }
};
struct EpiSwiGLU {
    static constexpr bool PERM = true, AFTER_DRAIN = false;
    bf16_t* hid;
    __device__ __forceinline__ void operator()(const f32x4 (&acc)[2][2][4][2], const Unit& u, int wr, int wc, int fr, int fq) const {
        const int row0 = u.pm * 256 + wr * 64 + fr;
#pragma unroll
        for (int ai = 0; ai < 2; ++ai)
#pragma unroll
            for (int m = 0; m < 4; ++m) { const int row = row0 + ai * 128 + m * 16;
                float h[8];
#pragma unroll
                for (int n = 0; n < 2; ++n)
#pragma unroll
                    for (int j = 0; j < 4; ++j) { const float g = acc[ai][0][m][n][j], up = acc[ai][1][m][n][j]; h[4 * n + j] = g * up / (1.f + __expf(-g)); }
                u32x4 w; w.x = pkbf(h[0], h[1]); w.y = pkbf(h[2], h[3]); w.z = pkbf(h[4], h[5]); w.w = pkbf(h[6], h[7]);
                *(u32x4*)(hid + (size_t)row * DFF + u.pn * 128 + wc * 32 + 8 * fq) = w; }
    }
};
template <bool XN> struct EpiRes {
    static constexpr bool PERM = false, AFTER_DRAIN = false;
    const float *xp, *xs;
    const bf16_t* Rp; const float *Sp, *gp, *bp;
    const float* gate;
    bf16_t* R; float* stats;
    __device__ __forceinline__ void operator()(const f32x4 (&acc)[2][2][4][2], const Unit& u, int wr, int wc, int fr, int fq) const {
        const int col0 = u.pn * 256 + wc * 32 + 4 * fq;
#pragma unroll
        for (int ai = 0; ai < 2; ++ai)
#pragma unroll
            for (int m = 0; m < 4; ++m) { const int row = u.pm * 256 + ai * 128 + wr * 64 + m * 16 + fr; const int cb = row_cb(row);
                float mean = 0.f, rstd = 0.f;
                if (XN) { const float s = Sp[row * 2], ss = Sp[row * 2 + 1]; mean = s * (1.f / 1024.f); rstd = rsqrtf(fmaxf(ss * (1.f / 1024.f) - mean * mean, 0.f) + 1e-5f); }
                const float* xr = XN ? nullptr : (row < NPT ? xp + (size_t)row * DM : xs + (size_t)(row - NPT) * DM);
                float ps = 0.f, pss = 0.f;
#pragma unroll
                for (int bj = 0; bj < 2; ++bj)
#pragma unroll
                    for (int n = 0; n < 2; ++n) { const int c = col0 + bj * 128 + n * 16;
                        f32x4 x;
                        if (XN) { const u32x2 rr = *(const u32x2*)(Rp + (size_t)row * DM + c); const f32x4 gg = *(const f32x4*)(gp + c), bb = *(const f32x4*)(bp + c);
                            x[0] = (bf2f(rr.x & 0xffffu) - mean) * rstd * gg[0] + bb[0]; x[1] = (bf2f(rr.x >> 16) - mean) * rstd * gg[1] + bb[1];
                            x[2] = (bf2f(rr.y & 0xffffu) - mean) * rstd * gg[2] + bb[2]; x[3] = (bf2f(rr.y >> 16) - mean) * rstd * gg[3] + bb[3];
                        } else x = *(const f32x4*)(xr + c);
                        const f32x4 gt = *(const f32x4*)(gate + (size_t)cb * 6144 + c);
                        const f32x4 a = acc[ai][bj][m][n];
                        f32x4 r;
#pragma unroll
                        for (int j = 0; j < 4; ++j) { r[j] = ALPHA * x[j] + (1.f + gt[j]) * a[j]; ps += r[j]; pss += r[j] * r[j]; }
                        u32x2 w; w.x = pkbf(r[0], r[1]); w.y = pkbf(r[2], r[3]);
                        *(u32x2*)(R + (size_t)row * DM + c) = w; }
                ps += __shfl_xor(ps, 16); ps += __shfl_xor(ps, 32); pss += __shfl_xor(pss, 16); pss += __shfl_xor(pss, 32);
                if (fq == 0) { atomicAdd(stats + row * 2, ps); atomicAdd(stats + row * 2 + 1, pss); } }
    }
};
__device__ __forceinline__ void fcum_unit(const Ctx& C, int b, unsigned char* smem) {
    const int tid = mk_tid();
    float* tot = (float*)smem;
    float pre[8][8];
    const float* gp = C.GATES() + ((size_t)b * SEQ + tid * 8) * 16 + 8;
    float run[8];
#pragma unroll
    for (int h = 0; h < 8; ++h) run[h] = 0.f;
#pragma unroll
    for (int j = 0; j < 8; ++j) { const float4 a = *(const float4*)(gp + j * 16), c = *(const float4*)(gp + j * 16 + 4);
        run[0] += a.x; run[1] += a.y; run[2] += a.z; run[3] += a.w; run[4] += c.x; run[5] += c.y; run[6] += c.z; run[7] += c.w;
#pragma unroll
        for (int h = 0; h < 8; ++h) pre[j][h] = run[h]; }
    __syncthreads();
#pragma unroll
    for (int h = 0; h < 8; ++h) tot[tid * 8 + h] = run[h];
    __syncthreads();
    int cur = 0;
    for (int d = 1; d < 512; d <<= 1) {
        float v[8];
#pragma unroll
        for (int h = 0; h < 8; ++h) { v[h] = tot[cur * 4096 + tid * 8 + h]; if (tid >= d) v[h] += tot[cur * 4096 + (tid - d) * 8 + h]; }
#pragma unroll
        for (int h = 0; h < 8; ++h) tot[(cur ^ 1) * 4096 + tid * 8 + h] = v[h];
        cur ^= 1;
        __syncthreads();
    }
#pragma unroll
    for (int h = 0; h < 8; ++h) { const float off = tid > 0 ? tot[cur * 4096 + (tid - 1) * 8 + h] : 0.f;
        float* o = C.FQ() + ((size_t)(b * 8 + h)) * SEQ + tid * 8;
        float4 a, c; a.x = (off + pre[0][h]) * LOG2E; a.y = (off + pre[1][h]) * LOG2E; a.z = (off + pre[2][h]) * LOG2E; a.w = (off + pre[3][h]) * LOG2E;
        c.x = (off + pre[4][h]) * LOG2E; c.y = (off + pre[5][h]) * LOG2E; c.z = (off + pre[6][h]) * LOG2E; c.w = (off + pre[7][h]) * LOG2E;
        *(float4*)o = a; *(float4*)(o + 4) = c; }
    __syncthreads();
}

constexpr int M1_PAIRB = 18944, TP = 72;
__device__ __forceinline__ void m1_quad(const Ctx& C, int quad, unsigned char* smem) {
    const int tid = mk_tid(), lane = tid & 63, wid = __builtin_amdgcn_readfirstlane(tid >> 6), p = wid >> 1, sub = wid & 1, r32 = lane & 31, hi = lane >> 5;
    const int gc = quad * 4 + p, bh = gc >> 6, c = gc & 63, b = bh >> 2, h = bh & 3;
    const int row0 = b * SEQ + c * 64;
    unsigned char* base = smem + p * M1_PAIRB;
    bf16_t* Kt = (bf16_t*)base; bf16_t* Vt = (bf16_t*)(base + 9216); float* wt = (float*)(base + 18432);
    const int tp = tid & 127;
    u32x4 kpre[4], vpre[4];
#pragma unroll
    for (int j = 0; j < 4; ++j) { const int id = tp + 128 * j, s = id & 63, d8 = (id >> 6) * 8;
        kpre[j] = *(const u32x4*)(C.PROJ() + (size_t)(row0 + s) * PW + 256 + h * 64 + d8);
        vpre[j] = *(const u32x4*)(C.PROJ() + (size_t)(row0 + s) * PW + 512 + h * 64 + d8); }
    if (sub == 0) {
        const float lf = C.GATES()[(size_t)(row0 + lane) * 16 + 4 + h], li = C.GATES()[(size_t)(row0 + lane) * 16 + h];
        float B = lf;
#pragma unroll
        for (int o = 1; o < 64; o <<= 1) { const float t = __shfl_up(B, o); if (lane >= o) B += t; }
        const float g = li - B, G = wmax(g), a = __shfl(B, 63);
        wt[lane] = __expf(g - G);
        if (lane == 0) { C.AB()[gc * 2] = a; C.AB()[gc * 2 + 1] = a + G; }
    }
    __syncthreads();
#pragma unroll
    for (int j = 0; j < 4; ++j) { const int id = tp + 128 * j, s = id & 63, d8 = (id >> 6) * 8;
        const u32x4 kk = kpre[j], vv = vpre[j];
        float f[8]; unpack8(kk, f); const float w = wt[s];
        u32x4 kw; kw.x = pkbf(f[0] * w, f[1] * w); kw.y = pkbf(f[2] * w, f[3] * w); kw.z = pkbf(f[4] * w, f[5] * w); kw.w = pkbf(f[6] * w, f[7] * w);
        *(u32x4*)(Kt + s * TP + d8) = kw; *(u32x4*)(Vt + s * TP + d8) = vv; }
    __syncthreads();
    f32x16 acc[2]; acc[0] = f32x16{}; acc[1] = f32x16{};
#pragma unroll
    for (int ks = 0; ks < 4; ++ks) {
        const bf16x8 a = gather8(Kt + (16 * ks + 8 * hi) * TP + 32 * sub + r32, TP, 4);
#pragma unroll
        for (int bj = 0; bj < 2; ++bj) { const bf16x8 bb = gather8(Vt + (16 * ks + 8 * hi) * TP + 32 * bj + r32, TP, 4);
            acc[bj] = __builtin_amdgcn_mfma_f32_32x32x16_bf16(a, bb, acc[bj], 0, 0, 0); }
    }
    float* U = C.UT() + (size_t)gc * 4160;
#pragma unroll
    for (int bj = 0; bj < 2; ++bj)
#pragma unroll
        for (int a4 = 0; a4 < 4; ++a4) { f32x4 v; v[0] = acc[bj][4 * a4]; v[1] = acc[bj][4 * a4 + 1]; v[2] = acc[bj][4 * a4 + 2]; v[3] = acc[bj][4 * a4 + 3];
            *(f32x4*)(U + (32 * bj + r32) * 64 + 32 * sub + 8 * a4 + 4 * hi) = v; }
    { float su = 0.f;
#pragma unroll 8
        for (int s = 0; s < 32; ++s) su += bf2f(Kt[(32 * hi + s) * TP + 32 * sub + r32]);
        su += __shfl_xor(su, 32);
        if (hi == 0) U[4096 + 32 * sub + r32] = su; }
    __syncthreads();
}

__device__ __forceinline__ void scan_phase(const Ctx& C, int l) {
    const int gtid = blockIdx.x * 512 + mk_tid(), GT = gridDim.x * 512;
    for (int idx = gtid; idx < 64 * 2080; idx += GT) {
        const int bh = idx / 2080, e = (idx % 2080) * 2;
        float s0 = 0.f, s1 = 0.f, m = -INFINITY;
        const float* U = C.UT() + (size_t)bh * 64 * 4160 + e; const float* ab = C.AB() + bh * 128;
#pragma unroll 16
        for (int c = 0; c < 64; ++c) { const int gc = bh * 64 + c;
            if (e < 4096) *(unsigned*)(C.CS() + (size_t)gc * 4096 + e) = pkbf(s0, s1); else { float2 o; o.x = s0; o.y = s1; *(float2*)(C.NS() + gc * 64 + e - 4096) = o; }
            if (e == 0) C.MS()[gc] = m;
            const float2 abv = *(const float2*)(ab + 2 * c); const float2 u = *(const float2*)(U + (size_t)c * 4160);
            const float mn = fmaxf(m + abv.x, abv.y);
            const float f0 = __expf(m + abv.x - mn), f1 = __expf(abv.y - mn);
            s0 = f0 * s0 + f1 * u.x; s1 = f0 * s1 + f1 * u.y; m = mn; }
        const int b_ = bh >> 2, h = bh & 3;
        if (e < 4096) { const int dv = e >> 6, dk = e & 63; float* o = C.out + O_PMC + ((size_t)((l * 16 + b_) * 4 + h)) * 4096 + dk * 64 + dv; o[0] = s0; o[64] = s1; }
        else { float* o = C.out + O_PMN + ((l * 16 + b_) * 4 + h) * 64 + e - 4096; o[0] = s0; o[1] = s1; }
        if (e == 0) C.out[O_PMM + (l * 16 + b_) * 4 + h] = m;
    }
}

constexpr int M3_PAIRB = 27136;
__device__ __forceinline__ void m3_quad(const Ctx& C, int l, int quad, unsigned char* smem) {
    const int tid = mk_tid(), lane = tid & 63, wid = __builtin_amdgcn_readfirstlane(tid >> 6), p = wid >> 1, tb = wid & 1, r32 = lane & 31, hi = lane >> 5;
    const int gc = quad * 4 + p, bh = gc >> 6, c = gc & 63, b = bh >> 2, h = bh & 3;
    const int row0 = b * SEQ + c * 64;
    unsigned char* base = smem + p * M3_PAIRB;
    bf16_t* Vt = (bf16_t*)base; float* tg = (float*)(base + 9216); float* tmu = tg + 64; float* te = tg + 128; float* tmt = tg + 192; float* tn0 = tg + 256;
    float* Hs = (float*)(base + 9216 + 1280) + tb * 2080;
    const int t = 32 * tb + r32;
    bf16x8 qf[4], kfr[2][4], cbf[2][4]; u32x4 mof[4];
#pragma unroll
    for (int ds = 0; ds < 4; ++ds) qf[ds] = *(const bf16x8*)(C.PROJ() + (size_t)(row0 + t) * PW + h * 64 + 16 * ds + 8 * hi);
#pragma unroll
    for (int sb = 0; sb < 2; ++sb) if (sb <= tb) {
#pragma unroll
        for (int ds = 0; ds < 4; ++ds) kfr[sb][ds] = *(const bf16x8*)(C.PROJ() + (size_t)(row0 + 32 * sb + r32) * PW + 256 + h * 64 + 16 * ds + 8 * hi); }
#pragma unroll
    for (int bj = 0; bj < 2; ++bj)
#pragma unroll
        for (int ds = 0; ds < 4; ++ds) cbf[bj][ds] = *(const bf16x8*)(C.CS() + (size_t)gc * 4096 + (32 * bj + r32) * 64 + 16 * ds + 8 * hi);
#pragma unroll
    for (int j8 = 0; j8 < 4; ++j8) mof[j8] = *(const u32x4*)(C.PROJ() + (size_t)(row0 + t) * PW + 768 + h * 64 + 32 * hi + 8 * j8);
    if (tb == 0) {
        const float lf = C.GATES()[(size_t)(row0 + lane) * 16 + 4 + h], li = C.GATES()[(size_t)(row0 + lane) * 16 + h];
        float B = lf;
#pragma unroll
        for (int o = 1; o < 64; o <<= 1) { const float t = __shfl_up(B, o); if (lane >= o) B += t; }
        const float g = li - B; float G = g;
#pragma unroll
        for (int o = 1; o < 64; o <<= 1) { const float t = __shfl_up(G, o); if (lane >= o) G = fmaxf(G, t); }
        const float m0 = C.MS()[gc], mu = fmaxf(m0, G);
        tg[lane] = g; tmu[lane] = mu; te[lane] = __expf(m0 - mu); tmt[lane] = B + mu; tn0[lane] = C.NS()[gc * 64 + lane];
    }
    { const int tp = tid & 127;
#pragma unroll
        for (int j = 0; j < 4; ++j) { const int id = tp + 128 * j, s = id & 63, d8 = (id >> 6) * 8;
            *(u32x4*)(Vt + s * TP + d8) = *(const u32x4*)(C.PROJ() + (size_t)(row0 + s) * PW + 512 + h * 64 + d8); } }
    __syncthreads();
    f32x16 st[2]; st[0] = f32x16{}; st[1] = f32x16{};
#pragma unroll
    for (int sb = 0; sb < 2; ++sb) if (sb <= tb) {
#pragma unroll
        for (int ds = 0; ds < 4; ++ds) st[sb] = __builtin_amdgcn_mfma_f32_32x32x16_bf16(kfr[sb][ds], qf[ds], st[sb], 0, 0, 0); }
    const float mu_t = tmu[t], e_t = te[t];
    float den = 0.f;
#pragma unroll
    for (int sb = 0; sb < 2; ++sb) if (sb <= tb) {
#pragma unroll
        for (int r = 0; r < 16; ++r) { const int s = 32 * sb + crow(r, hi); const float w = (s <= t) ? __expf(tg[s] - mu_t) : 0.f; st[sb][r] *= w; den += st[sb][r]; } }
    den += __shfl_xor(den, 32);
    f32x16 acc[2]; acc[0] = f32x16{}; acc[1] = f32x16{};
#pragma unroll
    for (int sb = 0; sb < 2; ++sb) if (sb <= tb) {
#pragma unroll
        for (int kk = 0; kk < 2; ++kk) { u32x4 pw; pw.x = pkbf(st[sb][8 * kk], st[sb][8 * kk + 1]); pw.y = pkbf(st[sb][8 * kk + 2], st[sb][8 * kk + 3]);
            pw.z = pkbf(st[sb][8 * kk + 4], st[sb][8 * kk + 5]); pw.w = pkbf(st[sb][8 * kk + 6], st[sb][8 * kk + 7]);
            const bf16x8 pa = __builtin_bit_cast(bf16x8, pw);
#pragma unroll
            for (int bj = 0; bj < 2; ++bj) { const bf16x8 vb = gather8(Vt + (32 * sb + 16 * kk + 4 * hi) * TP + 32 * bj + r32, TP, 8);
                acc[bj] = __builtin_amdgcn_mfma_f32_32x32x16_bf16(pa, vb, acc[bj], 0, 0, 0); } } }
    float qn = 0.f;
#pragma unroll
    for (int ds = 0; ds < 4; ++ds) { float f[8]; unpack8(__builtin_bit_cast(u32x4, qf[ds]), f);
#pragma unroll
        for (int j = 0; j < 8; ++j) qn += f[j] * tn0[16 * ds + 8 * hi + j];
        u32x4 qs; qs.x = pkbf(f[0] * e_t, f[1] * e_t); qs.y = pkbf(f[2] * e_t, f[3] * e_t); qs.z = pkbf(f[4] * e_t, f[5] * e_t); qs.w = pkbf(f[6] * e_t, f[7] * e_t);
        const bf16x8 qa = __builtin_bit_cast(bf16x8, qs);
#pragma unroll
        for (int bj = 0; bj < 2; ++bj) acc[bj] = __builtin_amdgcn_mfma_f32_32x32x16_bf16(qa, cbf[bj][ds], acc[bj], 0, 0, 0); }
    qn += __shfl_xor(qn, 32);
    den += e_t * qn;
    const float rden = 1.f / fmaxf(fabsf(den), __expf(-tmt[t]));
#pragma unroll
    for (int bj = 0; bj < 2; ++bj)
#pragma unroll
        for (int r = 0; r < 16; ++r) Hs[crow(r, hi) * 65 + 32 * bj + r32] = acc[bj][r];
    asm volatile("s_waitcnt lgkmcnt(0)" ::: "memory");
    float hv[32]; float s1 = 0.f;
#pragma unroll
    for (int j = 0; j < 32; ++j) { hv[j] = Hs[r32 * 65 + 32 * hi + j] * rden; s1 += hv[j]; }
    s1 += __shfl_xor(s1, 32);
    const float mean = s1 * (1.f / 64.f); float s2 = 0.f;
#pragma unroll
    for (int j = 0; j < 32; ++j) { hv[j] -= mean; s2 += hv[j] * hv[j]; }
    s2 += __shfl_xor(s2, 32);
    const float rstd = rsqrtf(s2 * (1.f / 64.f) + 1e-6f);
    const size_t row = (size_t)row0 + t;
    const float* ng = C.norm_g() + l * 256 + h * 64 + 32 * hi;
#pragma unroll
    for (int j8 = 0; j8 < 4; ++j8) { float mo[8]; unpack8(mof[j8], mo);
        float o[8];
#pragma unroll
        for (int j = 0; j < 8; ++j) o[j] = hv[8 * j8 + j] * rstd * ng[8 * j8 + j] * sigm(mo[j]);
        u32x4 w; w.x = pkbf(o[0], o[1]); w.y = pkbf(o[2], o[3]); w.z = pkbf(o[4], o[5]); w.w = pkbf(o[6], o[7]);
        *(u32x4*)(C.HA() + row * DM + h * 64 + 32 * hi + 8 * j8) = w; }
    __syncthreads();
}

constexpr int GP = 264;
__device__ __forceinline__ void gmlp_unit(const Ctx& C, int l, int unit, unsigned char* smem) {
    const int tid = mk_tid(), lane = tid & 63, wid = __builtin_amdgcn_readfirstlane(tid >> 6), r32 = lane & 31, hi = lane >> 5;
    const int row0 = unit * 128;
    bf16_t* vn = (bf16_t*)smem;
    const float4 lg = *(const float4*)(C.gln_g() + l * 256 + 4 * lane), lb = *(const float4*)(C.gln_b() + l * 256 + 4 * lane);
    u32x2 rpre[16];
#pragma unroll
    for (int i = 0; i < 16; ++i) rpre[i] = *(const u32x2*)(C.PROJ() + (size_t)(row0 + wid * 16 + i) * PW + 2816 + 4 * lane);
#pragma unroll
    for (int i = 0; i < 16; ++i) { const int s = wid * 16 + i;
        const u32x2 rr = rpre[i];
        float v0 = bf2f(rr.x & 0xffffu), v1 = bf2f(rr.x >> 16), v2 = bf2f(rr.y & 0xffffu), v3 = bf2f(rr.y >> 16);
        const float mean = wsum((v0 + v1) + (v2 + v3)) * (1.f / 256.f);
        v0 -= mean; v1 -= mean; v2 -= mean; v3 -= mean;
        const float rstd = rsqrtf(wsum((v0 * v0 + v1 * v1) + (v2 * v2 + v3 * v3)) * (1.f / 256.f) + 1e-5f);
        u32x2 o; o.x = pkbf(v0 * rstd * lg.x + lb.x, v1 * rstd * lg.y + lb.y); o.y = pkbf(v2 * rstd * lg.z + lb.z, v3 * rstd * lg.w + lb.w);
        *(u32x2*)(vn + s * GP + 4 * lane) = o; }
    __syncthreads();
    const int g = wid >> 1, th = wid & 1;
    const bf16_t* W = C.GW() + (size_t)(l * 4 + g) * 128 * 128;
    f32x16 acc[2][2];
#pragma unroll
    for (int i = 0; i < 2; ++i) { acc[i][0] = f32x16{}; acc[i][1] = f32x16{}; }
#pragma unroll
    for (int ks = 0; ks < 8; ++ks) {
        bf16x8 bfr[2];
        if (ks < 4 * th + 4) {
#pragma unroll
            for (int cbk = 0; cbk < 2; ++cbk) bfr[cbk] = gather8(vn + (16 * ks + 8 * hi) * GP + g * 64 + 32 * cbk + r32, GP, 4);
#pragma unroll
            for (int i = 0; i < 2; ++i) { const int tbk = 2 * th + i;
                if (ks < 2 * tbk + 2) { const bf16x8 a = *(const bf16x8*)(W + (32 * tbk + r32) * 128 + 16 * ks + 8 * hi);
                    acc[i][0] = __builtin_amdgcn_mfma_f32_32x32x16_bf16(a, bfr[0], acc[i][0], 0, 0, 0);
                    acc[i][1] = __builtin_amdgcn_mfma_f32_32x32x16_bf16(a, bfr[1], acc[i][1], 0, 0, 0); } }
        }
    }
    __syncthreads();
    float* Z = (float*)smem;
#pragma unroll
    for (int i = 0; i < 2; ++i)
#pragma unroll
        for (int cbk = 0; cbk < 2; ++cbk)
#pragma unroll
            for (int r = 0; r < 16; ++r) Z[(32 * (2 * th + i) + crow(r, hi)) * 257 + g * 64 + 32 * cbk + r32] = acc[i][cbk][r];
    __syncthreads();
#pragma unroll
    for (int j = 0; j < 8; ++j) { const int id = tid + 512 * j, t = id >> 5, c8 = (id & 31) * 8;
        float gu[8]; unpack8(*(const u32x4*)(C.PROJ() + (size_t)(row0 + t) * PW + 2560 + c8), gu);
        const float bsv = C.gbs()[(size_t)(l * 4 + (c8 >> 6)) * 128 + t];
        const float* z = Z + t * 257 + c8;
        u32x4 w; w.x = pkbf(gu[0] * (z[0] + bsv), gu[1] * (z[1] + bsv)); w.y = pkbf(gu[2] * (z[2] + bsv), gu[3] * (z[3] + bsv));
        w.z = pkbf(gu[4] * (z[4] + bsv), gu[5] * (z[5] + bsv)); w.w = pkbf(gu[6] * (z[6] + bsv), gu[7] * (z[7] + bsv));
        *(u32x4*)(C.HA() + (size_t)(row0 + t) * DM + 768 + c8) = w; }
    __syncthreads();
}

__device__ __forceinline__ void gmlp_sample_unit(const Ctx& C, int l, int bs_, unsigned char* smem) {
    const int tid = mk_tid(), lane = tid & 63, wid = __builtin_amdgcn_readfirstlane(tid >> 6);
    float* vn = (float*)smem;
    float* wl = vn + 32 * 257;
    const int row0 = NPT + bs_ * 32;
    for (int i = tid; i < 4096; i += 512) { const int g = i >> 10, t = (i >> 5) & 31, s2 = i & 31; wl[(g * 32 + t) * 33 + s2] = C.gws()[((size_t)(l * 4 + g) * 128 + t) * 128 + s2]; }
    const float4 lg = *(const float4*)(C.gln_g() + l * 256 + 4 * lane), lb = *(const float4*)(C.gln_b() + l * 256 + 4 * lane);
    for (int i = 0; i < 4; ++i) { const int s = wid * 4 + i;
        const u32x2 rr = *(const u32x2*)(C.PROJ() + (size_t)(row0 + s) * PW + 2816 + 4 * lane);
        float v0 = bf2f(rr.x & 0xffffu), v1 = bf2f(rr.x >> 16), v2 = bf2f(rr.y & 0xffffu), v3 = bf2f(rr.y >> 16);
        const float mean = wsum((v0 + v1) + (v2 + v3)) * (1.f / 256.f);
        v0 -= mean; v1 -= mean; v2 -= mean; v3 -= mean;
        const float rstd = rsqrtf(wsum((v0 * v0 + v1 * v1) + (v2 * v2 + v3 * v3)) * (1.f / 256.f) + 1e-5f);
        float4 o; o.x = v0 * rstd * lg.x + lb.x; o.y = v1 * rstd * lg.y + lb.y; o.z = v2 * rstd * lg.z + lb.z; o.w = v3 * rstd * lg.w + lb.w;
        vn[s * 257 + 4 * lane] = o.x; vn[s * 257 + 4 * lane + 1] = o.y; vn[s * 257 + 4 * lane + 2] = o.z; vn[s * 257 + 4 * lane + 3] = o.w;
        *(float4*)(C.out + O_SGV + ((size_t)(l * 16 + bs_) * 32 + s) * 256 + 4 * lane) = o; }
    __syncthreads();
    for (int j = 0; j < 16; ++j) { const int o = tid + 512 * j, t = o >> 8, cc = o & 255, g = cc >> 6;
        const float* w = wl + (g * 32 + t) * 33;
        float z = C.gbs()[(l * 4 + g) * 128 + t];
        for (int s = 0; s <= t; ++s) z += w[s] * vn[s * 257 + cc];
        const float gu = bf2f(C.PROJ()[(size_t)(row0 + t) * PW + 2560 + cc]);
        C.HA()[(size_t)(row0 + t) * DM + 768 + cc] = (bf16_t)(pkbf(gu * z, 0.f) & 0xffffu); }
    __syncthreads();
}

__device__ __forceinline__ void mlstm_sample_unit(const Ctx& C, int l, int unit, unsigned char* smem) {
    const int tid = mk_tid(), bs_ = unit >> 2, h = unit & 3;
    const int row0 = NPT + bs_ * 32;
    float* q = (float*)smem; float* k = q + 32 * 65; float* v = k + 32 * 65; float* P = v + 32 * 65;
    float* Hh = P + 32 * 33;
    float* tB = Hh + 32 * 65; float* tg = tB + 32; float* tmu = tg + 32; float* te = tmu + 32; float* tmt = te + 32; float* trd = tmt + 32; float* tmean = trd + 32; float* trs = tmean + 32; float* tw = trs + 32; float* C0s = tw + 64; float* n0s = C0s + 4096; float* tlf = n0s + 64; float* tli = tlf + 32;
    const size_t sidx = (size_t)(l * 16 + bs_) * 4 + h;
    int zo = 0; asm volatile("" : "+v"(zo));
    const float* C0g = C.st_C() + sidx * 4096; const float* n0g = C.st_n() + sidx * 64; const float m0 = C.st_m()[sidx];
    for (int i = tid; i < 1024; i += 512) *(float4*)(C0s + 4 * i) = *(const float4*)(C0g + 4 * i);
    if (tid < 64) n0s[tid] = n0g[tid];
    if (tid >= 64 && tid < 96) { const int t = tid - 64; tlf[t] = C.GATES()[(size_t)(row0 + t) * 16 + 4 + h]; tli[t] = C.GATES()[(size_t)(row0 + t) * 16 + h]; }
    const float* C0 = C0s; const float* n0 = n0s;
    for (int i = tid; i < 32 * 64; i += 512) { const int t = i >> 6, d = i & 63; const bf16_t* pr = C.PROJ() + (size_t)(row0 + t) * PW + h * 64 + d;
        q[t * 65 + d] = bf2f(pr[0]); k[t * 65 + d] = bf2f(pr[256]); v[t * 65 + d] = bf2f(pr[512]); }
    __syncthreads();
    if (tid == 0) { float B = 0.f, G = -INFINITY;
        for (int t = 0; t < 32; ++t) { const float lf = tlf[t], li = tli[t];
            B += lf; const float g = li - B; G = fmaxf(G, g); const float mu = fmaxf(m0, G);
            tB[t] = B; tg[t] = g; tmu[t] = mu; te[t] = __expf(m0 - mu); tmt[t] = B + mu; }
        const float mend = B + fmaxf(m0, G);
        for (int s = 0; s < 32; ++s) tw[s] = __expf(B + tg[s] - mend);
        tw[32] = __expf(m0 + B - mend); tw[33] = mend; }
    __syncthreads();
    for (int j = 0; j < 2; ++j) { const int t = tid >> 4, s = (tid & 15) + 16 * j; float d = 0.f;
        if (s <= t) { for (int e = 0; e < 64; ++e) d += q[t * 65 + e] * k[s * 65 + e]; d *= __expf(tg[s] - tmu[t]); }
        P[t * 33 + s] = d; }
    __syncthreads();
    if (tid < 32) { const int t = tid; float den = 0.f, qn = 0.f;
        for (int s = 0; s < 32; ++s) den += P[t * 33 + s];
        for (int e = 0; e < 64; ++e) qn += q[t * 65 + e] * n0[e + zo];
        den += te[t] * qn; trd[t] = 1.f / fmaxf(fabsf(den), __expf(-tmt[t])); }
    __syncthreads();
    { const int t = tid >> 4, d4 = (tid & 15) * 4; float a0 = 0.f, a1 = 0.f, a2 = 0.f, a3 = 0.f, c0 = 0.f, c1 = 0.f, c2 = 0.f, c3 = 0.f;
        for (int s = 0; s < 32; ++s) { const float p = P[t * 33 + s]; a0 += p * v[s * 65 + d4]; a1 += p * v[s * 65 + d4 + 1]; a2 += p * v[s * 65 + d4 + 2]; a3 += p * v[s * 65 + d4 + 3]; }
        for (int e = 0; e < 64; ++e) { const float qq = q[t * 65 + e]; const float4 cc = *(const float4*)(C0 + e * 64 + d4); c0 += qq * cc.x; c1 += qq * cc.y; c2 += qq * cc.z; c3 += qq * cc.w; }
        const float et = te[t], rd = trd[t];
        Hh[t * 65 + d4] = (a0 + et * c0) * rd; Hh[t * 65 + d4 + 1] = (a1 + et * c1) * rd; Hh[t * 65 + d4 + 2] = (a2 + et * c2) * rd; Hh[t * 65 + d4 + 3] = (a3 + et * c3) * rd; }
    __syncthreads();
    if (tid < 32) { float s1 = 0.f; for (int e = 0; e < 64; ++e) s1 += Hh[tid * 65 + e]; const float mean = s1 * (1.f / 64.f); float s2 = 0.f;
        for (int e = 0; e < 64; ++e) { const float d = Hh[tid * 65 + e] - mean; s2 += d * d; }
        tmean[tid] = mean; trs[tid] = rsqrtf(s2 * (1.f / 64.f) + 1e-6f); }
    __syncthreads();
    { const int t = tid >> 4, d4 = (tid & 15) * 4; const size_t row = (size_t)row0 + t; float o[4];
#pragma unroll
        for (int j = 0; j < 4; ++j) { const float mo = bf2f(C.PROJ()[row * PW + 768 + h * 64 + d4 + j]);
            o[j] = (Hh[t * 65 + d4 + j] - tmean[t]) * trs[t] * C.norm_g()[l * 256 + h * 64 + d4 + j] * sigm(mo); }
        u32x2 w; w.x = pkbf(o[0], o[1]); w.y = pkbf(o[2], o[3]); *(u32x2*)(C.HA() + row * DM + h * 64 + d4) = w; }
    { const int dk = tid >> 3, dv8 = (tid & 7) * 8; const float d0 = tw[32]; float a[8];
#pragma unroll
        for (int j = 0; j < 8; ++j) a[j] = d0 * C0[dk * 64 + dv8 + j];
        for (int s = 0; s < 32; ++s) { const float wk = tw[s + zo] * k[s * 65 + dk];
#pragma unroll
            for (int j = 0; j < 8; ++j) a[j] += wk * v[s * 65 + dv8 + j]; }
        float* o = C.out + O_SMC + sidx * 4096 + dk * 64 + dv8;
#pragma unroll
        for (int j = 0; j < 8; ++j) o[j] = a[j]; }
    if (tid < 64) { float a = tw[32] * n0[tid]; for (int s = 0; s < 32; ++s) a += tw[s + zo] * k[s * 65 + tid]; C.out[O_SMN + sidx * 64 + tid] = a; }
    if (tid == 0) C.out[O_SMM + sidx] = tw[33];
    __syncthreads();
}

__device__ __forceinline__ bf16x8 cvt8(const float* p) {
    const float4 a = *(const float4*)p, b = *(const float4*)(p + 4);
    u32x4 w; w.x = pkbf(a.x, a.y); w.y = pkbf(a.z, a.w); w.z = pkbf(b.x, b.y); w.w = pkbf(b.z, b.w);
    return __builtin_bit_cast(bf16x8, w);
}
__device__ __forceinline__ void fox_sample_unit(const Ctx& C, int l, int unit, unsigned char* smem) {
    const int tid = mk_tid(), lane = tid & 63, wid = __builtin_amdgcn_readfirstlane(tid >> 6), r32 = lane & 31, hi = lane >> 5, bs_ = unit >> 3, h = unit & 7;
    constexpr int NS_ = 1056;
    float* F = (float*)smem;
    float* pm = F + 1088;
    float* pl = pm + 256;
    float* wsc = pl + 256;
    float* pO = wsc + 256;
    const int row0 = NPT + bs_ * 32;
    const size_t cbase = (size_t)(l * 16 + bs_);
    if (wid == 0) {
        float v[17]; float tot = 0.f;
#pragma unroll
        for (int j = 0; j < 17; ++j) { const int s = lane * 17 + j; float x = 0.f;
            if (s < 1024) x = C.cache_logf()[(cbase * 1024 + s) * 8 + h]; else if (s < NS_) x = C.GATES()[(size_t)(row0 + s - 1024) * 16 + 8 + h];
            tot += x; v[j] = tot; }
        float inc = tot;
#pragma unroll
        for (int o = 1; o < 64; o <<= 1) { const float t = __shfl_up(inc, o); if (lane >= o) inc += t; }
        const float off = inc - tot;
#pragma unroll
        for (int j = 0; j < 17; ++j) { const int s = lane * 17 + j; if (s < NS_) F[s] = (off + v[j]) * LOG2E; }
    }
    bf16x8 qf[4];
#pragma unroll
    for (int ds = 0; ds < 4; ++ds) qf[ds] = *(const bf16x8*)(C.PROJ() + (size_t)(row0 + r32) * PW + 1024 + h * 64 + 16 * ds + 8 * hi);
    __syncthreads();
    const float Fq = F[1024 + r32];
    float m_run = -INFINITY, l_run = 0.f;
    f32x16 o[2]; o[0] = f32x16{}; o[1] = f32x16{};
    float* mysc = wsc + wid * 32;
    for (int kb = wid; kb < 33; kb += 8) {
        const int key0 = 32 * kb;
        const float* kbase = kb < 32 ? C.cache_k() + ((cbase * 1024 + key0) * 8 + h) * 64 : C.out + O_SFK + ((cbase * 32) * 8 + h) * 64;
        const float* vbase = kb < 32 ? C.cache_v() + ((cbase * 1024 + key0) * 8 + h) * 64 : C.out + O_SFV + ((cbase * 32) * 8 + h) * 64;
        f32x16 st = f32x16{};
#pragma unroll
        for (int ds = 0; ds < 4; ++ds) { const bf16x8 a = cvt8(kbase + (size_t)r32 * 512 + 16 * ds + 8 * hi); st = __builtin_amdgcn_mfma_f32_32x32x16_bf16(a, qf[ds], st, 0, 0, 0); }
        float mx = -INFINITY;
#pragma unroll
        for (int r = 0; r < 16; ++r) { const int key = key0 + crow(r, hi); float v = st[r] + Fq - F[key]; if (key > 1024 + r32) v = -INFINITY; st[r] = v; mx = fmaxf(mx, v); }
        mx = fmaxf(mx, __shfl_xor(mx, 32));
        const float m_new = fmaxf(m_run, mx), sc = exp2f(m_run - m_new);
        m_run = m_new; l_run *= sc;
        if (hi == 0) mysc[r32] = sc;
        float ps = 0.f;
#pragma unroll
        for (int r = 0; r < 16; ++r) { st[r] = exp2f(st[r] - m_new); ps += st[r]; }
        l_run += ps;
        asm volatile("s_waitcnt lgkmcnt(0)" ::: "memory");
#pragma unroll
        for (int r = 0; r < 16; ++r) { const float f = mysc[crow(r, hi)]; o[0][r] *= f; o[1][r] *= f; }
#pragma unroll
        for (int kk = 0; kk < 2; ++kk) { u32x4 pw; pw.x = pkbf(st[8 * kk], st[8 * kk + 1]); pw.y = pkbf(st[8 * kk + 2], st[8 * kk + 3]); pw.z = pkbf(st[8 * kk + 4], st[8 * kk + 5]); pw.w = pkbf(st[8 * kk + 6], st[8 * kk + 7]);
            const bf16x8 pa = __builtin_bit_cast(bf16x8, pw);
#pragma unroll
            for (int bj = 0; bj < 2; ++bj) { const float* vp = vbase + (size_t)(16 * kk + 4 * hi) * 512 + 32 * bj + r32;
                u32x4 vw; vw.x = pkbf(vp[0], vp[512]); vw.y = pkbf(vp[1024], vp[1536]); vw.z = pkbf(vp[4096], vp[4608]); vw.w = pkbf(vp[5120], vp[5632]);
                o[bj] = __builtin_amdgcn_mfma_f32_32x32x16_bf16(pa, __builtin_bit_cast(bf16x8, vw), o[bj], 0, 0, 0); } }
    }
    l_run += __shfl_xor(l_run, 32);
    if (hi == 0) { pm[wid * 32 + r32] = m_run; pl[wid * 32 + r32] = l_run; }
#pragma unroll
    for (int bj = 0; bj < 2; ++bj)
#pragma unroll
        for (int r = 0; r < 16; ++r) pO[(wid * 32 + crow(r, hi)) * 65 + 32 * bj + r32] = o[bj][r];
    __syncthreads();
    { const int t = tid >> 4, c4 = (tid & 15) * 4; float M = -INFINITY;
#pragma unroll
        for (int w = 0; w < 8; ++w) M = fmaxf(M, pm[w * 32 + t]);
        float den = 0.f, n0 = 0.f, n1 = 0.f, n2 = 0.f, n3 = 0.f;
#pragma unroll
        for (int w = 0; w < 8; ++w) { const float f = exp2f(pm[w * 32 + t] - M); den += f * pl[w * 32 + t]; const float* po = pO + (w * 32 + t) * 65 + c4;
            n0 += f * po[0]; n1 += f * po[1]; n2 += f * po[2]; n3 += f * po[3]; }
        const float inv = 1.f / den;
        u32x2 w2; w2.x = pkbf(n0 * inv, n1 * inv); w2.y = pkbf(n2 * inv, n3 * inv);
        *(u32x2*)(C.HA() + (size_t)(row0 + t) * DM + 256 + h * 64 + c4) = w2; }
    __syncthreads();
}
#define LAS __attribute__((address_space(3)))
#define XB_TMO      128
#define XB_XCNT(j)  (256  + 64 * (j))
#define XB_XSUB(j)  (1280 + 64 * (j))
#define XB_XGEN(j)  (2304 + 64 * (j))
#define XB_TOP      3328
#define XB_TOPGEN   3392
#define XCD_BAR_WORDS 3456
#define XB_SPIN_CAP (1u << 18)

__device__ __forceinline__ unsigned xb_ld(unsigned* p)              { return __hip_atomic_load(p, __ATOMIC_RELAXED, __HIP_MEMORY_SCOPE_AGENT); }
__device__ __forceinline__ unsigned xb_add(unsigned* p, unsigned v) { return __hip_atomic_fetch_add(p, v, __ATOMIC_RELAXED, __HIP_MEMORY_SCOPE_AGENT); }
__device__ __forceinline__ unsigned xb_xcc_id() { return (unsigned)__builtin_amdgcn_s_getreg((3 << 11) | 20) & 0xFu; }
#define XB_SPIN(cond, bar) do { unsigned _sp = 0; while (cond) { __builtin_amdgcn_s_sleep(1); \
    if ((++_sp & 255u) == 0u) { if (xb_ld(&(bar)[XB_TMO])) break; if (_sp > XB_SPIN_CAP) { atomicAdd(&(bar)[XB_TMO], 1u); break; } } } } while (0)

struct XcdBarrier {
    unsigned* bar; unsigned x;
    volatile LAS unsigned* st;
};

__device__ __forceinline__ XcdBarrier xcd_barrier_post(unsigned* bar, volatile LAS unsigned* st) {
    XcdBarrier b; b.bar = bar; b.x = xb_xcc_id(); b.st = st;
    if (threadIdx.x == 0) (void)xb_add(&bar[XB_XCNT(b.x)], 1u);
    return b;
}
__device__ __forceinline__ void xcd_barrier_complete(unsigned* bar, unsigned x, unsigned& nloc, unsigned& nx) {
    const unsigned G = gridDim.x * gridDim.y * gridDim.z;
    unsigned sum, cnt, mine, sp = 0u;
    for (;;) {
        sum = 0u; cnt = 0u; mine = 0u;
#pragma unroll
        for (unsigned j = 0; j < 16; ++j) { const unsigned c = xb_ld(&bar[XB_XCNT(j)]); sum += c; cnt += (c > 0u) ? 1u : 0u; mine = (j == x) ? c : mine; }
        if (sum == G) break;
        __builtin_amdgcn_s_sleep(1);
        if ((++sp & 255u) == 0u) { if (xb_ld(&bar[XB_TMO])) break; if (sp > XB_SPIN_CAP) { atomicAdd(&bar[XB_TMO], 1u); break; } }
    }
    nloc = mine > 0u ? mine : 1u; nx = cnt > 0u ? cnt : 1u;
}

__device__ __forceinline__ void xcd_barrier(const XcdBarrier& b) {
    asm volatile("s_waitcnt vmcnt(0)" ::: "memory");
    __syncthreads();
    if (threadIdx.x == 0) {
        unsigned* bar = b.bar;
        __builtin_amdgcn_s_waitcnt(0);
        unsigned nloc = b.st[0], nx = b.st[1];
        if (nloc == 0u) { xcd_barrier_complete(bar, b.x, nloc, nx); b.st[0] = nloc; b.st[1] = nx; }
        const unsigned old = xb_add(&bar[XB_XSUB(b.x)], 1u);
        const unsigned gen = old / nloc;
        if (old + 1u == (gen + 1u) * nloc) {
            __builtin_amdgcn_fence(__ATOMIC_RELEASE, "agent");
            asm volatile("s_waitcnt vmcnt(0)" ::: "memory");
            const unsigned og = xb_add(&bar[XB_TOP], 1u);
            const unsigned tg = og / nx;
            if (og + 1u == (tg + 1u) * nx) xb_add(&bar[XB_TOPGEN], 1u);
            else XB_SPIN(xb_ld(&bar[XB_TOPGEN]) == tg, bar);
            __builtin_amdgcn_fence(__ATOMIC_ACQUIRE, "agent");
            xb_add(&bar[XB_XGEN(b.x)], 1u);
            asm volatile("s_waitcnt vmcnt(0)" ::: "memory");
        } else {
            XB_SPIN(xb_ld(&bar[XB_XGEN(b.x)]) == gen, bar);
            __builtin_amdgcn_fence(__ATOMIC_ACQUIRE, "agent");
            asm volatile("s_waitcnt vmcnt(0)" ::: "memory");
        }
    }
    __syncthreads();
}

struct Args { const float* in[29]; float* out; unsigned char* ws; int ph_lo, ph_hi; };
constexpr int N_PHASES = 20;
#ifndef MK_ONLY
#define MK_ONLY -1
#endif
#define PH(k) (MK_ONLY < 0 || MK_ONLY == (k))
#ifndef MK_SUB
#define MK_SUB -1
#endif
#define SUB(j) ((MK_SUB < 0 || MK_SUB == (j)) && (rep == 0 || MK_REP_SUB < 0 || MK_REP_SUB == (j)))
#ifndef MK_REP_K
#define MK_REP_K -1000
#endif
#ifndef MK_REP_MASK
#define MK_REP_MASK 0
#endif
#ifndef MK_REP_N
#define MK_REP_N 1
#endif
#ifndef MK_REP_SUB
#define MK_REP_SUB -1
#endif

template <class Epi> __device__ __forceinline__ void run_gemm(int G, int bx, unsigned char* smem, const bf16_t* A, const bf16_t* Bt, int N, int K, const Epi& E) {
    pg8::Gemm g{A, Bt, MT, N, K}; pg8::StaticOrder S; S.init(MT, N, G, bx);
    pg8::gemm_phase<Epi, pg8::StaticOrder, true, true>((PG8_LAS unsigned char*)smem, g, S, E);
}

template <class Epi> __device__ __forceinline__ void run_gemm_panel(int G, int bx, unsigned char* smem, const bf16_t* A, const bf16_t* Bt, int N, int K, const Epi& E) {
    pg8::Gemm g{A, Bt, MT, N, K}; PanelOrder S; S.init(G, bx);
    pg8::gemm_phase<Epi, PanelOrder, true, true>((PG8_LAS unsigned char*)smem, g, S, E);
}

__global__ void __launch_bounds__(512, 2) mk_fwd(Args args) {
    extern __shared__ __attribute__((aligned(16))) unsigned char smem[];
    cg::grid_group grid = cg::this_grid();
    Ctx C; C.tab = (const PG8_LAS unsigned long long*)(smem + LDS_BYTES - 256);
    if (mk_tid() == 0) { PG8_LAS unsigned long long* tw = (PG8_LAS unsigned long long*)(smem + LDS_BYTES - 256);
#pragma unroll
        for (int i = 0; i < 29; ++i) tw[i] = (unsigned long long)args.in[i]; }
    if (mk_tid() < 2) ((volatile LAS unsigned*)(smem + LDS_BYTES - 16))[mk_tid()] = 0u;
    __syncthreads();
    XcdBarrier xbar = xcd_barrier_post((unsigned*)(args.ws + 4096), (volatile LAS unsigned*)(smem + LDS_BYTES - 16));

#ifdef MK_EXTRA_SYNCS
    for (int i = 0; i < MK_EXTRA_SYNCS; ++i) xcd_barrier(xbar);
#endif
    for (int ph = args.ph_lo; ph < args.ph_hi; ++ph) {
        { unsigned long long w_ = (unsigned long long)args.ws, o_ = (unsigned long long)args.out; asm volatile("" : "+s"(w_), "+s"(o_)); C.ws = (unsigned char*)(__attribute__((address_space(1))) unsigned char*)w_; C.out = (float*)(__attribute__((address_space(1))) float*)o_; }
        int G = (int)gridDim.x, bx = (int)blockIdx.x; asm volatile("" : "+s"(G), "+s"(bx));
        const int ptype = ph < 2 ? 100 + ph : (ph - 2) % 9; const int pbit = ptype >= 100 ? ptype - 91 : ptype; const int nrep = (ptype == MK_REP_K || ((MK_REP_MASK >> pbit) & 1)) ? MK_REP_N : 1;
        for (int rep = 0; rep < nrep; ++rep) {
        if (rep > 0) { XcdBarrier xb_ = xbar; unsigned long long bp_ = (unsigned long long)xb_.bar; asm volatile("" : "+s"(bp_)); xb_.bar = (unsigned*)(__attribute__((address_space(1))) unsigned*)bp_; xcd_barrier(xb_); }
        if (ph == 0) { if constexpr (PH(100)) p0a(C, smem); }
        else if (ph == 1) { if constexpr (PH(101)) p0b(C); }
        else {
            const int l = (ph - 2) / 9, k = (ph - 2) % 9;
            const float* mod = C.MOD() + (size_t)l * 32 * 6144;
            float* st1 = C.STATS() + (size_t)(l * 2) * MT * 2; float* st2 = C.STATS() + (size_t)(l * 2 + 1) * MT * 2; float* stw1 = rep > 0 ? C.STATS() + (size_t)4 * MT * 2 : st1; float* stw2 = rep > 0 ? C.STATS() + (size_t)4 * MT * 2 : st2;
            if (k == 0) { if constexpr (PH(0)) {
                EpiInProj E{C.PROJ(), C.GATES(), C.out, l, C.b_mi() + l * 4, C.b_mf() + l * 4, C.b_ff() + l * 8};
                run_gemm(G, bx, smem, C.HA(), C.WIN() + (size_t)l * NINP * 1024, NINP, 1024, E);
            } } else if (k == 1) { if constexpr (PH(1)) {
                if (SUB(0)) for (int q = bx; q < 1024; q += G) m1_quad(C, q, smem);
                if (SUB(1)) for (int u = bx; u < 512; u += G) gmlp_unit(C, l, u, smem);
                if (SUB(2)) for (int u = bx; u < 16; u += G) fcum_unit(C, u, smem);
                if (SUB(3)) for (int u = (bx + G - (16 % G)) % G; u < 64; u += G) mlstm_sample_unit(C, l, u, smem);
                if (SUB(4)) for (int u = (bx + G - (80 % G)) % G; u < 16; u += G) gmlp_sample_unit(C, l, u, smem);
            } } else if (k == 2) { if constexpr (PH(2)) {
                scan_phase(C, l);
            } } else if (k == 3) { if constexpr (PH(3)) {
                const attn_body::AttnTensors AT{(const attn_body::bf16*)(C.PROJ() + 1024), (const attn_body::bf16*)(C.PROJ() + 1536), (const attn_body::bf16*)(C.PROJ() + 2048), (attn_body::bf16*)(C.HA() + 256), C.FQ()};
                const int vcu0 = (G % 8 == 0) ? (bx % 8) * (G / 8) + bx / 8 : bx;
                if (SUB(0)) for (int v = vcu0; v < 256; v += G) { const attn_body::StaticOrder S(v); attn_body::attn_phase<attn_body::StaticOrder>((char*)smem, AT, S); }
                __syncthreads();
                if (SUB(1)) for (int q = bx; q < 1024; q += G) m3_quad(C, l, q, smem);
                if (SUB(2)) for (int u = G - 1 - bx; u < 128; u += G) fox_sample_unit(C, l, u, smem);
            } } else if (k == 4) { if constexpr (PH(4)) {
                if (l == 0) { EpiRes<false> E{C.x_prompt(), C.x_sample(), nullptr, nullptr, nullptr, nullptr, mod + 2048, C.R1(), stw1};
                    run_gemm_panel(G, bx, smem, C.HA(), C.WO() + (size_t)l * 1024 * 1024, 1024, 1024, E); }
                else { EpiRes<true> E{nullptr, nullptr, C.R2(), C.STATS() + (size_t)((l - 1) * 2 + 1) * MT * 2, C.ln2_g() + (l - 1) * 1024, C.ln2_b() + (l - 1) * 1024, mod + 2048, C.R1(), stw1};
                    run_gemm_panel(G, bx, smem, C.HA(), C.WO() + (size_t)l * 1024 * 1024, 1024, 1024, E); }
                if (rep == 0) { __syncthreads(); const int wv_ = __builtin_amdgcn_readfirstlane((int)(mk_tid() >> 6));
                    for (int p = bx; p < 256; p += G) ln_apply(C.R1(), st1, C.ln1_g() + l * 1024, C.ln1_b() + l * 1024, mod + 3072, mod + 4096, C.HA(), nullptr, nullptr, 256 * p, 256 * p + 256, wv_, 8); }
            } } else if (k == 5) { if constexpr (PH(5)) {
                { const int wv_ = __builtin_amdgcn_readfirstlane((int)(mk_tid() >> 6));
                  ln_apply(C.R1(), st1, C.ln1_g() + l * 1024, C.ln1_b() + l * 1024, mod + 3072, mod + 4096, C.HA(), nullptr, nullptr, rep == 0 ? NPT : 0, MT, bx * 8 + wv_, G * 8); }
            } } else if (k == 6) { if constexpr (PH(6)) {
                EpiSwiGLU E{C.PROJ()};
                run_gemm(G, bx, smem, C.HA(), C.WGU() + (size_t)l * 5632 * 1024, 5632, 1024, E);
            } } else if (k == 7) { if constexpr (PH(7)) {
                EpiRes<true> E{nullptr, nullptr, C.R1(), st1, C.ln1_g() + l * 1024, C.ln1_b() + l * 1024, mod + 5120, C.R2(), stw2};
                run_gemm(G, bx, smem, C.PROJ(), C.WD() + (size_t)l * 1024 * DFF, 1024, DFF, E);
            } } else { if constexpr (PH(8)) {
                if (l == 0) ln_apply(C.R2(), st2, C.ln2_g(), C.ln2_b(), mod + 32 * 6144, mod + 32 * 6144 + 1024, C.HA(), nullptr, nullptr, 0, MT, bx * 8 + __builtin_amdgcn_readfirstlane((int)(mk_tid() >> 6)), G * 8);
                else ln_apply(C.R2(), st2, C.ln2_g() + 1024, C.ln2_b() + 1024, nullptr, nullptr, nullptr, C.out + O_YP, C.out + O_YS, 0, MT, bx * 8 + __builtin_amdgcn_readfirstlane((int)(mk_tid() >> 6)), G * 8);
            } }
        }
        }
        if (ph + 1 < args.ph_hi) { if (args.ph_hi < 0) grid.sync(); else { XcdBarrier xb_ = xbar; unsigned long long bp_ = (unsigned long long)xb_.bar; asm volatile("" : "+s"(bp_)); xb_.bar = (unsigned*)(__attribute__((address_space(1))) unsigned*)bp_; xcd_barrier(xb_); } }
    }
}
}

#ifndef MK_NLAUNCH
#define MK_NLAUNCH 1
#endif
extern "C" void kernel_launch(void* const* d_in, const int* in_sizes, int n_in, void* d_out, int out_size, void* d_ws, size_t ws_size, hipStream_t stream) {
    static int grid = 0;
    if (grid == 0) {
        if (n_in != 29 || (size_t)out_size != mk::O_END || ws_size < mk::WS_END) { fprintf(stderr, "kernel_launch: unexpected shapes: n_in %d out %d ws %zu (need %zu)\n", n_in, out_size, ws_size, (size_t)mk::WS_END); grid = -1; return; }
        int dev = 0, cus = 0, per_cu = 0;
        (void)hipGetDevice(&dev); (void)hipDeviceGetAttribute(&cus, hipDeviceAttributeMultiprocessorCount, dev);
        if (hipFuncSetAttribute((const void*)mk::mk_fwd, hipFuncAttributeMaxDynamicSharedMemorySize, mk::LDS_BYTES) != hipSuccess) { fprintf(stderr, "kernel_launch: hipFuncSetAttribute failed\n"); grid = -1; return; }
        if (hipOccupancyMaxActiveBlocksPerMultiprocessor(&per_cu, (const void*)mk::mk_fwd, 512, mk::LDS_BYTES) != hipSuccess || per_cu < 1) { fprintf(stderr, "kernel_launch: occupancy query failed (%d)\n", per_cu); per_cu = 1; (void)hipGetLastError(); }
        grid = cus * (per_cu > 1 ? 1 : per_cu);
        if (grid <= 0) grid = 256;
    }
    if (grid < 0) return;
    if (hipMemsetAsync(d_ws, 0, 65536, stream) != hipSuccess) { fprintf(stderr, "kernel_launch: memset failed\n"); return; }
    mk::Args a{};
    for (int i = 0; i < 29; ++i) a.in[i] = (const float*)d_in[i];
    a.out = (float*)d_out; a.ws = (unsigned char*)d_ws;
    for (int li = 0; li < MK_NLAUNCH; ++li) {
        a.ph_lo = (MK_NLAUNCH == 1) ? 0 : li * mk::N_PHASES / MK_NLAUNCH; a.ph_hi = (MK_NLAUNCH == 1) ? mk::N_PHASES : (li + 1) * mk::N_PHASES / MK_NLAUNCH;
        void* kargs[] = {&a};
        const hipError_t e = hipLaunchCooperativeKernel((const void*)mk::mk_fwd, dim3(grid), dim3(512), kargs, mk::LDS_BYTES, stream);
        if (e != hipSuccess) { fprintf(stderr, "kernel_launch: cooperative launch failed: %s (grid %d)\n", hipGetErrorString(e), grid); break; }
    }
}
```
